# Optimizing an MI355X kernel written in HIP

```python
import jax, jax.numpy as jnp
from jax import lax
import numpy as np

D_MODEL = 1024
BATCH = 16
SEQ = 2048
DEPTH = 1
DEC_BATCH = 128
DEC_SEQ = 4
PAST_LEN = 8192
PAGE_SIZE = 128

HEAD_DIM = 64
N_HEADS = 8
ATTN_WIDTH = N_HEADS * HEAD_DIM
POOL_WIDTH = D_MODEL // 2
POOL_WINDOWS = (2, 4, 8, 16)
N_POOL_GROUPS = len(POOL_WINDOWS)
POOL_GROUP = POOL_WIDTH // N_POOL_GROUPS
POOL_HIST = max(POOL_WINDOWS) - 1
D_MIX = ATTN_WIDTH + POOL_WIDTH
PROJ_WIDTH = 3 * ATTN_WIDTH + POOL_WIDTH
DIL_PATTERNS = ((128, 1), (512, 4), (2048, 16))
N_STRIDED = 128
MAX_WINDOW = 2048
Q_BLOCK = 128
D_FF = 2816
CONV_WIDTH = 3
EPS = 1e-6
NEG = -1e30

kernel_name = 'hybrid_dilated_attn_pool_convffn_step'


def _rmsnorm(x, g):
    x32 = x.astype(jnp.float32)
    y = x32 * lax.rsqrt(jnp.mean(x32 * x32, axis=-1, keepdims=True) + EPS)
    return (y * g.astype(jnp.float32)).astype(x.dtype)


def _alibi_slopes():
    return jnp.asarray(2.0 ** (-8.0 * np.arange(1, N_HEADS + 1) / N_HEADS), dtype=jnp.float32)


def _dilated_branch_prompt(q, k, v, dilation, slopes):
    b, s, h, dh = q.shape
    L = s // dilation
    nb = -(-L // Q_BLOCK)
    Lp = nb * Q_BLOCK
    qs = q.reshape(b, L, dilation, h, dh)
    ks = k.reshape(b, L, dilation, h, dh)
    vs = v.reshape(b, L, dilation, h, dh)
    qb = jnp.pad(qs, ((0, 0), (0, Lp - L), (0, 0), (0, 0), (0, 0))).reshape(b, nb, Q_BLOCK, dilation, h, dh)
    pad_kv = ((0, 0), (Q_BLOCK, Lp - L), (0, 0), (0, 0), (0, 0))
    kp = jnp.pad(ks, pad_kv).reshape(b, nb + 1, Q_BLOCK, dilation, h, dh)
    vp = jnp.pad(vs, pad_kv).reshape(b, nb + 1, Q_BLOCK, dilation, h, dh)
    kb = jnp.concatenate([kp[:, :-1], kp[:, 1:]], axis=2)
    vb = jnp.concatenate([vp[:, :-1], vp[:, 1:]], axis=2)
    scores = jnp.einsum('bnqchd,bnkchd->bnchqk', qb, kb).astype(jnp.float32) * (HEAD_DIM ** -0.5)
    qi = jnp.arange(Q_BLOCK)[:, None]
    ki = jnp.arange(2 * Q_BLOCK)[None, :]
    diff = qi + Q_BLOCK - ki
    key_j = jnp.arange(nb)[:, None, None] * Q_BLOCK + ki[None] - Q_BLOCK
    valid = ((diff >= 0) & (diff <= N_STRIDED))[None] & (key_j >= 0)
    bias = -slopes[:, None, None] * (dilation * diff).astype(jnp.float32)[None]
    scores = jnp.where(valid[None, :, None, None], scores + bias[None, None, None], NEG)
    m = jnp.max(scores, axis=-1, keepdims=True)
    p = jnp.exp(scores - m)
    l = jnp.sum(p, axis=-1, keepdims=True)
    out = jnp.einsum('bnchqk,bnkchd->bnqchd', (p / l).astype(v.dtype), vb)
    lse = (m + jnp.log(l))[..., 0]
    out = out.reshape(b, Lp, dilation, h, dh)[:, :L].reshape(b, s, h, dh)
    lse = jnp.transpose(lse, (0, 1, 4, 2, 3)).reshape(b, Lp, dilation, h)[:, :L].reshape(b, s, h)
    return out, lse


def _dilated_branch_sample(q, k_all, v_all, dilation, slopes, n_hist):
    t = q.shape[1]
    n = jnp.arange(t)[:, None]
    kk = jnp.arange(N_STRIDED + 1)[None, :]
    idx = n_hist + n - kk * dilation
    valid = idx >= 0
    idx_c = jnp.maximum(idx, 0)
    kg = k_all[:, idx_c]
    vg = v_all[:, idx_c]
    scores = jnp.einsum('bthd,btkhd->bhtk', q, kg).astype(jnp.float32) * (HEAD_DIM ** -0.5)
    bias = -slopes[:, None, None] * (dilation * kk).astype(jnp.float32)[None]
    scores = jnp.where(valid[None, None], scores + bias[None], NEG)
    m = jnp.max(scores, axis=-1, keepdims=True)
    p = jnp.exp(scores - m)
    l = jnp.sum(p, axis=-1, keepdims=True)
    out = jnp.einsum('bhtk,btkhd->bthd', (p / l).astype(v_all.dtype), vg)
    lse = jnp.transpose((m + jnp.log(l))[..., 0], (0, 2, 1))
    return out, lse


def _merge_branches(branches):
    outs = jnp.stack([o for o, _ in branches], 0).astype(jnp.float32)
    lses = jnp.stack([s for _, s in branches], 0)
    w = jax.nn.softmax(lses, axis=0)[..., None]
    return jnp.sum(w * outs, axis=0)


def _pool_mixer(u_ext, pos, w_pool, pool_scale):
    b = u_ext.shape[0]
    t = pos.shape[0]
    u32 = u_ext.astype(jnp.float32)
    c = jnp.pad(jnp.cumsum(u32, axis=1), ((0, 0), (1, 0), (0, 0)))
    end = POOL_HIST + 1 + jnp.arange(t)
    groups = []
    for g, w in enumerate(POOL_WINDOWS):
        sl = slice(g * POOL_GROUP, (g + 1) * POOL_GROUP)
        wsum = c[:, end, sl] - c[:, end - w, sl]
        cnt = jnp.minimum(w, pos + 1).astype(jnp.float32)[None, :, None]
        groups.append(wsum / cnt)
    pooled = jnp.concatenate(groups, axis=-1)
    d = (pooled - u32[:, POOL_HIST:]).astype(u_ext.dtype).reshape(b, t, N_POOL_GROUPS, POOL_GROUP)
    mixed = jnp.einsum('btgc,gcd->btgd', d, w_pool).reshape(b, t, POOL_WIDTH)
    return mixed * pool_scale


def _conv_ffn(xn, hist, w_up, conv_w, conv_b, w_down):
    up = xn @ w_up
    ext = jnp.concatenate([hist, up], axis=1)
    t = up.shape[1]
    conv = conv_b + sum(ext[:, j:j + t] * conv_w[j] for j in range(CONV_WIDTH))
    gate, val = jnp.split(conv, 2, axis=-1)
    out = (jax.nn.silu(gate) * val) @ w_down
    return out, ext[:, -(CONV_WIDTH - 1):]


def _layer(x, pos, kv_hist, pool_prefix, ffn_prefix, g_attn_norm, w_in, g_q, g_k, w_pool, pool_scale,
           w_out, g_ffn_norm, w_up, conv_w, conv_b, w_down):
    b, t, _ = x.shape
    xn = _rmsnorm(x, g_attn_norm)
    proj = xn @ w_in
    q, k, v, u = jnp.split(proj, [ATTN_WIDTH, 2 * ATTN_WIDTH, 3 * ATTN_WIDTH], axis=-1)
    q = _rmsnorm(q.reshape(b, t, N_HEADS, HEAD_DIM), g_q)
    k = _rmsnorm(k.reshape(b, t, N_HEADS, HEAD_DIM), g_k)
    v = v.reshape(b, t, N_HEADS, HEAD_DIM)
    slopes = _alibi_slopes()
    if kv_hist is None:
        branches = [_dilated_branch_prompt(q, k, v, r, slopes) for (_, r) in DIL_PATTERNS]
        n_keep = min(MAX_WINDOW, t)
        new_k, new_v = k[:, t - n_keep:], v[:, t - n_keep:]
    else:
        k_hist, v_hist = kv_hist
        n_hist = k_hist.shape[1]
        k_all = jnp.concatenate([k_hist, k], axis=1)
        v_all = jnp.concatenate([v_hist, v], axis=1)
        branches = [_dilated_branch_sample(q, k_all, v_all, r, slopes, n_hist) for (_, r) in DIL_PATTERNS]
        new_k, new_v = k, v
    attn = _merge_branches(branches).astype(x.dtype).reshape(b, t, ATTN_WIDTH)
    u_ext = jnp.concatenate([pool_prefix, u], axis=1)
    pool_out = _pool_mixer(u_ext, pos, w_pool, pool_scale)
    new_pool = u_ext[:, -POOL_HIST:]
    h = x + jnp.concatenate([attn, pool_out.astype(x.dtype)], axis=-1) @ w_out
    ffn_out, new_ffn = _conv_ffn(_rmsnorm(h, g_ffn_norm), ffn_prefix, w_up, conv_w, conv_b, w_down)
    return h + ffn_out, new_k, new_v, new_pool, new_ffn


def setup_inputs(seed: int = 0) -> dict:
    key = jax.random.key(seed)
    ks = jax.random.split(key, 20)
    f32 = jnp.float32
    wb = min(MAX_WINDOW, PAST_LEN)

    def nrm(k, shape, scale):
        return jax.random.normal(k, shape, f32) * scale

    return {
        'x_prompt': nrm(ks[0], (BATCH, SEQ, D_MODEL), 1.0),
        'x_sample': nrm(ks[1], (DEC_BATCH, DEC_SEQ, D_MODEL), 1.0),
        'cache_k': nrm(ks[2], (DEPTH, DEC_BATCH, wb, N_HEADS, HEAD_DIM), 1.0),
        'cache_v': nrm(ks[3], (DEPTH, DEC_BATCH, wb, N_HEADS, HEAD_DIM), 1.0),
        'state_pool': nrm(ks[4], (DEPTH, DEC_BATCH, POOL_HIST, POOL_WIDTH), 1.0),
        'state_ffn_conv': nrm(ks[5], (DEPTH, DEC_BATCH, CONV_WIDTH - 1, 2 * D_FF), 1.0),
        'g_attn_norm': 1.0 + nrm(ks[6], (DEPTH, D_MODEL), 0.02),
        'w_in': nrm(ks[7], (DEPTH, D_MODEL, PROJ_WIDTH), D_MODEL ** -0.5),
        'g_q': 1.0 + nrm(ks[8], (DEPTH, N_HEADS, HEAD_DIM), 0.02),
        'g_k': 1.0 + nrm(ks[9], (DEPTH, N_HEADS, HEAD_DIM), 0.02),
        'w_pool': nrm(ks[10], (DEPTH, N_POOL_GROUPS, POOL_GROUP, POOL_GROUP), POOL_GROUP ** -0.5),
        'pool_scale': 1.0 + nrm(ks[11], (DEPTH, POOL_WIDTH), 0.02),
        'w_out': nrm(ks[12], (DEPTH, D_MIX, D_MODEL), D_MIX ** -0.5),
        'g_ffn_norm': 1.0 + nrm(ks[13], (DEPTH, D_MODEL), 0.02),
        'w_up': nrm(ks[14], (DEPTH, D_MODEL, 2 * D_FF), D_MODEL ** -0.5),
        'conv_w': nrm(ks[15], (DEPTH, CONV_WIDTH, 2 * D_FF), CONV_WIDTH ** -0.5),
        'conv_b': nrm(ks[16], (DEPTH, 2 * D_FF), 0.02),
        'w_down': nrm(ks[17], (DEPTH, D_FF, D_MODEL), D_FF ** -0.5),
    }


def reference(x_prompt, x_sample, cache_k, cache_v, state_pool, state_ffn_conv, g_attn_norm, w_in, g_q, g_k,
              w_pool, pool_scale, w_out, g_ffn_norm, w_up, conv_w, conv_b, w_down):
    pos_p = jnp.arange(x_prompt.shape[1])
    pos_s = PAST_LEN + jnp.arange(x_sample.shape[1])
    yp, ys = x_prompt, x_sample
    kp_l, vp_l, pp_l, fp_l, ks_l, vs_l, ps_l, fs_l = [], [], [], [], [], [], [], []
    for l in range(DEPTH):
        wts = (g_attn_norm[l], w_in[l], g_q[l], g_k[l], w_pool[l], pool_scale[l], w_out[l], g_ffn_norm[l],
               w_up[l], conv_w[l], conv_b[l], w_down[l])
        pool0 = jnp.zeros((yp.shape[0], POOL_HIST, POOL_WIDTH), yp.dtype)
        ffn0 = jnp.zeros((yp.shape[0], CONV_WIDTH - 1, 2 * D_FF), yp.dtype)
        yp, kp, vp, pp, fp = _layer(yp, pos_p, None, pool0, ffn0, *wts)
        ys, kn, vn, pn, fn = _layer(ys, pos_s, (cache_k[l], cache_v[l]), state_pool[l], state_ffn_conv[l], *wts)
        kp_l.append(kp); vp_l.append(vp); pp_l.append(pp); fp_l.append(fp)
        ks_l.append(kn); vs_l.append(vn); ps_l.append(pn); fs_l.append(fn)
    new_k_prompt = jnp.stack(kp_l, 0)
    new_v_prompt = jnp.stack(vp_l, 0)
    new_pool_prompt = jnp.stack(pp_l, 0)
    new_ffn_prompt = jnp.stack(fp_l, 0)
    new_k_sample = jnp.stack(ks_l, 0)
    new_v_sample = jnp.stack(vs_l, 0)
    new_pool_sample = jnp.stack(ps_l, 0)
    new_ffn_sample = jnp.stack(fs_l, 0)
    return (yp, ys, new_k_prompt, new_v_prompt, new_pool_prompt, new_ffn_prompt, new_k_sample, new_v_sample, new_pool_sample, new_ffn_sample)
```

```cpp
#include <hip/hip_runtime.h>
#include <hip/hip_bf16.h>
#include <cstdio>
#include <cstdint>
#ifndef MK_N_LAUNCHES
#define MK_N_LAUNCHES 7
#endif
constexpr int DM = 1024, NB = 16, SEQ = 2048, DB = 128, DS = 4;
constexpr int NH = 8, AW = 512, PJ = 2048, FF = 2816, FF2 = 5632;
constexpr int MP = NB * SEQ, MS = DB * DS, M = MP + MS;
constexpr int NPANEL = M / 256, NPANEL_P = MP / 256;
constexpr float EPS = 1e-6f;
constexpr float QSCALE = 0.125f * 1.4426950408889634f;
constexpr size_t O_Y = 0, O_KP = 34078720, O_VP = 50855936, O_PP = 67633152, O_FP = 67756032, O_KS = 67936256, O_VS = 68198400, O_PS = 68460544, O_FS = 69443584, O_END = 70885376;
namespace pg8 {
#define PG8_LAS __attribute__((address_space(3)))
typedef unsigned short bf16_t;
typedef short bf16x8 __attribute__((ext_vector_type(8)));
typedef float f32x4 __attribute__((ext_vector_type(4)));
typedef unsigned u32x4 __attribute__((ext_vector_type(4)));
constexpr int BM = 256, BK = 64, HALF = 128, HTB = HALF * BK * 2  , STAGE_BYTES = 8 * HTB, NXCD = 8, WGM = 8;

__host__ __device__ __forceinline__ int lds_byte(int r, int c) { const int st = (r >> 4) * 2 + (c >> 5), rr = r & 15, cc = c & 31, ob = rr * 64 + cc * 2; return st * 1024 + (ob ^ (((ob >> 9) & 1) << 5)); }
__host__ __device__ __forceinline__ void stage_rc(int b, int& R, int& C) { const int st = b / 1024, sb = b % 1024, swz = sb ^ (((sb >> 9) & 1) << 5); R = (st >> 1) * 16 + swz / 64; C = (st & 1) * 32 + (swz % 64) / 2; }
__host__ __device__ __forceinline__ int perm32(int rho) { const int n = rho >> 4, i = rho & 15; return 8 * (i >> 2) + 4 * n + (i & 3); }

struct Unit { int pm, pn; };
struct Gemm { const bf16_t* A; const bf16_t* Bt; int M, N, K; };

struct StaticOrder {
    int nM, nN, nwg, G, c;
    __host__ __device__ void init(int M, int N, int G_, int c_) { nM = M / BM; nN = N / BM; nwg = nM * nN; G = G_; c = c_; }
    __host__ __device__ bool next(int i, Unit& u) const {
        const long L = (long)i * G + c; if (L >= nwg) return false;
        int wgid = (int)L; { const int q = nwg / NXCD, r = nwg % NXCD, xcd = wgid % NXCD, off = wgid / NXCD; wgid = (xcd < r ? xcd * (q + 1) : r * (q + 1) + (xcd - r) * q) + off; }
        const int nig = WGM * nN, gid = wgid / nig, fm = gid * WGM, gsz = (nM - fm) < WGM ? (nM - fm) : WGM;
        u.pm = fm + ((wgid % nig) % gsz); u.pn = (wgid % nig) / gsz; return true;
    }
    __device__ __forceinline__ void a_ready(const Unit&) const {}
    __device__ __forceinline__ void done(const Unit&) const {}
};

__device__ __forceinline__ unsigned cvt_pk_bf16(float lo, float hi) { unsigned r; asm volatile("v_cvt_pk_bf16_f32 %0, %1, %2" : "=v"(r) : "v"(lo), "v"(hi)); return r; }
typedef float f32x2 __attribute__((ext_vector_type(2)));
typedef unsigned u32x2 __attribute__((ext_vector_type(2)));
__device__ __forceinline__ float dpp_ror1(float v) { return __builtin_bit_cast(float, __builtin_amdgcn_update_dpp(0, __builtin_bit_cast(int, v), 0x121, 0xf, 0xf, false)); }
__device__ __forceinline__ float dpp_ror2(float v) { return __builtin_bit_cast(float, __builtin_amdgcn_update_dpp(0, __builtin_bit_cast(int, v), 0x122, 0xf, 0xf, false)); }
__device__ __forceinline__ f32x4 ror1v(f32x4 v) { return (f32x4){dpp_ror1(v[0]), dpp_ror1(v[1]), dpp_ror1(v[2]), dpp_ror1(v[3])}; }
__device__ __forceinline__ f32x4 ror2v(f32x4 v) { return (f32x4){dpp_ror2(v[0]), dpp_ror2(v[1]), dpp_ror2(v[2]), dpp_ror2(v[3])}; }
__device__ __forceinline__ float silu_mul(float g, float v) { return g * v * __builtin_amdgcn_rcpf(1.0f + __builtin_amdgcn_exp2f(-1.4426950408889634f * g)); }

struct EpiInProj {
    static constexpr bool PERM = true, AFTER_DRAIN = false;
    bf16_t* QKVU; size_t tstride; float* out; const float* gq; const float* gk;
    __device__ __forceinline__ void operator()(f32x4 (&acc)[2][2][4][2], const Unit& u, int wr, int wc, int fr, int fq) const {
        const int type = u.pn >> 1, half = u.pn & 1;
        const int cbase = half * 256 + wc * 64 + 8 * fq;
        bf16_t* dst = QKVU + (size_t)type * tstride;
        f32x4 gv[2][2];
        if (type < 2) { const float* gs = (type == 0 ? gq : gk) + (half * 4 + wc) * 64 + 8 * fq; const float qs = type == 0 ? QSCALE : 1.0f;
#pragma unroll
            for (int bj = 0; bj < 2; ++bj)
#pragma unroll
                for (int n = 0; n < 2; ++n) gv[bj][n] = *(const f32x4*)(gs + 32 * bj + 4 * n) * qs; }
#pragma unroll
        for (int ai = 0; ai < 2; ++ai)
#pragma unroll
            for (int m = 0; m < 4; ++m) {
                const int row = u.pm * BM + ai * HALF + wr * 64 + m * 16 + fr;
                f32x4 v[2][2];
#pragma unroll
                for (int bj = 0; bj < 2; ++bj)
#pragma unroll
                    for (int n = 0; n < 2; ++n) v[bj][n] = acc[ai][bj][m][n];
                if (type < 2) {
                    float ss = 0.f;
#pragma unroll
                    for (int bj = 0; bj < 2; ++bj)
#pragma unroll
                        for (int n = 0; n < 2; ++n) { const f32x4 x = v[bj][n]; ss += (x[0] * x[0] + x[1] * x[1]) + (x[2] * x[2] + x[3] * x[3]); }
                    ss += __shfl_xor(ss, 16); ss += __shfl_xor(ss, 32);
                    const float r = 1.0f / sqrtf(ss * (1.0f / 64.0f) + EPS);
#pragma unroll
                    for (int bj = 0; bj < 2; ++bj)
#pragma unroll
                        for (int n = 0; n < 2; ++n) v[bj][n] = v[bj][n] * r * gv[bj][n];
                }
                bf16_t* rowp = dst + (size_t)row * 512 + cbase;
#pragma unroll
                for (int bj = 0; bj < 2; ++bj) { u32x4 w; w.x = cvt_pk_bf16(v[bj][0][0], v[bj][0][1]); w.y = cvt_pk_bf16(v[bj][0][2], v[bj][0][3]); w.z = cvt_pk_bf16(v[bj][1][0], v[bj][1][1]); w.w = cvt_pk_bf16(v[bj][1][2], v[bj][1][3]);
                    *(u32x4*)(rowp + 32 * bj) = w; }
                if (type == 1 || type == 2) {
                    float* o = out + (row < MP ? (type == 1 ? O_KP : O_VP) + (size_t)row * 512 : (type == 1 ? O_KS : O_VS) + (size_t)(row - MP) * 512) + cbase;
#pragma unroll
                    for (int bj = 0; bj < 2; ++bj) { *(f32x4*)(o + 32 * bj) = v[bj][0]; *(f32x4*)(o + 32 * bj + 4) = v[bj][1]; }
                } else if (type == 3) {
                    float* o = nullptr;
                    if (row < MP) { const int t = row & (SEQ - 1); if (t >= SEQ - 15) o = out + O_PP + ((size_t)(row >> 11) * 15 + (t - (SEQ - 15))) * 512 + cbase; }
                    else { const int rs = row - MP; o = out + O_PS + ((size_t)(rs >> 2) * 15 + 11 + (rs & 3)) * 512 + cbase; }
                    if (o) {
#pragma unroll
                        for (int bj = 0; bj < 2; ++bj) { *(f32x4*)(o + 32 * bj) = v[bj][0]; *(f32x4*)(o + 32 * bj + 4) = v[bj][1]; } }
                }
            }
    }
};

struct EpiOutProj {
    static constexpr bool PERM = true, AFTER_DRAIN = false;
    const float* xp; const float* xs; float* Y; bf16_t* HB; float* ssp; PG8_LAS float* tab;
    __device__ __forceinline__ void operator()(f32x4 (&acc)[2][2][4][2], const Unit& u, int wr, int wc, int fr, int fq) const {
#pragma unroll
        for (int ai = 0; ai < 2; ++ai)
#pragma unroll
            for (int m = 0; m < 4; ++m) {
                const int lrow = ai * HALF + wr * 64 + m * 16 + fr, row = u.pm * BM + lrow;
                const float* xr = (row < MP ? xp + (size_t)row * DM : xs + (size_t)(row - MP) * DM);
                const int col = u.pn * BM + wc * 32 + 8 * fq;
                float part = 0.f;
#pragma unroll
                for (int bj = 0; bj < 2; ++bj) {
                    const f32x4 h0 = *(const f32x4*)(xr + col + bj * HALF) + acc[ai][bj][m][0], h1 = *(const f32x4*)(xr + col + bj * HALF + 4) + acc[ai][bj][m][1];
                    float* yo = Y + (size_t)row * DM + col + bj * HALF; *(f32x4*)yo = h0; *(f32x4*)(yo + 4) = h1;
                    u32x4 w; w.x = cvt_pk_bf16(h0[0], h0[1]); w.y = cvt_pk_bf16(h0[2], h0[3]); w.z = cvt_pk_bf16(h1[0], h1[1]); w.w = cvt_pk_bf16(h1[2], h1[3]);
                    *(u32x4*)(HB + (size_t)row * DM + col + bj * HALF) = w;
                    part += (h0[0] * h0[0] + h0[1] * h0[1]) + (h0[2] * h0[2] + h0[3] * h0[3]) + (h1[0] * h1[0] + h1[1] * h1[1]) + (h1[2] * h1[2] + h1[3] * h1[3]);
                }
                part += __shfl_xor(part, 16); part += __shfl_xor(part, 32);
                if (fq == 0) tab[lrow * 4 + wc] = part;
                if (m & 1) asm volatile("" ::: "memory");
            }
        asm volatile("s_waitcnt lgkmcnt(0)" ::: "memory"); __builtin_amdgcn_s_barrier(); asm volatile("" ::: "memory");
        const int tid = (wr * 4 + wc) * 64 + fq * 16 + fr;
        if (tid < BM) { const f32x4 t = *(const PG8_LAS f32x4*)(tab + tid * 4); ssp[(size_t)(u.pm * BM + tid) * 4 + u.pn] = (t[0] + t[1]) + (t[2] + t[3]); }
    }
};

struct EpiUp {
    static constexpr bool PERM = true, AFTER_DRAIN = false;
    bf16_t* ACT; const float* ssp; float* halo; float* out; const float* convw; const float* convb; const float* hist; PG8_LAS float* tab;
    __device__ __forceinline__ void operator()(f32x4 (&acc)[2][2][4][2], const Unit& u, int wr, int wc, int fr, int fq) const {
        const int chb = 32 * wc + 8 * fq, ch0 = u.pn * 128 + chb;
        const bool sample = u.pm >= NPANEL_P;
#pragma unroll
        for (int ai = 0; ai < 2; ++ai)
#pragma unroll
            for (int m = 0; m < 4; ++m) {
                const int row = u.pm * BM + ai * HALF + wr * 64 + m * 16 + fr;
                const f32x4 t = *(const f32x4*)(ssp + (size_t)row * 4);
                const float rr = 1.0f / sqrtf(((t[0] + t[1]) + (t[2] + t[3])) * (1.0f / DM) + EPS);
#pragma unroll
                for (int bj = 0; bj < 2; ++bj)
#pragma unroll
                    for (int n = 0; n < 2; ++n) acc[ai][bj][m][n] = acc[ai][bj][m][n] * rr;
            }
        if (fr >= 14) {
#pragma unroll
            for (int ai = 0; ai < 2; ++ai)
#pragma unroll
                for (int bj = 0; bj < 2; ++bj)
#pragma unroll
                    for (int n = 0; n < 2; ++n) *(PG8_LAS f32x4*)(tab + ((ai * 2 + wr) * 2 + (fr - 14)) * 256 + bj * 128 + chb + 4 * n) = acc[ai][bj][3][n];
        }
        if (!sample) {
            if (wr == 0 && fr < 2) {
#pragma unroll
                for (int bj = 0; bj < 2; ++bj)
#pragma unroll
                    for (int n = 0; n < 2; ++n) *(f32x4*)(halo + (size_t)(u.pm * 4 + fr) * FF2 + bj * FF + ch0 + 4 * n) = acc[0][bj][0][n];
            }
            if (wr == 1 && fr >= 14) {
#pragma unroll
                for (int bj = 0; bj < 2; ++bj)
#pragma unroll
                    for (int n = 0; n < 2; ++n) { *(f32x4*)(halo + (size_t)(u.pm * 4 + 2 + fr - 14) * FF2 + bj * FF + ch0 + 4 * n) = acc[1][bj][3][n];
                        if ((u.pm & 7) == 7) *(f32x4*)(out + O_FP + (size_t)((u.pm >> 3) * 2 + fr - 14) * FF2 + bj * FF + ch0 + 4 * n) = acc[1][bj][3][n]; }
            }
        } else if ((fr & 3) >= 2) {
#pragma unroll
            for (int ai = 0; ai < 2; ++ai)
#pragma unroll
                for (int m = 0; m < 4; ++m) { const int rs = u.pm * BM + ai * HALF + wr * 64 + m * 16 + fr - MP;
#pragma unroll
                    for (int bj = 0; bj < 2; ++bj)
#pragma unroll
                        for (int n = 0; n < 2; ++n) *(f32x4*)(out + O_FS + (size_t)((rs >> 2) * 2 + (fr & 3) - 2) * FF2 + bj * FF + ch0 + 4 * n) = acc[ai][bj][m][n]; }
        }
        asm volatile("s_waitcnt lgkmcnt(0)" ::: "memory"); __builtin_amdgcn_s_barrier(); asm volatile("" ::: "memory");
#pragma unroll
        for (int n = 0; n < 2; ++n) {
            f32x4 w0[2], w1[2], w2[2], cb[2];
#pragma unroll
            for (int bj = 0; bj < 2; ++bj) { const int col = bj * FF + ch0 + 4 * n; w0[bj] = *(const f32x4*)(convw + col); w1[bj] = *(const f32x4*)(convw + FF2 + col); w2[bj] = *(const f32x4*)(convw + 2 * FF2 + col); cb[bj] = *(const f32x4*)(convb + col); }
#pragma unroll
            for (int ai = 0; ai < 2; ++ai) {
                f32x4 pv[2];
                if (!sample) {
                    const int sb = (wr == 1) ? ai * 2 : 1;
#pragma unroll
                    for (int bj = 0; bj < 2; ++bj) { pv[bj] = (f32x4){0.f, 0.f, 0.f, 0.f}; if (fr >= 14) pv[bj] = *(const PG8_LAS f32x4*)(tab + (sb * 2 + (fr - 14)) * 256 + bj * 128 + chb + 4 * n); }
                }
#pragma unroll
                for (int m = 0; m < 4; ++m) {
                    const int row = u.pm * BM + ai * HALF + wr * 64 + m * 16 + fr;
                    f32x4 cv[2];
                    if (!sample) {
#pragma unroll
                        for (int bj = 0; bj < 2; ++bj) { const f32x4 cur = acc[ai][bj][m][n]; const f32x4 prv = m > 0 ? acc[ai][bj][m - 1][n] : pv[bj];
                            const f32x4 p1 = ror1v(fr == 15 ? prv : cur), p2 = ror2v(fr >= 14 ? prv : cur);
                            cv[bj] = cb[bj] + w0[bj] * p2 + w1[bj] * p1 + w2[bj] * cur; }
                    } else {
                        const int rs = row - MP, ns = fr & 3; const float* hp = hist + (size_t)(rs >> 2) * 2 * FF2 + ch0 + 4 * n;
#pragma unroll
                        for (int bj = 0; bj < 2; ++bj) { const f32x4 cur = acc[ai][bj][m][n]; const f32x4 c1 = ror1v(cur), c2 = ror2v(cur);
                            const f32x4 h0 = *(const f32x4*)(hp + bj * FF), h1 = *(const f32x4*)(hp + FF2 + bj * FF);
                            const f32x4 p1 = ns >= 1 ? c1 : h1, p2 = ns >= 2 ? c2 : (ns == 1 ? h1 : h0);
                            cv[bj] = cb[bj] + w0[bj] * p2 + w1[bj] * p1 + w2[bj] * cur; }
                    }
                    u32x2 w; w.x = cvt_pk_bf16(silu_mul(cv[0][0], cv[1][0]), silu_mul(cv[0][1], cv[1][1])); w.y = cvt_pk_bf16(silu_mul(cv[0][2], cv[1][2]), silu_mul(cv[0][3], cv[1][3]));
                    const bool skip = !sample && ai == 0 && m == 0 && wr == 0 && fr < 2;
                    if (!skip) *(u32x2*)(ACT + (size_t)row * FF + ch0 + 4 * n) = w;
                }
            }
        }
    }
};

struct EpiDown {
    static constexpr bool PERM = true, AFTER_DRAIN = false;
    float* Y;
    __device__ __forceinline__ void operator()(f32x4 (&acc)[2][2][4][2], const Unit& u, int wr, int wc, int fr, int fq) const {
#pragma unroll
        for (int ai = 0; ai < 2; ++ai)
#pragma unroll
            for (int m = 0; m < 4; ++m) {
                const int row = u.pm * BM + ai * HALF + wr * 64 + m * 16 + fr;
                float* yo = Y + (size_t)row * DM + u.pn * BM + wc * 32 + 8 * fq;
#pragma unroll
                for (int bj = 0; bj < 2; ++bj) { const f32x4 a = *(const f32x4*)(yo + bj * HALF) + acc[ai][bj][m][0], b = *(const f32x4*)(yo + bj * HALF + 4) + acc[ai][bj][m][1];
                    *(f32x4*)(yo + bj * HALF) = a; *(f32x4*)(yo + bj * HALF + 4) = b; }
            }
    }
};

template <class Epi, class Sched, bool ALIGN_EPI = false, bool SP2 = false>
__device__ __forceinline__ void gemm_phase(PG8_LAS unsigned char* lds, const Gemm g, const Sched& S, const Epi& E) {
    const int tid = threadIdx.x, wid = __builtin_amdgcn_readfirstlane(tid >> 6), lane = tid & 63, wr = wid >> 2, wc = wid & 3, fr = lane & 15, fq = lane >> 4;
    const int K = g.K, nt = K / BK;
    unsigned voffA[2], voffB[2];
#pragma unroll
    for (int i = 0; i < 2; ++i) { int R, C; stage_rc(tid * 16 + i * 8192, R, C); const int Rb = Epi::PERM ? ((R & ~31) + perm32(R & 31)) : R;
        voffA[i] = (unsigned)(R * K + C) * 2u; voffB[i] = (unsigned)(Rb * K + C) * 2u; }
    const size_t kstep = (size_t)(BK * 2);
    const size_t hstep = (size_t)HALF * K * 2;
    const size_t tstep = 2 * hstep;
    const unsigned ldsw = (unsigned)wid * 1024u;
    const int aoff = lds_byte(wr * 64 + fr, fq * 8), boff = lds_byte(wc * 32 + fr, fq * 8);
#define PG8_SA(b, h) (((b) * 2 + (h)) * HTB)
#define PG8_SB(b, h) ((4 + (b) * 2 + (h)) * HTB)
#define PG8_STAGE(bufoff, gbase, voff) do { _Pragma("unroll") for (int _i = 0; _i < 2; ++_i) \
        __builtin_amdgcn_global_load_lds((const unsigned*)((const char*)(gbase) + (voff)[_i]), (PG8_LAS unsigned*)(lds + (bufoff) + ldsw + _i * 8192), 16, 0, 0); } while (0)
#define PG8_LDA(dst, b, h) do { _Pragma("unroll") for (int m = 0; m < 4; ++m) _Pragma("unroll") for (int k = 0; k < 2; ++k) dst[m][k] = *(const PG8_LAS bf16x8*)(lds + PG8_SA(b, h) + aoff + m * 2048 + k * 1024); } while (0)
#define PG8_LDB(dst, b, h) do { _Pragma("unroll") for (int n = 0; n < 2; ++n) _Pragma("unroll") for (int k = 0; k < 2; ++k) dst[n][k] = *(const PG8_LAS bf16x8*)(lds + PG8_SB(b, h) + boff + n * 2048 + k * 1024); } while (0)
#define PG8_MMA(ai, bj, At, Bt) do { __builtin_amdgcn_s_setprio(1); _Pragma("unroll") for (int m = 0; m < 4; ++m) _Pragma("unroll") for (int n = 0; n < 2; ++n) _Pragma("unroll") for (int k = 0; k < 2; ++k) \
        acc[ai][bj][m][n] = __builtin_amdgcn_mfma_f32_16x16x32_bf16(Bt[n][k], At[m][k], acc[ai][bj][m][n], 0, 0, 0); __builtin_amdgcn_s_setprio(0); } while (0)
#define PG8_WAIT_V(n) asm volatile("s_waitcnt vmcnt(" #n ")" ::: "memory")
#define PG8_WAIT_L(n) asm volatile("s_waitcnt lgkmcnt(" #n ")" ::: "memory")
#define PG8_BAR __builtin_amdgcn_s_barrier()
#define PG8_SCHED __builtin_amdgcn_sched_barrier(0)
    Unit cur, nxt; int ui = 0;
    if (!S.next(0, cur)) return;
    f32x4 acc[2][2][4][2];
#pragma unroll
    for (int a = 0; a < 2; ++a)
#pragma unroll
        for (int b = 0; b < 2; ++b)
#pragma unroll
            for (int m = 0; m < 4; ++m)
#pragma unroll
                for (int n = 0; n < 2; ++n) acc[a][b][m][n] = (f32x4){0.f, 0.f, 0.f, 0.f};
    bf16x8 At[4][2], B0[2][2], B1[2][2];
    const char* cA = (const char*)g.A + (size_t)cur.pm * tstep; const char* cB = (const char*)g.Bt + (size_t)cur.pn * tstep;
    S.a_ready(cur);
    if constexpr (SP2) {
        PG8_STAGE(PG8_SB(0, 0), cB, voffB); PG8_STAGE(PG8_SB(0, 1), cB + hstep, voffB); PG8_STAGE(PG8_SA(0, 0), cA, voffA); PG8_STAGE(PG8_SA(0, 1), cA + hstep, voffA);
        if (wr == 1) PG8_BAR;
        PG8_WAIT_V(2); PG8_BAR;
        PG8_STAGE(PG8_SB(1, 0), cB + kstep, voffB); PG8_STAGE(PG8_SA(1, 0), cA + kstep, voffA); PG8_STAGE(PG8_SB(1, 1), cB + hstep + kstep, voffB);
        PG8_WAIT_V(6); PG8_BAR;
    } else {
        PG8_STAGE(PG8_SB(0, 0), cB, voffB); PG8_STAGE(PG8_SA(0, 0), cA, voffA); PG8_STAGE(PG8_SB(0, 1), cB + hstep, voffB); PG8_STAGE(PG8_SA(0, 1), cA + hstep, voffA);
        if (wr == 1) PG8_BAR;
        PG8_WAIT_V(4); PG8_BAR;
        PG8_STAGE(PG8_SB(1, 0), cB + kstep, voffB); PG8_STAGE(PG8_SA(1, 0), cA + kstep, voffA); PG8_STAGE(PG8_SB(1, 1), cB + hstep + kstep, voffB);
        PG8_WAIT_V(6); PG8_BAR;
    }
    for (;;) {
        const bool has_next = S.next(ui + 1, nxt);
        const char* nA = has_next ? (const char*)g.A + (size_t)nxt.pm * tstep : cA; const char* nB = has_next ? (const char*)g.Bt + (size_t)nxt.pn * tstep : cB;
        for (int t = 0; t < nt; t += 2) {
            const bool last = (t == nt - 2);
            const char* a1 = cA + (size_t)(t + 1) * kstep;
            const char* a2 = last ? nA : cA + (size_t)(t + 2) * kstep; const char* b2 = last ? nB : cB + (size_t)(t + 2) * kstep;
            const char* a3 = a2 + kstep; const char* b3 = b2 + kstep;
            if (last && has_next) S.a_ready(nxt);
            if constexpr (SP2) {
            PG8_LDB(B0, 0, 0); PG8_LDB(B1, 0, 1); PG8_SCHED; PG8_LDA(At, 0, 0); PG8_STAGE(PG8_SA(1, 1), a1 + hstep, voffA);
            PG8_WAIT_V(8); PG8_WAIT_L(0); PG8_BAR; PG8_MMA(0, 0, At, B0); PG8_MMA(0, 1, At, B1); PG8_BAR; PG8_SCHED;
            PG8_LDA(At, 0, 1); PG8_STAGE(PG8_SB(0, 0), b2, voffB); PG8_STAGE(PG8_SB(0, 1), b2 + hstep, voffB); PG8_STAGE(PG8_SA(0, 0), a2, voffA);
            PG8_WAIT_V(8); PG8_WAIT_L(0); PG8_BAR; PG8_MMA(1, 0, At, B0); PG8_MMA(1, 1, At, B1); PG8_BAR; PG8_SCHED;
            PG8_LDB(B0, 1, 0); PG8_LDB(B1, 1, 1); PG8_SCHED; PG8_LDA(At, 1, 0); PG8_STAGE(PG8_SA(0, 1), a2 + hstep, voffA);
            PG8_WAIT_V(8); PG8_WAIT_L(0); PG8_BAR; PG8_MMA(0, 0, At, B0); PG8_MMA(0, 1, At, B1); PG8_BAR; PG8_SCHED;
            PG8_LDA(At, 1, 1); PG8_STAGE(PG8_SB(1, 0), b3, voffB); PG8_STAGE(PG8_SB(1, 1), b3 + hstep, voffB); PG8_STAGE(PG8_SA(1, 0), a3, voffA);
            PG8_WAIT_V(8); PG8_WAIT_L(0); PG8_BAR; PG8_MMA(1, 0, At, B0); PG8_MMA(1, 1, At, B1); PG8_BAR; PG8_SCHED;
            } else {
            PG8_LDB(B0, 0, 0); PG8_SCHED; PG8_LDA(At, 0, 0); PG8_STAGE(PG8_SA(1, 1), a1 + hstep, voffA);
            PG8_WAIT_L(8); PG8_BAR; PG8_WAIT_L(0); PG8_MMA(0, 0, At, B0); PG8_BAR; PG8_SCHED;
            PG8_LDB(B1, 0, 1); PG8_STAGE(PG8_SB(0, 0), b2, voffB);
            PG8_BAR; PG8_WAIT_L(0); PG8_MMA(0, 1, At, B1); PG8_BAR;
            PG8_LDA(At, 0, 1); PG8_STAGE(PG8_SA(0, 0), a2, voffA);
            PG8_BAR; PG8_WAIT_L(0); PG8_MMA(1, 0, At, B0); PG8_BAR; PG8_SCHED;
            PG8_STAGE(PG8_SB(0, 1), b2 + hstep, voffB);
            PG8_WAIT_V(6); PG8_BAR; PG8_MMA(1, 1, At, B1); PG8_BAR;
            PG8_LDB(B0, 1, 0); PG8_SCHED; PG8_LDA(At, 1, 0); PG8_STAGE(PG8_SA(0, 1), a2 + hstep, voffA);
            PG8_WAIT_L(8); PG8_BAR; PG8_WAIT_L(0); PG8_MMA(0, 0, At, B0); PG8_BAR; PG8_SCHED;
            PG8_LDB(B1, 1, 1); PG8_STAGE(PG8_SB(1, 0), b3, voffB);
            PG8_BAR; PG8_WAIT_L(0); PG8_MMA(0, 1, At, B1); PG8_BAR;
            PG8_LDA(At, 1, 1); PG8_STAGE(PG8_SA(1, 0), a3, voffA);
            PG8_BAR; PG8_WAIT_L(0); PG8_MMA(1, 0, At, B0); PG8_BAR; PG8_SCHED;
            PG8_STAGE(PG8_SB(1, 1), b3 + hstep, voffB);
            PG8_WAIT_V(6); PG8_BAR; PG8_MMA(1, 1, At, B1); PG8_BAR;
            }
        }
        if constexpr (ALIGN_EPI) { if (wr == 0) PG8_BAR; }
        if constexpr (!Epi::AFTER_DRAIN) { E(acc, cur, wr, wc, fr, fq); S.done(cur); }
        if (!has_next) break;
#pragma unroll
        for (int a = 0; a < 2; ++a)
#pragma unroll
            for (int b = 0; b < 2; ++b)
#pragma unroll
                for (int m = 0; m < 4; ++m)
#pragma unroll
                    for (int n = 0; n < 2; ++n) acc[a][b][m][n] = (f32x4){0.f, 0.f, 0.f, 0.f};
        cur = nxt; cA = nA; cB = nB; ++ui;
        if constexpr (ALIGN_EPI) { if (wr == 1) PG8_BAR; }
    }
    PG8_WAIT_V(0);
    if constexpr (!ALIGN_EPI) { if (wr == 0) PG8_BAR; }
    PG8_BAR;
    if constexpr (Epi::AFTER_DRAIN) { E.fused(acc, cur, wr, wc, fr, fq, lds, wid, lane); S.done(cur); }
#undef PG8_SA
#undef PG8_SB
#undef PG8_STAGE
#undef PG8_LDA
#undef PG8_LDB
#undef PG8_MMA
#undef PG8_WAIT_V
#undef PG8_WAIT_L
#undef PG8_BAR
#undef PG8_SCHED
}
}

constexpr int NWAVES = 8;
constexpr int N_LAUNCHES = MK_N_LAUNCHES;
constexpr int PER_PHASE = 7;
constexpr size_t MiB = 1u << 20;
constexpr size_t WS_CTL = 0, CTL_ZERO_BYTES = 1 * MiB;
constexpr size_t WS_WIN = 2 * MiB, WS_WOUT = 6 * MiB, WS_WUP = 8 * MiB, WS_WDN = 20 * MiB, WS_WPOOL = 26 * MiB;
constexpr size_t WS_HALO = 28 * MiB;
constexpr size_t WS_SSP = 40 * MiB;
constexpr size_t WS_XN = 44 * MiB;
constexpr size_t WS_Q = 110 * MiB, QKVU_STRIDE = 33 * MiB;
constexpr size_t WS_MIX = 242 * MiB;
constexpr size_t WS_HB = 308 * MiB;
constexpr size_t WS_ACT = 374 * MiB;
constexpr size_t WS_END = 554 * MiB;
static_assert(WS_XN + (size_t)M * DM * 2 <= WS_Q && WS_Q + 4 * QKVU_STRIDE <= WS_MIX && WS_MIX + (size_t)M * DM * 2 <= WS_HB && WS_HB + (size_t)M * DM * 2 <= WS_ACT && WS_ACT + (size_t)M * FF * 2 <= WS_END, "d_ws map");
static_assert(WS_HALO + (size_t)NPANEL * 4 * FF2 * 4 <= WS_SSP && WS_SSP + (size_t)M * 16 * 4 <= WS_XN && (size_t)M * 512 * 2 <= QKVU_STRIDE, "d_ws map 2");
constexpr int CW_TMO = 0, CW_CODE = 1, CW_BAR = 4096;
constexpr int RING_OFF = 0, RING_BYTES = 131072;
constexpr int TAB_OFF = RING_BYTES;
constexpr int LDSCTL_OFF = RING_BYTES + 8192, MISC_OFF = LDSCTL_OFF + 320;
constexpr int LDS_BYTES = 147456;
static_assert(MISC_OFF + 128 <= LDS_BYTES, "LDS map");
#define GAS __attribute__((address_space(1)))
#define LAS __attribute__((address_space(3)))
typedef unsigned short bf16;
typedef unsigned v4u __attribute__((ext_vector_type(4)));
typedef float f32x4 __attribute__((ext_vector_type(4)));
typedef short bf16x8 __attribute__((ext_vector_type(8)));
typedef GAS unsigned gu32;
typedef GAS unsigned long long gu64;
#define RLX_AGENT __ATOMIC_RELAXED, __HIP_MEMORY_SCOPE_AGENT
#define LDS_WAIT() asm volatile("s_waitcnt lgkmcnt(0)" ::: "memory")
#define VM_WAIT() asm volatile("s_waitcnt vmcnt(0)" ::: "memory")
__device__ __forceinline__ unsigned long long rt() { return __builtin_amdgcn_s_memrealtime(); }
__device__ __forceinline__ unsigned f2bf(float f) { unsigned u = __builtin_bit_cast(unsigned, f); return (u + 0x7fffu + ((u >> 16) & 1u)) >> 16; }
__device__ __forceinline__ unsigned pk2(float lo, float hi) { return f2bf(lo) | (f2bf(hi) << 16); }

#define XB_TMO      128
#define XB_XCNT(j)  (256  + 64 * (j))
#define XB_XSUB(j)  (1280 + 64 * (j))
#define XB_XGEN(j)  (2304 + 64 * (j))
#define XB_TOP      3328
#define XB_TOPGEN   3392
#define XCD_BAR_WORDS 3456
#define XB_SPIN_CAP (1u << 18)

__device__ __forceinline__ unsigned xb_ld(unsigned* p)              { return __hip_atomic_load(p, __ATOMIC_RELAXED, __HIP_MEMORY_SCOPE_AGENT); }
__device__ __forceinline__ unsigned xb_add(unsigned* p, unsigned v) { return __hip_atomic_fetch_add(p, v, __ATOMIC_RELAXED, __HIP_MEMORY_SCOPE_AGENT); }
__device__ __forceinline__ unsigned xb_xcc_id() { return (unsigned)__builtin_amdgcn_s_getreg((3 << 11) | 20) & 0xFu; }
#define XB_SPIN(cond, bar) do { unsigned _sp = 0; while (cond) { __builtin_amdgcn_s_sleep(1); \
    if ((++_sp & 255u) == 0u) { if (xb_ld(&(bar)[XB_TMO])) break; if (_sp > XB_SPIN_CAP) { atomicAdd(&(bar)[XB_TMO], 1u); break; } } } } while (0)

struct XcdBarrier {
    unsigned* bar; unsigned x;
    volatile LAS unsigned* st;
};

__device__ __forceinline__ XcdBarrier xcd_barrier_post(unsigned* bar, volatile LAS unsigned* st) {
    XcdBarrier b; b.bar = bar; b.x = xb_xcc_id(); b.st = st;
    if (threadIdx.x == 0) (void)xb_add(&bar[XB_XCNT(b.x)], 1u);
    return b;
}
__device__ __forceinline__ void xcd_barrier_complete(unsigned* bar, unsigned x, unsigned& nloc, unsigned& nx) {
    const unsigned G = gridDim.x * gridDim.y * gridDim.z;
    unsigned sum, cnt, mine, sp = 0u;
    for (;;) {
        sum = 0u; cnt = 0u; mine = 0u;
#pragma unroll
        for (unsigned j = 0; j < 16; ++j) { const unsigned c = xb_ld(&bar[XB_XCNT(j)]); sum += c; cnt += (c > 0u) ? 1u : 0u; mine = (j == x) ? c : mine; }
        if (sum == G) break;
        __builtin_amdgcn_s_sleep(1);
        if ((++sp & 255u) == 0u) { if (xb_ld(&bar[XB_TMO])) break; if (sp > XB_SPIN_CAP) { atomicAdd(&bar[XB_TMO], 1u); break; } }
    }
    nloc = mine > 0u ? mine : 1u; nx = cnt > 0u ? cnt : 1u;
}

__device__ __forceinline__ void xcd_barrier(const XcdBarrier& b) {
    asm volatile("s_waitcnt vmcnt(0)" ::: "memory");
    __syncthreads();
    if (threadIdx.x == 0) {
        unsigned* bar = b.bar;
        __builtin_amdgcn_s_waitcnt(0);
        unsigned nloc = b.st[0], nx = b.st[1];
        if (nloc == 0u) { xcd_barrier_complete(bar, b.x, nloc, nx); b.st[0] = nloc; b.st[1] = nx; }
        const unsigned old = xb_add(&bar[XB_XSUB(b.x)], 1u);
        const unsigned gen = old / nloc;
        if (old + 1u == (gen + 1u) * nloc) {
            __builtin_amdgcn_fence(__ATOMIC_RELEASE, "agent");
            asm volatile("s_waitcnt vmcnt(0)" ::: "memory");
            const unsigned og = xb_add(&bar[XB_TOP], 1u);
            const unsigned tg = og / nx;
            if (og + 1u == (tg + 1u) * nx) xb_add(&bar[XB_TOPGEN], 1u);
            else XB_SPIN(xb_ld(&bar[XB_TOPGEN]) == tg, bar);
            __builtin_amdgcn_fence(__ATOMIC_ACQUIRE, "agent");
            xb_add(&bar[XB_XGEN(b.x)], 1u);
            asm volatile("s_waitcnt vmcnt(0)" ::: "memory");
        } else {
            XB_SPIN(xb_ld(&bar[XB_XGEN(b.x)]) == gen, bar);
            __builtin_amdgcn_fence(__ATOMIC_ACQUIRE, "agent");
            asm volatile("s_waitcnt vmcnt(0)" ::: "memory");
        }
    }
    __syncthreads();
}

typedef unsigned u32x4_t __attribute__((ext_vector_type(4)));
typedef unsigned u32x2_t __attribute__((ext_vector_type(2)));
typedef short v4i16_t __attribute__((ext_vector_type(4)));
struct Frame {
    LAS unsigned char* lds;
    volatile LAS unsigned* MISC;
    gu32* ctl;
    int tid, lane, wave;
    int vcu, G;
    const float* in[18]; float* out; unsigned char* ws;
};
__device__ __forceinline__ float wave_sum(float v) {
#pragma unroll
    for (int o = 1; o < 64; o <<= 1) v += __shfl_xor(v, o);
    return v;
}
__device__ __forceinline__ unsigned cvtpk(float lo, float hi) { unsigned r; asm volatile("v_cvt_pk_bf16_f32 %0, %1, %2" : "=v"(r) : "v"(lo), "v"(hi)); return r; }
__device__ __forceinline__ bf16x8 cvt8(f32x4 a, f32x4 b) { u32x4_t w; w.x = cvtpk(a[0], a[1]); w.y = cvtpk(a[2], a[3]); w.z = cvtpk(b[0], b[1]); w.w = cvtpk(b[2], b[3]); return __builtin_bit_cast(bf16x8, w); }
__device__ __forceinline__ float bf2f(unsigned short b) { return __builtin_bit_cast(float, (unsigned)b << 16); }

__device__ __forceinline__ int dest_row_base(int mode, int n0) {
    if (mode == 1) { const int c0 = n0 & 255; return (n0 & ~255) + 128 * ((c0 >> 5) & 1) + 32 * (c0 >> 6); }
    if (mode == 2) { const int half = n0 >= FF ? 1 : 0, chn = n0 - half * FF; return 256 * (chn >> 7) + 128 * half + (chn & 127); }
    return n0;
}
__device__ __forceinline__ void p0_transpose_item(const float* W, int K, int N, bf16* WT, int mode, const float* kscale, LAS float* scr, int item, int lane) {
    const int nblk = N / 32, kb = item / nblk, nb = item % nblk, k0 = 64 * kb, n0 = 32 * nb;
#pragma unroll 8
    for (int i = 0; i < 32; ++i) { const int kk = 2 * i + (lane >> 5); float v = W[(size_t)(k0 + kk) * N + n0 + (lane & 31)]; if (kscale) v *= kscale[k0 + kk]; scr[kk * 33 + (lane & 31)] = v; }
    LDS_WAIT(); asm volatile("" ::: "memory");
    const int c = lane & 7, rb = dest_row_base(mode, n0);
#pragma unroll
    for (int j = 0; j < 4; ++j) { const int n = (lane >> 3) + 8 * j; const LAS float* s = scr + (8 * c) * 33 + n;
        v4u o; o.x = pk2(s[0 * 33], s[1 * 33]); o.y = pk2(s[2 * 33], s[3 * 33]); o.z = pk2(s[4 * 33], s[5 * 33]); o.w = pk2(s[6 * 33], s[7 * 33]);
        *(GAS v4u*)(WT + (size_t)(rb + n) * K + k0 + 8 * c) = o; }
    LDS_WAIT(); asm volatile("" ::: "memory");
}
__device__ __forceinline__ void rms_row_to_bf16(const float* xrow, const float* g, bf16* orow, int lane) {
    const GAS f32x4* xr = (const GAS f32x4*)xrow + lane; const GAS f32x4* gr = (const GAS f32x4*)g + lane;
    f32x4 v[4]; float s = 0.f;
#pragma unroll
    for (int j = 0; j < 4; ++j) { v[j] = xr[64 * j]; s += (v[j].x * v[j].x + v[j].y * v[j].y) + (v[j].z * v[j].z + v[j].w * v[j].w); }
    const float r = 1.f / sqrtf(wave_sum(s) * (1.f / DM) + EPS);
    GAS unsigned long long* o8 = (GAS unsigned long long*)orow + lane;
#pragma unroll
    for (int j = 0; j < 4; ++j) { const f32x4 gg = gr[64 * j]; o8[64 * j] = (unsigned long long)pk2(v[j].x * r * gg.x, v[j].y * r * gg.y) | ((unsigned long long)pk2(v[j].z * r * gg.z, v[j].w * r * gg.w) << 32); }
}
__device__ __forceinline__ void p0_prologue(Frame& F) {
    LAS float* scr = (LAS float*)(F.lds + RING_OFF + F.wave * 16384);
    const int gw = F.vcu * NWAVES + F.wave, NGW = F.G * NWAVES;
    constexpr int I_IN = (DM / 64) * (PJ / 32), I_OUT = (DM / 64) * (DM / 32), I_UP = (DM / 64) * (FF2 / 32), I_DN = (FF / 64) * (DM / 32), I_PL = (128 / 64) * (128 / 32);
    constexpr int NITEMS = I_IN + I_OUT + I_UP + I_DN + 4 * I_PL;
    bf16* ws16 = (bf16*)F.ws;
    for (int it = gw; it < NITEMS; it += NGW) {
        int r = it;
        if (r < I_IN) { p0_transpose_item(F.in[7], DM, PJ, (bf16*)(F.ws + WS_WIN), 1, nullptr, scr, r, F.lane); continue; } r -= I_IN;
        if (r < I_OUT) { p0_transpose_item(F.in[12], DM, DM, (bf16*)(F.ws + WS_WOUT), 0, nullptr, scr, r, F.lane); continue; } r -= I_OUT;
        if (r < I_UP) { p0_transpose_item(F.in[14], DM, FF2, (bf16*)(F.ws + WS_WUP), 2, F.in[13], scr, r, F.lane); continue; } r -= I_UP;
        if (r < I_DN) { p0_transpose_item(F.in[17], FF, DM, (bf16*)(F.ws + WS_WDN), 0, nullptr, scr, r, F.lane); continue; } r -= I_DN;
        { const int g = r / I_PL; p0_transpose_item(F.in[10] + (size_t)g * 128 * 128, 128, 128, (bf16*)(F.ws + WS_WPOOL) + (size_t)g * 128 * 128, 0, nullptr, scr, r % I_PL, F.lane); }
    }
    (void)ws16;
    for (int m = gw; m < M; m += NGW) rms_row_to_bf16(m < MP ? F.in[0] + (size_t)m * DM : F.in[1] + (size_t)(m - MP) * DM, F.in[6], (bf16*)(F.ws + WS_XN) + (size_t)m * DM, F.lane);
    { const int gt = F.vcu * (NWAVES * 64) + F.tid, NT = F.G * NWAVES * 64;
      for (int i = gt; i < DB * 11 * 128; i += NT) { const int b = i / (11 * 128), rem = i % (11 * 128), j = rem >> 7, c4 = rem & 127;
          *(f32x4*)(F.out + O_PS + ((size_t)b * 15 + j) * 512 + 4 * c4) = *(const f32x4*)(F.in[4] + ((size_t)b * 15 + 4 + j) * 512 + 4 * c4); } }
}

constexpr int VROW = 160;
constexpr int VTILE = 32 * VROW;
struct AState { float m, l; f32x4 o[4]; };
template <bool SAMPLE> struct KVRaw;
template <> struct KVRaw<false> { bf16x8 k[2][2]; bf16x8 v[4]; };
template <> struct KVRaw<true> { f32x4 k[2][2][2]; f32x4 v[8]; };
template <bool SAMPLE> __device__ __forceinline__ const void* kv_row(const void* base, const void* newb, int j, int rs, int cr, int b, int h) {
    int a = (j << rs) + cr;
    if (!SAMPLE) { a = a > SEQ - 1 ? SEQ - 1 : a; return (const bf16*)base + ((size_t)(b * SEQ + a) * AW + h * 64); }
    a = a > 2048 + DS - 1 ? 2048 + DS - 1 : a;
    return a < 2048 ? (const float*)base + ((size_t)(b * 2048 + a) * AW + h * 64) : (const float*)newb + ((size_t)(b * DS + a - 2048) * AW + h * 64);
}
template <bool SAMPLE> __device__ __forceinline__ void kv_load(KVRaw<SAMPLE>& R, const void* Kb, const void* Kn, const void* Vb, const void* Vn, int kb, int rs, int cr, int b, int h, int lane) {
    const int g = lane >> 4, c15 = lane & 15;
#pragma unroll
    for (int t = 0; t < 2; ++t) { const void* p = kv_row<SAMPLE>(Kb, Kn, 16 * (kb + t) + c15, rs, cr, b, h);
#pragma unroll
        for (int s = 0; s < 2; ++s) {
            if constexpr (!SAMPLE) R.k[t][s] = *(const bf16x8*)((const bf16*)p + 32 * s + 8 * g);
            else { R.k[t][s][0] = *(const f32x4*)((const float*)p + 32 * s + 8 * g); R.k[t][s][1] = *(const f32x4*)((const float*)p + 32 * s + 8 * g + 4); } } }
    { const void* p = kv_row<SAMPLE>(Vb, Vn, 16 * kb + (lane >> 1), rs, cr, b, h); const int hh = lane & 1;
        if constexpr (!SAMPLE) {
#pragma unroll
            for (int i = 0; i < 4; ++i) R.v[i] = *(const bf16x8*)((const bf16*)p + 32 * hh + 8 * i);
        } else {
#pragma unroll
            for (int i = 0; i < 8; ++i) R.v[i] = *(const f32x4*)((const float*)p + 32 * hh + 4 * i);
        } }
}
template <bool SAMPLE> __device__ __forceinline__ void attn_step(AState& st, const KVRaw<SAMPLE>& R, const bf16x8 (&qf)[2], int kb, int qsub, float sl2r, LAS unsigned char* vl, int lane) {
    const int g = lane >> 4;
    { LAS unsigned char* wp = vl + (lane >> 1) * VROW + (lane & 1) * 64;
#pragma unroll
        for (int i = 0; i < 4; ++i) { bf16x8 x; if constexpr (!SAMPLE) x = R.v[i]; else x = cvt8(R.v[2 * i], R.v[2 * i + 1]); *(LAS bf16x8*)(wp + 16 * i) = x; } }
    f32x4 s[2];
#pragma unroll
    for (int t = 0; t < 2; ++t) { bf16x8 k0, k1; if constexpr (!SAMPLE) { k0 = R.k[t][0]; k1 = R.k[t][1]; } else { k0 = cvt8(R.k[t][0][0], R.k[t][0][1]); k1 = cvt8(R.k[t][1][0], R.k[t][1][1]); }
        s[t] = __builtin_amdgcn_mfma_f32_16x16x32_bf16(k0, qf[0], (f32x4){0.f, 0.f, 0.f, 0.f}, 0, 0, 0);
        s[t] = __builtin_amdgcn_mfma_f32_16x16x32_bf16(k1, qf[1], s[t], 0, 0, 0); }
    float mx = -INFINITY;
#pragma unroll
    for (int t = 0; t < 2; ++t)
#pragma unroll
        for (int i = 0; i < 4; ++i) { const int d = qsub - (16 * (kb + t) + 4 * g + i); const float x = ((unsigned)d <= 128u) ? s[t][i] - sl2r * (float)d : -INFINITY; s[t][i] = x; mx = fmaxf(mx, x); }
    mx = fmaxf(mx, __shfl_xor(mx, 16)); mx = fmaxf(mx, __shfl_xor(mx, 32));
    const float mn = fmaxf(st.m, mx), alpha = __builtin_amdgcn_exp2f(st.m - mn); st.m = mn;
    float ps = 0.f;
#pragma unroll
    for (int t = 0; t < 2; ++t)
#pragma unroll
        for (int i = 0; i < 4; ++i) { const float p = __builtin_amdgcn_exp2f(s[t][i] - mn); s[t][i] = p; ps += p; }
    st.l = st.l * alpha + ps;
#pragma unroll
    for (int c = 0; c < 4; ++c) st.o[c] = st.o[c] * alpha;
    const bf16x8 pf = cvt8(s[0], s[1]);
    const LAS unsigned char* rp = vl + (4 * g + ((lane & 15) >> 2)) * VROW + (lane & 3) * 8;
#pragma unroll
    for (int c = 0; c < 4; ++c) {
        const v4i16_t a = __builtin_amdgcn_ds_read_tr16_b64_v4i16((LAS v4i16_t*)(rp + 32 * c));
        const v4i16_t bq = __builtin_amdgcn_ds_read_tr16_b64_v4i16((LAS v4i16_t*)(rp + 16 * VROW + 32 * c));
        const bf16x8 vf = (bf16x8){a[0], a[1], a[2], a[3], bq[0], bq[1], bq[2], bq[3]};
        st.o[c] = __builtin_amdgcn_mfma_f32_16x16x32_bf16(vf, pf, st.o[c], 0, 0, 0);
    }
}
template <bool SAMPLE> __device__ __forceinline__ void attn_list(AState& st, const bf16x8 (&qf)[2], int rs, int cr, int kb_lo, int kb_hi, int qsub, float sl2r,
                                                                 const void* Kb, const void* Kn, const void* Vb, const void* Vn, int b, int h, LAS unsigned char* vl, int lane) {
    KVRaw<SAMPLE> cur, nxt;
    kv_load<SAMPLE>(cur, Kb, Kn, Vb, Vn, kb_lo, rs, cr, b, h, lane);
    for (int kb = kb_lo; kb <= kb_hi; kb += 2) {
        kv_load<SAMPLE>(nxt, Kb, Kn, Vb, Vn, kb + 2, rs, cr, b, h, lane);
        attn_step<SAMPLE>(st, cur, qf, kb, qsub, sl2r, vl, lane);
        cur = nxt;
    }
}
__device__ __forceinline__ void attn_init(AState& st) { st.m = -1e30f; st.l = 0.f;
#pragma unroll
    for (int c = 0; c < 4; ++c) st.o[c] = (f32x4){0.f, 0.f, 0.f, 0.f}; }
__device__ __forceinline__ void attn_store(const AState& st, bf16* orow  , int lane) {
    float l = st.l; l += __shfl_xor(l, 16); l += __shfl_xor(l, 32);
    const float il = 1.0f / l; const int g = lane >> 4;
    if (orow) {
#pragma unroll
        for (int c = 0; c < 4; ++c) { u32x2_t w; w.x = cvtpk(st.o[c][0] * il, st.o[c][1] * il); w.y = cvtpk(st.o[c][2] * il, st.o[c][3] * il); *(u32x2_t*)(orow + 16 * c + 4 * g) = w; } }
}
__device__ __forceinline__ void attn_prompt_task(Frame& F, int T, LAS unsigned char* vl) {
    const int lane = F.lane, c15 = lane & 15, g = lane >> 4;
    const int bh = T >> 7, b = bh >> 3, h = bh & 7, rem = T & 127, jb = rem >> 4, c16 = rem & 15;
    const bf16* Qb = (const bf16*)(F.ws + WS_Q); const bf16* Kb = (const bf16*)(F.ws + WS_Q + QKVU_STRIDE); const bf16* Vb = (const bf16*)(F.ws + WS_Q + 2 * QKVU_STRIDE);
    const int qpos = 256 * jb + 16 * c15 + c16;
    bf16x8 qf[2];
    { const bf16* qp = Qb + ((size_t)(b * SEQ + qpos) * AW + h * 64 + 8 * g); qf[0] = *(const bf16x8*)qp; qf[1] = *(const bf16x8*)(qp + 32); }
    AState st; attn_init(st);
    const float slope2 = __builtin_amdgcn_exp2f(-(float)(h + 1)) * 1.4426950408889634f;
#pragma unroll 1
    for (int rs = 0; rs <= 4; rs += 2) {
        const int cr = c16 & ((1 << rs) - 1), q0 = (256 * jb + c16) >> rs, qstep = 16 >> rs;
        int kb_lo = (q0 - 128) >> 4; kb_lo = kb_lo < 0 ? 0 : kb_lo; const int kb_hi = (q0 + 15 * qstep) >> 4;
        attn_list<false>(st, qf, rs, cr, __builtin_amdgcn_readfirstlane(kb_lo), __builtin_amdgcn_readfirstlane(kb_hi), q0 + qstep * c15, slope2 * (float)(1 << rs), Kb, nullptr, Vb, nullptr, b, h, vl, lane);
    }
    attn_store(st, (bf16*)(F.ws + WS_MIX) + ((size_t)(b * SEQ + qpos) * DM + h * 64), lane);
}
__device__ __forceinline__ void attn_sample_task(Frame& F, int T, LAS unsigned char* vl) {
    const int lane = F.lane, c15 = lane & 15, g = lane >> 4;
    const int b = T >> 4, h = (T >> 1) & 7, qp = T & 1;
    const bf16* Qb = (const bf16*)(F.ws + WS_Q);
    const float* Kc = F.in[2]; const float* Vc = F.in[3]; const float* Kn = F.out + O_KS; const float* Vn = F.out + O_VS;
    const int nq = 2 * qp + (c15 & 1);
    bf16x8 qf[2];
    { const bf16* qptr = Qb + ((size_t)(MP + b * DS + nq) * AW + h * 64 + 8 * g); qf[0] = *(const bf16x8*)qptr; qf[1] = *(const bf16x8*)(qptr + 32); }
    AState st; attn_init(st);
    const float slope2 = __builtin_amdgcn_exp2f(-(float)(h + 1)) * 1.4426950408889634f;
    const int NEGQ = -(1 << 20);
    { const int q0 = 2048 + 2 * qp; attn_list<true>(st, qf, 0, 0, (q0 - 128) >> 4, (q0 + 1) >> 4, c15 < 2 ? q0 + c15 : NEGQ, slope2, Kc, Kn, Vc, Vn, b, h, vl, lane); }
#pragma unroll 1
    for (int rs = 2; rs <= 4; rs += 2)
#pragma unroll 1
        for (int i = 0; i < 2; ++i) { const int n = 2 * qp + i, q0 = 2048 >> rs;
            attn_list<true>(st, qf, rs, n, (q0 - 128) >> 4, q0 >> 4, c15 == i ? q0 : NEGQ, slope2 * (float)(1 << rs), Kc, Kn, Vc, Vn, b, h, vl, lane); }
    attn_store(st, c15 < 2 ? (bf16*)(F.ws + WS_MIX) + ((size_t)(MP + b * DS + 2 * qp + c15) * DM + h * 64) : nullptr, lane);
}
__device__ __forceinline__ void pool_tile(Frame& F, int T) {
    const int lane = F.lane, c15 = lane & 15, g = lane >> 4;
    const int row = T * 16 + c15; const bool sample = row >= MP;
    const bf16* U = (const bf16*)(F.ws + WS_Q + 3 * QKVU_STRIDE); const bf16* WP = (const bf16*)(F.ws + WS_WPOOL); const float* SP = F.in[4]; const float* PS = F.in[11];
    bf16* MIX = (bf16*)(F.ws + WS_MIX);
    const int t = sample ? ((row - MP) & 3) : (row & (SEQ - 1));
    const int bs = sample ? (row - MP) >> 2 : 0;
#pragma unroll 1
    for (int gi = 0; gi < 4; ++gi) {
        const int w = 2 << gi;
        f32x4 acc[8];
#pragma unroll
        for (int nt = 0; nt < 8; ++nt) acc[nt] = (f32x4){0.f, 0.f, 0.f, 0.f};
#pragma unroll 1
        for (int ks = 0; ks < 4; ++ks) {
            const int ch = 128 * gi + 32 * ks + 8 * g;
            float sum[8], cur[8];
#pragma unroll
            for (int e = 0; e < 8; ++e) { sum[e] = 0.f; cur[e] = 0.f; }
            for (int i = 0; i < w; ++i) {
                float v[8];
                if (t - i >= 0) { const bf16x8 x = *(const bf16x8*)(U + (size_t)(row - i) * AW + ch);
#pragma unroll
                    for (int e = 0; e < 8; ++e) v[e] = bf2f((unsigned short)x[e]); }
                else if (sample) { const float* sp = SP + ((size_t)bs * 15 + 15 + t - i) * 512 + ch; const f32x4 x0 = *(const f32x4*)sp, x1 = *(const f32x4*)(sp + 4);
                    v[0] = x0[0]; v[1] = x0[1]; v[2] = x0[2]; v[3] = x0[3]; v[4] = x1[0]; v[5] = x1[1]; v[6] = x1[2]; v[7] = x1[3]; }
                else {
#pragma unroll
                    for (int e = 0; e < 8; ++e) v[e] = 0.f; }
#pragma unroll
                for (int e = 0; e < 8; ++e) { sum[e] += v[e]; if (i == 0) cur[e] = v[e]; }
            }
            const float cnt = sample ? (float)w : (float)(w < t + 1 ? w : t + 1), ic = 1.0f / cnt;
            f32x4 d0, d1;
#pragma unroll
            for (int e = 0; e < 4; ++e) { d0[e] = sum[e] * ic - cur[e]; d1[e] = sum[4 + e] * ic - cur[4 + e]; }
            const bf16x8 df = cvt8(d0, d1);
#pragma unroll
            for (int nt = 0; nt < 8; ++nt) { const bf16x8 wf = *(const bf16x8*)(WP + ((size_t)(gi * 128 + 16 * nt + c15) * 128 + 32 * ks + 8 * g));
                acc[nt] = __builtin_amdgcn_mfma_f32_16x16x32_bf16(wf, df, acc[nt], 0, 0, 0); }
        }
#pragma unroll
        for (int nt = 0; nt < 8; ++nt) { const int col = 128 * gi + 16 * nt + 4 * g; const f32x4 sc = *(const f32x4*)(PS + col); const f32x4 o = acc[nt] * sc;
            u32x2_t wv; wv.x = cvtpk(o[0], o[1]); wv.y = cvtpk(o[2], o[3]); *(u32x2_t*)(MIX + (size_t)row * DM + 512 + col) = wv; }
    }
}
__device__ __forceinline__ void p2_attn_pool(Frame& F) {
    const int gw = F.vcu * NWAVES + F.wave;
    const int NGW = F.G * NWAVES;
    LAS unsigned char* vl = F.lds + RING_OFF + F.wave * VTILE;
#pragma unroll 1
    for (int pass = 0; pass < 2; ++pass) {
        if ((pass ^ F.wave) & 1) { for (int T = gw; T < DB * NH * 2; T += NGW) attn_sample_task(F, T, vl); }
        else { for (int T0 = gw * 8; T0 < NB * NH * 128; T0 += NGW * 8) { for (int k = 0; k < 8; ++k) attn_prompt_task(F, T0 + k, vl); } }
    }
    for (int T = gw; T < M / 16; T += NGW) pool_tile(F, T);
}
__device__ __forceinline__ void p5_fix_rows(Frame& F) {
    const float* halo = (const float*)(F.ws + WS_HALO); const float* cw = F.in[15]; const float* cbp = F.in[16]; bf16* ACT = (bf16*)(F.ws + WS_ACT);
    for (int it = blockIdx.x; it < NPANEL_P * 2; it += F.G) {
        const int pm = it >> 1, e = it & 1; const bool first = (pm & 7) == 0;
        for (int ch = F.tid; ch < FF; ch += NWAVES * 64) {
            float cv[2];
#pragma unroll
            for (int bj = 0; bj < 2; ++bj) { const int col = bj * FF + ch;
                const float um2 = first ? 0.f : halo[(size_t)((pm - 1) * 4 + 2) * FF2 + col], um1 = first ? 0.f : halo[(size_t)((pm - 1) * 4 + 3) * FF2 + col];
                const float u0 = halo[(size_t)(pm * 4 + 0) * FF2 + col], u1 = halo[(size_t)(pm * 4 + 1) * FF2 + col];
                const float w0 = cw[col], w1 = cw[FF2 + col], w2 = cw[2 * FF2 + col], cb = cbp[col];
                cv[bj] = e == 0 ? cb + w0 * um2 + w1 * um1 + w2 * u0 : cb + w0 * um1 + w1 * u0 + w2 * u1; }
            ACT[(size_t)(pm * 256 + e) * FF + ch] = (bf16)f2bf(pg8::silu_mul(cv[0], cv[1]));
        }
    }
}

struct Args { const float* in[18]; float* out; unsigned char* ws; int ph_lo, ph_hi, li, pad; };
__global__ void __launch_bounds__(NWAVES * 64, 2) mk_fwd(Args args) {
    extern __shared__ __attribute__((aligned(16))) unsigned char lds[];
    Frame F;
    F.lds = (LAS unsigned char*)lds;
    F.MISC = (volatile LAS unsigned*)(F.lds + MISC_OFF);
    F.tid = threadIdx.x; F.lane = F.tid & 63; F.wave = __builtin_amdgcn_readfirstlane(F.tid >> 6);
    F.G = gridDim.x; { const int bx = blockIdx.x; F.vcu = (F.G % 8 == 0) ? (bx % 8) * (F.G / 8) + bx / 8 : bx; }
    unsigned char* ws = args.ws; F.ws = ws; F.out = args.out;
    F.ctl = (gu32*)(ws + WS_CTL);
#pragma unroll
    for (int i = 0; i < 18; ++i) F.in[i] = args.in[i];
    for (int u = F.tid; u < (LDS_BYTES - LDSCTL_OFF) / 4; u += NWAVES * 64) ((LAS unsigned*)(F.lds + LDSCTL_OFF))[u] = 0u;
    __syncthreads();
    XcdBarrier bar; bar.bar = (unsigned*)(F.ctl + CW_BAR); bar.x = 0; bar.st = nullptr;
    if (N_LAUNCHES != PER_PHASE) bar = xcd_barrier_post((unsigned*)(F.ctl + CW_BAR), F.MISC + 8);
#define GRID_BAR(seam) do { if (N_LAUNCHES == PER_PHASE) { if (F.tid == 0) __hip_atomic_store(F.ctl + CW_TMO, 0xBADBA0u | (unsigned)(seam), RLX_AGENT); } else { xcd_barrier(bar); } } while (0)
    const int lo = args.ph_lo, hi = args.ph_hi;
#ifndef PH_MASK
#define PH_MASK 127
#endif
#define IN(k) ((((PH_MASK) >> (k)) & 1) && lo <= (k) && (k) < hi)
#define BOTH(k) (IN(k) && IN((k) + 1))
    bf16* const XN = (bf16*)(ws + WS_XN); bf16* const QB = (bf16*)(ws + WS_Q); bf16* const MIX = (bf16*)(ws + WS_MIX); bf16* const HB = (bf16*)(ws + WS_HB); bf16* const ACT = (bf16*)(ws + WS_ACT);

    if (IN(0)) { p0_prologue(F); if (BOTH(0)) GRID_BAR(0); }

    if (IN(1)) {
        pg8::Gemm g{XN, (const bf16*)(ws + WS_WIN), M, PJ, DM}; pg8::StaticOrder S; S.init(M, PJ, F.G, (int)blockIdx.x);
        pg8::EpiInProj E{QB, QKVU_STRIDE / 2, F.out, F.in[8], F.in[9]};
        pg8::gemm_phase<pg8::EpiInProj, pg8::StaticOrder, true, true>(F.lds + RING_OFF, g, S, E);
        if (BOTH(1)) GRID_BAR(1);
    }

    if (IN(2)) { p2_attn_pool(F); if (BOTH(2)) GRID_BAR(2); }

    if (IN(3)) {
        pg8::Gemm g{MIX, (const bf16*)(ws + WS_WOUT), M, DM, DM}; pg8::StaticOrder S; S.init(M, DM, F.G, (int)blockIdx.x);
        pg8::EpiOutProj E{F.in[0], F.in[1], F.out + O_Y, HB, (float*)(ws + WS_SSP), (PG8_LAS float*)(F.lds + TAB_OFF)};
        pg8::gemm_phase<pg8::EpiOutProj, pg8::StaticOrder, true, true>(F.lds + RING_OFF, g, S, E);
        if (BOTH(3)) GRID_BAR(3);
    }

    if (IN(4)) {
        pg8::Gemm g{HB, (const bf16*)(ws + WS_WUP), M, FF2, DM}; pg8::StaticOrder S; S.init(M, FF2, F.G, (int)blockIdx.x);
        pg8::EpiUp E{ACT, (const float*)(ws + WS_SSP), (float*)(ws + WS_HALO), F.out, F.in[15], F.in[16], F.in[5], (PG8_LAS float*)(F.lds + TAB_OFF)};
        pg8::gemm_phase<pg8::EpiUp, pg8::StaticOrder, true, true>(F.lds + RING_OFF, g, S, E);
        if (BOTH(4)) GRID_BAR(4);
    }

    if (IN(5)) { p5_fix_rows(F); if (BOTH(5)) GRID_BAR(5); }

    if (IN(6)) {
        pg8::Gemm g{ACT, (const bf16*)(ws + WS_WDN), M, DM, FF}; pg8::StaticOrder S; S.init(M, DM, F.G, (int)blockIdx.x);
        pg8::EpiDown E{F.out + O_Y};
        pg8::gemm_phase<pg8::EpiDown, pg8::StaticOrder, true, true>(F.lds + RING_OFF, g, S, E);
    }
#undef IN
#undef BOTH
}

extern "C" void kernel_launch(void* const* d_in, const int* in_sizes, int n_in, void* d_out, int out_size, void* d_ws, size_t ws_size, hipStream_t stream) {
    static int grid = 0;
    if (grid == 0) {
        if (n_in != 18 || in_sizes[0] != MP * DM || out_size != (int)O_END || ws_size < WS_END) { fprintf(stderr, "kernel_launch: unexpected shapes: n_in %d, in0 %d, out %d, ws %zu (need %zu); nothing launched\n", n_in, n_in > 0 ? in_sizes[0] : -1, out_size, ws_size, (size_t)WS_END); grid = -1; return; }
        int dev = 0, cus = 0, per_cu = 0;
        if (hipGetDevice(&dev) != hipSuccess || hipDeviceGetAttribute(&cus, hipDeviceAttributeMultiprocessorCount, dev) != hipSuccess) { fprintf(stderr, "kernel_launch: hipGetDevice / hipDeviceGetAttribute failed\n"); grid = -1; return; }
        if (hipFuncSetAttribute((const void*)mk_fwd, hipFuncAttributeMaxDynamicSharedMemorySize, LDS_BYTES) != hipSuccess) { fprintf(stderr, "kernel_launch: hipFuncSetAttribute failed\n"); grid = -1; return; }
        if (hipOccupancyMaxActiveBlocksPerMultiprocessor(&per_cu, (const void*)mk_fwd, NWAVES * 64, LDS_BYTES) != hipSuccess || per_cu < 1)
            fprintf(stderr, "kernel_launch: note: occupancy query reports %d workgroups per CU\n", per_cu);
        (void)hipGetLastError();
        grid = cus;
    }
    if (grid < 0) return;
    if (hipMemsetAsync((char*)d_ws + WS_CTL, 0, CTL_ZERO_BYTES, stream) != hipSuccess) { fprintf(stderr, "kernel_launch: hipMemsetAsync failed\n"); return; }
    Args a{};
    for (int i = 0; i < 18; ++i) a.in[i] = (const float*)d_in[i];
    a.out = (float*)d_out; a.ws = (unsigned char*)d_ws;
    static_assert(N_LAUNCHES == 1 || N_LAUNCHES == PER_PHASE, "-DMK_N_LAUNCHES must be 1 or 7");
    for (int li = 0; li < N_LAUNCHES; ++li) {
        a.ph_lo = (N_LAUNCHES == PER_PHASE) ? li : 0; a.ph_hi = (N_LAUNCHES == PER_PHASE) ? li + 1 : PER_PHASE; a.li = li;
        hipLaunchKernelGGL(mk_fwd, dim3(grid), dim3(NWAVES * 64), LDS_BYTES, stream, a);
        const hipError_t le = hipPeekAtLastError();
        if (le != hipSuccess) { fprintf(stderr, "kernel_launch: launch %d failed: %s\n", li, hipGetErrorName(le)); break; }
    }
}
```

```cpp
#include <hip/hip_runtime.h>
#include <hip/hip_bf16.h>
#include <cstdio>
#include <cstdint>
#ifndef MK_N_LAUNCHES
#define MK_N_LAUNCHES 1
#endif
constexpr int DM = 1024, NB = 16, SEQ = 2048, DB = 128, DS = 4;
constexpr int NH = 8, AW = 512, PJ = 2048, FF = 2816, FF2 = 5632;
constexpr int MP = NB * SEQ, MS = DB * DS, M = MP + MS;
constexpr int NPANEL = M / 256, NPANEL_P = MP / 256;
constexpr float EPS = 1e-6f;
constexpr float QSCALE = 0.125f * 1.4426950408889634f;
constexpr size_t O_Y = 0, O_KP = 34078720, O_VP = 50855936, O_PP = 67633152, O_FP = 67756032, O_KS = 67936256, O_VS = 68198400, O_PS = 68460544, O_FS = 69443584, O_END = 70885376;
namespace pg8 {
#define PG8_LAS __attribute__((address_space(3)))
typedef unsigned short bf16_t;
typedef short bf16x8 __attribute__((ext_vector_type(8)));
typedef float f32x4 __attribute__((ext_vector_type(4)));
typedef unsigned u32x4 __attribute__((ext_vector_type(4)));
constexpr int BM = 256, BK = 64, HALF = 128, HTB = HALF * BK * 2  , STAGE_BYTES = 8 * HTB, NXCD = 8, WGM = 8;

__host__ __device__ __forceinline__ int lds_byte(int r, int c) { const int st = (r >> 4) * 2 + (c >> 5), rr = r & 15, cc = c & 31, ob = rr * 64 + cc * 2; return st * 1024 + (ob ^ (((ob >> 9) & 1) << 5)); }
__host__ __device__ __forceinline__ void stage_rc(int b, int& R, int& C) { const int st = b / 1024, sb = b % 1024, swz = sb ^ (((sb >> 9) & 1) << 5); R = (st >> 1) * 16 + swz / 64; C = (st & 1) * 32 + (swz % 64) / 2; }
__host__ __device__ __forceinline__ int perm32(int rho) { const int n = rho >> 4, i = rho & 15; return 8 * (i >> 2) + 4 * n + (i & 3); }

struct Unit { int pm, pn; };
struct Gemm { const bf16_t* A; const bf16_t* Bt; int M, N, K; };

struct StaticOrder {
    int nM, nN, nwg, G, c;
    __host__ __device__ void init(int M, int N, int G_, int c_) { nM = M / BM; nN = N / BM; nwg = nM * nN; G = G_; c = c_; }
    __host__ __device__ bool next(int i, Unit& u) const {
        const long L = (long)i * G + c; if (L >= nwg) return false;
        int wgid = (int)L; { const int q = nwg / NXCD, r = nwg % NXCD, xcd = wgid % NXCD, off = wgid / NXCD; wgid = (xcd < r ? xcd * (q + 1) : r * (q + 1) + (xcd - r) * q) + off; }
        const int nig = WGM * nN, gid = wgid / nig, fm = gid * WGM, gsz = (nM - fm) < WGM ? (nM - fm) : WGM;
        u.pm = fm + ((wgid % nig) % gsz); u.pn = (wgid % nig) / gsz; return true;
    }
    __device__ __forceinline__ void a_ready(const Unit&) const {}
    __device__ __forceinline__ void done(const Unit&) const {}
};

typedef float f32x2c __attribute__((ext_vector_type(2))); typedef __bf16 bf16x2c __attribute__((ext_vector_type(2)));
__device__ __forceinline__ unsigned cvt_pk_bf16(float lo, float hi) { const f32x2c v = {lo, hi}; const bf16x2c b = __builtin_convertvector(v, bf16x2c); return __builtin_bit_cast(unsigned, b); }
typedef float f32x2 __attribute__((ext_vector_type(2)));
typedef unsigned u32x2 __attribute__((ext_vector_type(2)));
__device__ __forceinline__ float dpp_ror1(float v) { return __builtin_bit_cast(float, __builtin_amdgcn_update_dpp(0, __builtin_bit_cast(int, v), 0x121, 0xf, 0xf, false)); }
__device__ __forceinline__ float dpp_ror2(float v) { return __builtin_bit_cast(float, __builtin_amdgcn_update_dpp(0, __builtin_bit_cast(int, v), 0x122, 0xf, 0xf, false)); }
__device__ __forceinline__ f32x4 ror1v(f32x4 v) { return (f32x4){dpp_ror1(v[0]), dpp_ror1(v[1]), dpp_ror1(v[2]), dpp_ror1(v[3])}; }
__device__ __forceinline__ f32x4 ror2v(f32x4 v) { return (f32x4){dpp_ror2(v[0]), dpp_ror2(v[1]), dpp_ror2(v[2]), dpp_ror2(v[3])}; }
__device__ __forceinline__ float silu_mul(float g, float v) { return g * v * __builtin_amdgcn_rcpf(1.0f + __builtin_amdgcn_exp2f(-1.4426950408889634f * g)); }

struct EpiInProj {
    static constexpr bool PERM = true, AFTER_DRAIN = false;
    bf16_t* QKVU; size_t tstride; float* out; const float* gq; const float* gk;
    __device__ __forceinline__ void operator()(f32x4 (&acc)[2][2][4][2], const Unit& u, int wr, int wc, int fr, int fq) const {
        const int type = u.pn >> 1, half = u.pn & 1;
        const int cbase = half * 256 + wc * 64 + 8 * fq;
        bf16_t* dst = QKVU + (size_t)type * tstride;
        f32x4 gv[2][2];
        if (type < 2) { const float* gs = (type == 0 ? gq : gk) + (half * 4 + wc) * 64 + 8 * fq; const float qs = type == 0 ? QSCALE : 1.0f;
#pragma unroll
            for (int bj = 0; bj < 2; ++bj)
#pragma unroll
                for (int n = 0; n < 2; ++n) gv[bj][n] = *(const f32x4*)(gs + 32 * bj + 4 * n) * qs; }
#pragma unroll
        for (int ai = 0; ai < 2; ++ai)
#pragma unroll
            for (int m = 0; m < 4; ++m) {
                const int row = u.pm * BM + ai * HALF + wr * 64 + m * 16 + fr;
                f32x4 v[2][2];
#pragma unroll
                for (int bj = 0; bj < 2; ++bj)
#pragma unroll
                    for (int n = 0; n < 2; ++n) v[bj][n] = acc[ai][bj][m][n];
                if (type < 2) {
                    float ss = 0.f;
#pragma unroll
                    for (int bj = 0; bj < 2; ++bj)
#pragma unroll
                        for (int n = 0; n < 2; ++n) { const f32x4 x = v[bj][n]; ss += (x[0] * x[0] + x[1] * x[1]) + (x[2] * x[2] + x[3] * x[3]); }
                    ss += __shfl_xor(ss, 16); ss += __shfl_xor(ss, 32);
                    const float r = 1.0f / sqrtf(ss * (1.0f / 64.0f) + EPS);
#pragma unroll
                    for (int bj = 0; bj < 2; ++bj)
#pragma unroll
                        for (int n = 0; n < 2; ++n) v[bj][n] = v[bj][n] * r * gv[bj][n];
                }
                bf16_t* rowp = dst + (size_t)row * 512 + cbase;
#pragma unroll
                for (int bj = 0; bj < 2; ++bj) { u32x4 w; w.x = cvt_pk_bf16(v[bj][0][0], v[bj][0][1]); w.y = cvt_pk_bf16(v[bj][0][2], v[bj][0][3]); w.z = cvt_pk_bf16(v[bj][1][0], v[bj][1][1]); w.w = cvt_pk_bf16(v[bj][1][2], v[bj][1][3]);
                    *(u32x4*)(rowp + 32 * bj) = w; }
                if (type == 1 || type == 2) {
                    float* o = out + (type == 1 ? O_KP : O_VP) + (size_t)row * 512 + cbase;
#pragma unroll
                    for (int bj = 0; bj < 2; ++bj) { __builtin_nontemporal_store(v[bj][0], (f32x4*)(o + 32 * bj)); __builtin_nontemporal_store(v[bj][1], (f32x4*)(o + 32 * bj + 4)); }
                } else if (type == 3) {
                    float* o = nullptr;
                    { const int t = row & (SEQ - 1); if (t >= SEQ - 15) o = out + O_PP + ((size_t)(row >> 11) * 15 + (t - (SEQ - 15))) * 512 + cbase; }
                    if (o) {
#pragma unroll
                        for (int bj = 0; bj < 2; ++bj) { *(f32x4*)(o + 32 * bj) = v[bj][0]; *(f32x4*)(o + 32 * bj + 4) = v[bj][1]; } }
                }
            }
    }
};

struct EpiOutProj {
    static constexpr bool PERM = true, AFTER_DRAIN = false;
    const float* xp; bf16_t* HB; float* ssp; PG8_LAS float* tab;
    __device__ __forceinline__ void operator()(f32x4 (&acc)[2][2][4][2], const Unit& u, int wr, int wc, int fr, int fq) const {
        const size_t off0 = (size_t)(u.pm * BM + wr * 64 + fr) * DM + u.pn * BM + wc * 32 + 8 * fq;
#pragma unroll
        for (int ai = 0; ai < 2; ++ai) {
            f32x4 xv[4][2][2];
#pragma unroll
            for (int m = 0; m < 4; ++m)
#pragma unroll
                for (int bj = 0; bj < 2; ++bj) { const float* xr = xp + off0 + (size_t)(ai * HALF + m * 16) * DM + bj * HALF; xv[m][bj][0] = __builtin_nontemporal_load((const f32x4*)xr); xv[m][bj][1] = __builtin_nontemporal_load((const f32x4*)(xr + 4)); }
            __builtin_amdgcn_sched_barrier(0);
#pragma unroll
            for (int m = 0; m < 4; ++m) {
                const int lrow = ai * HALF + wr * 64 + m * 16 + fr;
                float part = 0.f;
#pragma unroll
                for (int bj = 0; bj < 2; ++bj) {
                    const f32x4 h0 = xv[m][bj][0] + acc[ai][bj][m][0], h1 = xv[m][bj][1] + acc[ai][bj][m][1];
                    u32x4 w; w.x = cvt_pk_bf16(h0[0], h0[1]); w.y = cvt_pk_bf16(h0[2], h0[3]); w.z = cvt_pk_bf16(h1[0], h1[1]); w.w = cvt_pk_bf16(h1[2], h1[3]);
                    *(u32x4*)(HB + off0 + (size_t)(ai * HALF + m * 16) * DM + bj * HALF) = w;
                    part += (h0[0] * h0[0] + h0[1] * h0[1]) + (h0[2] * h0[2] + h0[3] * h0[3]) + (h1[0] * h1[0] + h1[1] * h1[1]) + (h1[2] * h1[2] + h1[3] * h1[3]);
                }
                part += __shfl_xor(part, 16); part += __shfl_xor(part, 32);
                if (fq == 0) tab[lrow * 4 + wc] = part;
            }
            __builtin_amdgcn_sched_barrier(0);
        }
        asm volatile("s_waitcnt lgkmcnt(0)" ::: "memory"); __builtin_amdgcn_s_barrier(); asm volatile("" ::: "memory");
        const int tid = (wr * 4 + wc) * 64 + fq * 16 + fr;
        if (tid < BM) { const f32x4 t = *(const PG8_LAS f32x4*)(tab + tid * 4); ssp[(size_t)(u.pm * BM + tid) * 4 + u.pn] = (t[0] + t[1]) + (t[2] + t[3]); }
    }
};

struct EpiUp {
    static constexpr bool PERM = true, AFTER_DRAIN = false;
    bf16_t* ACT; const float* ssp; float* halo; float* out; const float* convw; const float* convb; PG8_LAS float* tab;
    __device__ __forceinline__ void operator()(f32x4 (&acc)[2][2][4][2], const Unit& u, int wr, int wc, int fr, int fq) const {
        const int chb = 32 * wc + 8 * fq, ch0 = u.pn * 128 + chb;
#pragma unroll
        for (int ai = 0; ai < 2; ++ai)
#pragma unroll
            for (int m = 0; m < 4; ++m) {
                const int row = u.pm * BM + ai * HALF + wr * 64 + m * 16 + fr;
                const f32x4 t = *(const f32x4*)(ssp + (size_t)row * 4);
                const float rr = 1.0f / sqrtf(((t[0] + t[1]) + (t[2] + t[3])) * (1.0f / DM) + EPS);
#pragma unroll
                for (int bj = 0; bj < 2; ++bj)
#pragma unroll
                    for (int n = 0; n < 2; ++n) acc[ai][bj][m][n] = acc[ai][bj][m][n] * rr;
            }
        if (fr >= 14) {
#pragma unroll
            for (int ai = 0; ai < 2; ++ai)
#pragma unroll
                for (int bj = 0; bj < 2; ++bj)
#pragma unroll
                    for (int n = 0; n < 2; ++n) *(PG8_LAS f32x4*)(tab + ((ai * 2 + wr) * 2 + (fr - 14)) * 256 + bj * 128 + chb + 4 * n) = acc[ai][bj][3][n];
        }
        {
            if (wr == 0 && fr < 2) {
#pragma unroll
                for (int bj = 0; bj < 2; ++bj)
#pragma unroll
                    for (int n = 0; n < 2; ++n) *(f32x4*)(halo + (size_t)(u.pm * 4 + fr) * FF2 + bj * FF + ch0 + 4 * n) = acc[0][bj][0][n];
            }
            if (wr == 1 && fr >= 14) {
#pragma unroll
                for (int bj = 0; bj < 2; ++bj)
#pragma unroll
                    for (int n = 0; n < 2; ++n) { *(f32x4*)(halo + (size_t)(u.pm * 4 + 2 + fr - 14) * FF2 + bj * FF + ch0 + 4 * n) = acc[1][bj][3][n];
                        if ((u.pm & 7) == 7) *(f32x4*)(out + O_FP + (size_t)((u.pm >> 3) * 2 + fr - 14) * FF2 + bj * FF + ch0 + 4 * n) = acc[1][bj][3][n]; }
            }
        }
        asm volatile("s_waitcnt lgkmcnt(0)" ::: "memory"); __builtin_amdgcn_s_barrier(); asm volatile("" ::: "memory");
#pragma unroll
        for (int n = 0; n < 2; ++n) {
            f32x4 w0[2], w1[2], w2[2], cb[2];
#pragma unroll
            for (int bj = 0; bj < 2; ++bj) { const int col = bj * FF + ch0 + 4 * n; w0[bj] = *(const f32x4*)(convw + col); w1[bj] = *(const f32x4*)(convw + FF2 + col); w2[bj] = *(const f32x4*)(convw + 2 * FF2 + col); cb[bj] = *(const f32x4*)(convb + col); }
#pragma unroll
            for (int ai = 0; ai < 2; ++ai) {
                f32x4 pv[2];
                {
                    const int sb = (wr == 1) ? ai * 2 : 1;
#pragma unroll
                    for (int bj = 0; bj < 2; ++bj) { pv[bj] = (f32x4){0.f, 0.f, 0.f, 0.f}; if (fr >= 14) pv[bj] = *(const PG8_LAS f32x4*)(tab + (sb * 2 + (fr - 14)) * 256 + bj * 128 + chb + 4 * n); }
                }
#pragma unroll
                for (int m = 0; m < 4; ++m) {
                    const int row = u.pm * BM + ai * HALF + wr * 64 + m * 16 + fr;
                    f32x4 cv[2];
                    {
#pragma unroll
                        for (int bj = 0; bj < 2; ++bj) { const f32x4 cur = acc[ai][bj][m][n]; const f32x4 prv = m > 0 ? acc[ai][bj][m - 1][n] : pv[bj];
                            const f32x4 p1 = ror1v(fr == 15 ? prv : cur), p2 = ror2v(fr >= 14 ? prv : cur);
                            cv[bj] = cb[bj] + w0[bj] * p2 + w1[bj] * p1 + w2[bj] * cur; }
                    }
                    u32x2 w; w.x = cvt_pk_bf16(silu_mul(cv[0][0], cv[1][0]), silu_mul(cv[0][1], cv[1][1])); w.y = cvt_pk_bf16(silu_mul(cv[0][2], cv[1][2]), silu_mul(cv[0][3], cv[1][3]));
                    const bool skip = ai == 0 && m == 0 && wr == 0 && fr < 2;
                    if (!skip) *(u32x2*)(ACT + (size_t)row * FF + ch0 + 4 * n) = w;
                }
            }
        }
    }
};

struct EpiDown {
    static constexpr bool PERM = true, AFTER_DRAIN = false;
    float* Y; const bf16_t* HB;
    __device__ __forceinline__ void operator()(f32x4 (&acc)[2][2][4][2], const Unit& u, int wr, int wc, int fr, int fq) const {
        const size_t off0 = (size_t)(u.pm * BM + wr * 64 + fr) * DM + u.pn * BM + wc * 32 + 8 * fq;
        u32x4 hb[2][4][2];
#pragma unroll
        for (int ai = 0; ai < 2; ++ai)
#pragma unroll
            for (int m = 0; m < 4; ++m)
#pragma unroll
                for (int bj = 0; bj < 2; ++bj) hb[ai][m][bj] = *(const u32x4*)(HB + off0 + (size_t)(ai * HALF + m * 16) * DM + bj * HALF);
        __builtin_amdgcn_sched_barrier(0);
#pragma unroll
        for (int ai = 0; ai < 2; ++ai)
#pragma unroll
            for (int m = 0; m < 4; ++m)
#pragma unroll
                for (int bj = 0; bj < 2; ++bj) { const u32x4 h = hb[ai][m][bj]; float* yo = Y + off0 + (size_t)(ai * HALF + m * 16) * DM + bj * HALF;
                    const f32x4 a = (f32x4){__builtin_bit_cast(float, h.x << 16), __builtin_bit_cast(float, h.x & 0xffff0000u), __builtin_bit_cast(float, h.y << 16), __builtin_bit_cast(float, h.y & 0xffff0000u)} + acc[ai][bj][m][0];
                    const f32x4 b = (f32x4){__builtin_bit_cast(float, h.z << 16), __builtin_bit_cast(float, h.z & 0xffff0000u), __builtin_bit_cast(float, h.w << 16), __builtin_bit_cast(float, h.w & 0xffff0000u)} + acc[ai][bj][m][1];
                    __builtin_nontemporal_store(a, (f32x4*)yo); __builtin_nontemporal_store(b, (f32x4*)(yo + 4)); }
    }
};

template <class Epi, class Sched, bool ALIGN_EPI = false, bool SP2 = false>
__device__ __forceinline__ void gemm_phase(PG8_LAS unsigned char* lds, const Gemm g, const Sched& S, const Epi& E) {
    const int tid = threadIdx.x, wid = __builtin_amdgcn_readfirstlane(tid >> 6), lane = tid & 63, wr = wid >> 2, wc = wid & 3, fr = lane & 15, fq = lane >> 4;
    const int K = g.K, nt = K / BK;
    unsigned voffA[2], voffB[2];
#pragma unroll
    for (int i = 0; i < 2; ++i) { int R, C; stage_rc(tid * 16 + i * 8192, R, C); const int Rb = Epi::PERM ? ((R & ~31) + perm32(R & 31)) : R;
        voffA[i] = (unsigned)(R * K + C) * 2u; voffB[i] = (unsigned)(Rb * K + C) * 2u; }
    const size_t kstep = (size_t)(BK * 2);
    const size_t hstep = (size_t)HALF * K * 2;
    const size_t tstep = 2 * hstep;
    const unsigned ldsw = (unsigned)wid * 1024u;
    const int aoff = lds_byte(wr * 64 + fr, fq * 8), boff = lds_byte(wc * 32 + fr, fq * 8);
#define PG8_SA(b, h) (((b) * 2 + (h)) * HTB)
#define PG8_SB(b, h) ((4 + (b) * 2 + (h)) * HTB)
#define PG8_STAGE(bufoff, gbase, voff) do { _Pragma("unroll") for (int _i = 0; _i < 2; ++_i) \
        __builtin_amdgcn_global_load_lds((const unsigned*)((const char*)(gbase) + (voff)[_i]), (PG8_LAS unsigned*)(lds + (bufoff) + ldsw + _i * 8192), 16, 0, 0); } while (0)
#define PG8_LDA(dst, b, h) do { _Pragma("unroll") for (int m = 0; m < 4; ++m) _Pragma("unroll") for (int k = 0; k < 2; ++k) dst[m][k] = *(const PG8_LAS bf16x8*)(lds + PG8_SA(b, h) + aoff + m * 2048 + k * 1024); } while (0)
#define PG8_LDB(dst, b, h) do { _Pragma("unroll") for (int n = 0; n < 2; ++n) _Pragma("unroll") for (int k = 0; k < 2; ++k) dst[n][k] = *(const PG8_LAS bf16x8*)(lds + PG8_SB(b, h) + boff + n * 2048 + k * 1024); } while (0)
#define PG8_MMA(ai, bj, At, Bt) do { __builtin_amdgcn_s_setprio(1); _Pragma("unroll") for (int m = 0; m < 4; ++m) _Pragma("unroll") for (int n = 0; n < 2; ++n) _Pragma("unroll") for (int k = 0; k < 2; ++k) \
        acc[ai][bj][m][n] = __builtin_amdgcn_mfma_f32_16x16x32_bf16(Bt[n][k], At[m][k], acc[ai][bj][m][n], 0, 0, 0); __builtin_amdgcn_s_setprio(0); } while (0)
#define PG8_WAIT_V(n) asm volatile("s_waitcnt vmcnt(" #n ")" ::: "memory")
#define PG8_WAIT_L(n) asm volatile("s_waitcnt lgkmcnt(" #n ")" ::: "memory")
#define PG8_BAR __builtin_amdgcn_s_barrier()
#define PG8_SCHED __builtin_amdgcn_sched_barrier(0)
    Unit cur, nxt; int ui = 0;
    if (!S.next(0, cur)) return;
    f32x4 acc[2][2][4][2];
#pragma unroll
    for (int a = 0; a < 2; ++a)
#pragma unroll
        for (int b = 0; b < 2; ++b)
#pragma unroll
            for (int m = 0; m < 4; ++m)
#pragma unroll
                for (int n = 0; n < 2; ++n) acc[a][b][m][n] = (f32x4){0.f, 0.f, 0.f, 0.f};
    bf16x8 At[4][2], B0[2][2], B1[2][2];
    const char* cA = (const char*)g.A + (size_t)cur.pm * tstep; const char* cB = (const char*)g.Bt + (size_t)cur.pn * tstep;
    S.a_ready(cur);
    if constexpr (SP2) {
        PG8_STAGE(PG8_SB(0, 0), cB, voffB); PG8_STAGE(PG8_SB(0, 1), cB + hstep, voffB); PG8_STAGE(PG8_SA(0, 0), cA, voffA); PG8_STAGE(PG8_SA(0, 1), cA + hstep, voffA);
        if (wr == 1) PG8_BAR;
        PG8_WAIT_V(2); PG8_BAR;
        PG8_STAGE(PG8_SB(1, 0), cB + kstep, voffB); PG8_STAGE(PG8_SA(1, 0), cA + kstep, voffA); PG8_STAGE(PG8_SB(1, 1), cB + hstep + kstep, voffB);
        PG8_WAIT_V(6); PG8_BAR;
    } else {
        PG8_STAGE(PG8_SB(0, 0), cB, voffB); PG8_STAGE(PG8_SA(0, 0), cA, voffA); PG8_STAGE(PG8_SB(0, 1), cB + hstep, voffB); PG8_STAGE(PG8_SA(0, 1), cA + hstep, voffA);
        if (wr == 1) PG8_BAR;
        PG8_WAIT_V(4); PG8_BAR;
        PG8_STAGE(PG8_SB(1, 0), cB + kstep, voffB); PG8_STAGE(PG8_SA(1, 0), cA + kstep, voffA); PG8_STAGE(PG8_SB(1, 1), cB + hstep + kstep, voffB);
        PG8_WAIT_V(6); PG8_BAR;
    }
    for (;;) {
        const bool has_next = S.next(ui + 1, nxt);
        const char* nA = has_next ? (const char*)g.A + (size_t)nxt.pm * tstep : cA; const char* nB = has_next ? (const char*)g.Bt + (size_t)nxt.pn * tstep : cB;
        for (int t = 0; t < nt; t += 2) {
            const bool last = (t == nt - 2);
            const char* a1 = cA + (size_t)(t + 1) * kstep;
            const char* a2 = last ? nA : cA + (size_t)(t + 2) * kstep; const char* b2 = last ? nB : cB + (size_t)(t + 2) * kstep;
            const char* a3 = a2 + kstep; const char* b3 = b2 + kstep;
            if (last && has_next) S.a_ready(nxt);
            if constexpr (SP2) {
            PG8_LDB(B0, 0, 0); PG8_LDB(B1, 0, 1); PG8_SCHED; PG8_LDA(At, 0, 0); PG8_STAGE(PG8_SA(1, 1), a1 + hstep, voffA);
            PG8_WAIT_V(8); PG8_WAIT_L(0); PG8_BAR; PG8_MMA(0, 0, At, B0); PG8_MMA(0, 1, At, B1); PG8_BAR; PG8_SCHED;
            PG8_LDA(At, 0, 1); PG8_STAGE(PG8_SB(0, 0), b2, voffB); PG8_STAGE(PG8_SB(0, 1), b2 + hstep, voffB); PG8_STAGE(PG8_SA(0, 0), a2, voffA);
            PG8_WAIT_V(8); PG8_WAIT_L(0); PG8_BAR; PG8_MMA(1, 0, At, B0); PG8_MMA(1, 1, At, B1); PG8_BAR; PG8_SCHED;
            PG8_LDB(B0, 1, 0); PG8_LDB(B1, 1, 1); PG8_SCHED; PG8_LDA(At, 1, 0); PG8_STAGE(PG8_SA(0, 1), a2 + hstep, voffA);
            PG8_WAIT_V(8); PG8_WAIT_L(0); PG8_BAR; PG8_MMA(0, 0, At, B0); PG8_MMA(0, 1, At, B1); PG8_BAR; PG8_SCHED;
            PG8_LDA(At, 1, 1); PG8_STAGE(PG8_SB(1, 0), b3, voffB); PG8_STAGE(PG8_SB(1, 1), b3 + hstep, voffB); PG8_STAGE(PG8_SA(1, 0), a3, voffA);
            PG8_WAIT_V(8); PG8_WAIT_L(0); PG8_BAR; PG8_MMA(1, 0, At, B0); PG8_MMA(1, 1, At, B1); PG8_BAR; PG8_SCHED;
            } else {
            PG8_LDB(B0, 0, 0); PG8_SCHED; PG8_LDA(At, 0, 0); PG8_STAGE(PG8_SA(1, 1), a1 + hstep, voffA);
            PG8_WAIT_L(8); PG8_BAR; PG8_WAIT_L(0); PG8_MMA(0, 0, At, B0); PG8_BAR; PG8_SCHED;
            PG8_LDB(B1, 0, 1); PG8_STAGE(PG8_SB(0, 0), b2, voffB);
            PG8_BAR; PG8_WAIT_L(0); PG8_MMA(0, 1, At, B1); PG8_BAR;
            PG8_LDA(At, 0, 1); PG8_STAGE(PG8_SA(0, 0), a2, voffA);
            PG8_BAR; PG8_WAIT_L(0); PG8_MMA(1, 0, At, B0); PG8_BAR; PG8_SCHED;
            PG8_STAGE(PG8_SB(0, 1), b2 + hstep, voffB);
            PG8_WAIT_V(6); PG8_BAR; PG8_MMA(1, 1, At, B1); PG8_BAR;
            PG8_LDB(B0, 1, 0); PG8_SCHED; PG8_LDA(At, 1, 0); PG8_STAGE(PG8_SA(0, 1), a2 + hstep, voffA);
            PG8_WAIT_L(8); PG8_BAR; PG8_WAIT_L(0); PG8_MMA(0, 0, At, B0); PG8_BAR; PG8_SCHED;
            PG8_LDB(B1, 1, 1); PG8_STAGE(PG8_SB(1, 0), b3, voffB);
            PG8_BAR; PG8_WAIT_L(0); PG8_MMA(0, 1, At, B1); PG8_BAR;
            PG8_LDA(At, 1, 1); PG8_STAGE(PG8_SA(1, 0), a3, voffA);
            PG8_BAR; PG8_WAIT_L(0); PG8_MMA(1, 0, At, B0); PG8_BAR; PG8_SCHED;
            PG8_STAGE(PG8_SB(1, 1), b3 + hstep, voffB);
            PG8_WAIT_V(6); PG8_BAR; PG8_MMA(1, 1, At, B1); PG8_BAR;
            }
        }
        if constexpr (ALIGN_EPI) { if (wr == 0) PG8_BAR; }
        if constexpr (!Epi::AFTER_DRAIN) { E(acc, cur, wr, wc, fr, fq); S.done(cur); }
        if (!has_next) break;
#pragma unroll
        for (int a = 0; a < 2; ++a)
#pragma unroll
            for (int b = 0; b < 2; ++b)
#pragma unroll
                for (int m = 0; m < 4; ++m)
#pragma unroll
                    for (int n = 0; n < 2; ++n) acc[a][b][m][n] = (f32x4){0.f, 0.f, 0.f, 0.f};
        cur = nxt; cA = nA; cB = nB; ++ui;
        if constexpr (ALIGN_EPI) { if (wr == 1) PG8_BAR; }
    }
    PG8_WAIT_V(0);
    if constexpr (!ALIGN_EPI) { if (wr == 0) PG8_BAR; }
    PG8_BAR;
    if constexpr (Epi::AFTER_DRAIN) { E.fused(acc, cur, wr, wc, fr, fq, lds, wid, lane); S.done(cur); }
#undef PG8_SA
#undef PG8_SB
#undef PG8_STAGE
#undef PG8_LDA
#undef PG8_LDB
#undef PG8_MMA
#undef PG8_WAIT_V
#undef PG8_WAIT_L
#undef PG8_BAR
#undef PG8_SCHED
}
}

constexpr int NWAVES = 8;
constexpr int N_LAUNCHES = MK_N_LAUNCHES;
constexpr int PER_PHASE = 7;
constexpr size_t MiB = 1u << 20;
constexpr size_t WS_CTL = 0, CTL_ZERO_BYTES = 64 * 1024;
constexpr size_t WS_WIN = 2 * MiB, WS_WOUT = 6 * MiB, WS_WUP = 8 * MiB, WS_WDN = 20 * MiB, WS_WPOOL = 26 * MiB;
constexpr size_t WS_HALO = 28 * MiB;
constexpr size_t WS_SSP = 40 * MiB;
constexpr size_t WS_SSPS = 42 * MiB;
constexpr size_t WS_XN = 44 * MiB;
constexpr size_t WS_Q = 110 * MiB, QKVU_STRIDE = 33 * MiB;
constexpr size_t WS_MIX = 242 * MiB;
constexpr size_t WS_HB = 308 * MiB;
constexpr size_t WS_ACT = 374 * MiB;
constexpr size_t WS_OP = 554 * MiB;
constexpr size_t WS_LSE = 650 * MiB;
constexpr size_t WS_END = 654 * MiB;
static_assert(WS_XN + (size_t)M * DM * 2 <= WS_Q && WS_Q + 4 * QKVU_STRIDE <= WS_MIX && WS_MIX + (size_t)M * DM * 2 <= WS_HB && WS_HB + (size_t)M * DM * 2 <= WS_ACT && WS_ACT + (size_t)M * FF * 2 <= WS_OP && WS_OP + (size_t)3 * MP * 512 * 2 <= WS_LSE && WS_LSE + (size_t)3 * MP * 8 * 4 <= WS_END, "d_ws map");
static_assert(WS_HALO + (size_t)NPANEL * 4 * FF2 * 4 <= WS_SSP && WS_SSP + (size_t)M * 16 * 4 <= WS_XN && (size_t)M * 512 * 2 <= QKVU_STRIDE, "d_ws map 2");
constexpr int CW_TMO = 0, CW_CODE = 1, CW_BAR = 4096;
constexpr int RING_OFF = 0, RING_BYTES = 131072;
constexpr int TAB_OFF = RING_BYTES;
constexpr int LDSCTL_OFF = RING_BYTES + 8192, MISC_OFF = LDSCTL_OFF + 320;
constexpr int LDS_BYTES = 147456;
static_assert(MISC_OFF + 128 <= LDS_BYTES, "LDS map");
#define GAS __attribute__((address_space(1)))
#define LAS __attribute__((address_space(3)))
typedef unsigned short bf16;
typedef unsigned v4u __attribute__((ext_vector_type(4)));
typedef float f32x4 __attribute__((ext_vector_type(4)));
typedef short bf16x8 __attribute__((ext_vector_type(8)));
typedef GAS unsigned gu32;
typedef GAS unsigned long long gu64;
#define RLX_AGENT __ATOMIC_RELAXED, __HIP_MEMORY_SCOPE_AGENT
#define LDS_WAIT() asm volatile("s_waitcnt lgkmcnt(0)" ::: "memory")
#define VM_WAIT() asm volatile("s_waitcnt vmcnt(0)" ::: "memory")
__device__ __forceinline__ unsigned long long rt() { return __builtin_amdgcn_s_memrealtime(); }
__device__ __forceinline__ unsigned f2bf(float f) { unsigned u = __builtin_bit_cast(unsigned, f); return (u + 0x7fffu + ((u >> 16) & 1u)) >> 16; }
__device__ __forceinline__ unsigned pk2(float lo, float hi) { return f2bf(lo) | (f2bf(hi) << 16); }

#define XB_TMO      128
#define XB_XCNT(j)  (256  + 64 * (j))
#define XB_XSUB(j)  (1280 + 64 * (j))
#define XB_XGEN(j)  (2304 + 64 * (j))
#define XB_TOP      3328
#define XB_TOPGEN   3392
#define XCD_BAR_WORDS 3456
#define XB_SPIN_CAP (1u << 18)

__device__ __forceinline__ unsigned xb_ld(unsigned* p)              { return __hip_atomic_load(p, __ATOMIC_RELAXED, __HIP_MEMORY_SCOPE_AGENT); }
__device__ __forceinline__ unsigned xb_add(unsigned* p, unsigned v) { return __hip_atomic_fetch_add(p, v, __ATOMIC_RELAXED, __HIP_MEMORY_SCOPE_AGENT); }
__device__ __forceinline__ unsigned xb_xcc_id() { return (unsigned)__builtin_amdgcn_s_getreg((3 << 11) | 20) & 0xFu; }
#define XB_SPIN(cond, bar) do { unsigned _sp = 0; while (cond) { __builtin_amdgcn_s_sleep(1); \
    if ((++_sp & 255u) == 0u) { if (xb_ld(&(bar)[XB_TMO])) break; if (_sp > XB_SPIN_CAP) { atomicAdd(&(bar)[XB_TMO], 1u); break; } } } } while (0)

struct XcdBarrier {
    unsigned* bar; unsigned x;
    volatile LAS unsigned* st;
};

__device__ __forceinline__ XcdBarrier xcd_barrier_post(unsigned* bar, volatile LAS unsigned* st) {
    XcdBarrier b; b.bar = bar; b.x = xb_xcc_id(); b.st = st;
    if (threadIdx.x == 0) (void)xb_add(&bar[XB_XCNT(b.x)], 1u);
    return b;
}
__device__ __forceinline__ void xcd_barrier_complete(unsigned* bar, unsigned x, unsigned& nloc, unsigned& nx) {
    const unsigned G = gridDim.x * gridDim.y * gridDim.z;
    unsigned sum, cnt, mine, sp = 0u;
    for (;;) {
        sum = 0u; cnt = 0u; mine = 0u;
#pragma unroll
        for (unsigned j = 0; j < 16; ++j) { const unsigned c = xb_ld(&bar[XB_XCNT(j)]); sum += c; cnt += (c > 0u) ? 1u : 0u; mine = (j == x) ? c : mine; }
        if (sum == G) break;
        __builtin_amdgcn_s_sleep(1);
        if ((++sp & 255u) == 0u) { if (xb_ld(&bar[XB_TMO])) break; if (sp > XB_SPIN_CAP) { atomicAdd(&bar[XB_TMO], 1u); break; } }
    }
    nloc = mine > 0u ? mine : 1u; nx = cnt > 0u ? cnt : 1u;
}

__device__ __forceinline__ void xcd_barrier(const XcdBarrier& b) {
    asm volatile("s_waitcnt vmcnt(0)" ::: "memory");
    __syncthreads();
    if (threadIdx.x == 0) {
        unsigned* bar = b.bar;
        __builtin_amdgcn_s_waitcnt(0);
        unsigned nloc = b.st[0], nx = b.st[1];
        if (nloc == 0u) { xcd_barrier_complete(bar, b.x, nloc, nx); b.st[0] = nloc; b.st[1] = nx; }
        const unsigned old = xb_add(&bar[XB_XSUB(b.x)], 1u);
        const unsigned gen = old / nloc;
        if (old + 1u == (gen + 1u) * nloc) {
            __builtin_amdgcn_fence(__ATOMIC_RELEASE, "agent");
            asm volatile("s_waitcnt vmcnt(0)" ::: "memory");
            const unsigned og = xb_add(&bar[XB_TOP], 1u);
            const unsigned tg = og / nx;
            if (og + 1u == (tg + 1u) * nx) xb_add(&bar[XB_TOPGEN], 1u);
            else XB_SPIN(xb_ld(&bar[XB_TOPGEN]) == tg, bar);
            __builtin_amdgcn_fence(__ATOMIC_ACQUIRE, "agent");
            xb_add(&bar[XB_XGEN(b.x)], 1u);
            asm volatile("s_waitcnt vmcnt(0)" ::: "memory");
        } else {
            XB_SPIN(xb_ld(&bar[XB_XGEN(b.x)]) == gen, bar);
            __builtin_amdgcn_fence(__ATOMIC_ACQUIRE, "agent");
            asm volatile("s_waitcnt vmcnt(0)" ::: "memory");
        }
    }
    __syncthreads();
}

typedef unsigned u32x4_t __attribute__((ext_vector_type(4)));
typedef unsigned u32x2_t __attribute__((ext_vector_type(2)));
typedef short v4i16_t __attribute__((ext_vector_type(4)));
struct Frame {
    LAS unsigned char* lds;
    volatile LAS unsigned* MISC;
    gu32* ctl;
    int tid, lane, wave;
    int vcu, G;
    const float* in[18]; float* out; unsigned char* ws;
};
__device__ __forceinline__ float wave_sum(float v) {
#pragma unroll
    for (int o = 1; o < 64; o <<= 1) v += __shfl_xor(v, o);
    return v;
}
typedef float f32x2_t __attribute__((ext_vector_type(2))); typedef __bf16 bf16x2_t __attribute__((ext_vector_type(2)));
__device__ __forceinline__ unsigned cvtpk(float lo, float hi) { const f32x2_t v = {lo, hi}; const bf16x2_t b = __builtin_convertvector(v, bf16x2_t); return __builtin_bit_cast(unsigned, b); }
__device__ __forceinline__ bf16x8 cvt8(f32x4 a, f32x4 b) { u32x4_t w; w.x = cvtpk(a[0], a[1]); w.y = cvtpk(a[2], a[3]); w.z = cvtpk(b[0], b[1]); w.w = cvtpk(b[2], b[3]); return __builtin_bit_cast(bf16x8, w); }
__device__ __forceinline__ float bf2f(unsigned short b) { return __builtin_bit_cast(float, (unsigned)b << 16); }

__device__ __forceinline__ int dest_row_base(int mode, int n0) {
    if (mode == 1) { const int c0 = n0 & 255; return (n0 & ~255) + 128 * ((c0 >> 5) & 1) + 32 * (c0 >> 6); }
    if (mode == 2) { const int half = n0 >= FF ? 1 : 0, chn = n0 - half * FF; return 256 * (chn >> 7) + 128 * half + (chn & 127); }
    return n0;
}
__device__ __forceinline__ void p0_transpose_item(const float* W, int K, int N, bf16* WT, int mode, const float* kscale, LAS float* scr, int item, int lane) {
    const int nblk = N / 32, kb = item / nblk, nb = item % nblk, k0 = 64 * kb, n0 = 32 * nb;
    { f32x4 v[8]; const int n4 = 4 * (lane & 7);
#pragma unroll
      for (int i = 0; i < 8; ++i) v[i] = __builtin_nontemporal_load((const f32x4*)(W + (size_t)(k0 + 8 * i + (lane >> 3)) * N + n0 + n4));
#pragma unroll
      for (int i = 0; i < 8; ++i) { const int kk = 8 * i + (lane >> 3); const float sc = kscale ? kscale[k0 + kk] : 1.0f;
#pragma unroll
          for (int j = 0; j < 4; ++j) scr[kk * 33 + n4 + j] = v[i][j] * sc; } }
    LDS_WAIT(); asm volatile("" ::: "memory");
    const int c = lane & 7, rb = dest_row_base(mode, n0);
#pragma unroll
    for (int j = 0; j < 4; ++j) { const int n = (lane >> 3) + 8 * j; const LAS float* s = scr + (8 * c) * 33 + n;
        v4u o; o.x = pk2(s[0 * 33], s[1 * 33]); o.y = pk2(s[2 * 33], s[3 * 33]); o.z = pk2(s[4 * 33], s[5 * 33]); o.w = pk2(s[6 * 33], s[7 * 33]);
        *(GAS v4u*)(WT + (size_t)(rb + n) * K + k0 + 8 * c) = o; }
    LDS_WAIT(); asm volatile("" ::: "memory");
}
template <int NR> __device__ __forceinline__ void rms_rows_to_bf16(const float* const (&xrow)[NR], const float* g, bf16* const (&orow)[NR], int lane) {
    f32x4 v[NR][4]; float s[NR];
#pragma unroll
    for (int r = 0; r < NR; ++r) { const GAS f32x4* xr = (const GAS f32x4*)xrow[r] + 2 * lane;
#pragma unroll
        for (int j = 0; j < 2; ++j) { v[r][2 * j] = __builtin_nontemporal_load(xr + 128 * j); v[r][2 * j + 1] = __builtin_nontemporal_load(xr + 128 * j + 1); } }
    const GAS f32x4* gr = (const GAS f32x4*)g + 2 * lane; f32x4 gg[4];
#pragma unroll
    for (int j = 0; j < 2; ++j) { gg[2 * j] = gr[128 * j]; gg[2 * j + 1] = gr[128 * j + 1]; }
#pragma unroll
    for (int r = 0; r < NR; ++r) { s[r] = 0.f;
#pragma unroll
        for (int j = 0; j < 4; ++j) s[r] += (v[r][j].x * v[r][j].x + v[r][j].y * v[r][j].y) + (v[r][j].z * v[r][j].z + v[r][j].w * v[r][j].w); }
#pragma unroll
    for (int r = 0; r < NR; ++r) { const float rr = 1.f / sqrtf(wave_sum(s[r]) * (1.f / DM) + EPS);
        GAS v4u* o16 = (GAS v4u*)orow[r] + lane;
#pragma unroll
        for (int j = 0; j < 2; ++j) { const f32x4 a = v[r][2 * j] * rr * gg[2 * j], c = v[r][2 * j + 1] * rr * gg[2 * j + 1];
            v4u o; o.x = pk2(a.x, a.y); o.y = pk2(a.z, a.w); o.z = pk2(c.x, c.y); o.w = pk2(c.z, c.w); o16[64 * j] = o; } }
}
__device__ __forceinline__ void p0_prologue(Frame& F) {
    LAS float* scr = (LAS float*)(F.lds + RING_OFF + F.wave * 16384);
    const int gw = F.vcu * NWAVES + F.wave, NGW = F.G * NWAVES;
    constexpr int I_IN = (DM / 64) * (PJ / 32), I_OUT = (DM / 64) * (DM / 32), I_UP = (DM / 64) * (FF2 / 32), I_DN = (FF / 64) * (DM / 32), I_PL = (128 / 64) * (128 / 32);
    constexpr int NITEMS = I_IN + I_OUT + I_UP + I_DN + 4 * I_PL;
    bf16* ws16 = (bf16*)F.ws;
    for (int it = gw; it < NITEMS; it += NGW) {
        int r = it;
        if (r < I_IN) { p0_transpose_item(F.in[7], DM, PJ, (bf16*)(F.ws + WS_WIN), 1, nullptr, scr, r, F.lane); continue; } r -= I_IN;
        if (r < I_OUT) { p0_transpose_item(F.in[12], DM, DM, (bf16*)(F.ws + WS_WOUT), 0, nullptr, scr, r, F.lane); continue; } r -= I_OUT;
        if (r < I_UP) { p0_transpose_item(F.in[14], DM, FF2, (bf16*)(F.ws + WS_WUP), 2, F.in[13], scr, r, F.lane); continue; } r -= I_UP;
        if (r < I_DN) { p0_transpose_item(F.in[17], FF, DM, (bf16*)(F.ws + WS_WDN), 0, nullptr, scr, r, F.lane); continue; } r -= I_DN;
        { const int g = r / I_PL; p0_transpose_item(F.in[10] + (size_t)g * 128 * 128, 128, 128, (bf16*)(F.ws + WS_WPOOL) + (size_t)g * 128 * 128, 0, nullptr, scr, r % I_PL, F.lane); }
    }
    (void)ws16;
    for (int m0 = gw * 8; m0 < M; m0 += NGW * 8) {
        const float* xr[8]; bf16* orw[8];
#pragma unroll
        for (int r = 0; r < 8; ++r) { const int m = m0 + r; xr[r] = m < MP ? F.in[0] + (size_t)m * DM : F.in[1] + (size_t)(m - MP) * DM; orw[r] = (bf16*)(F.ws + WS_XN) + (size_t)m * DM; }
        rms_rows_to_bf16<8>(xr, F.in[6], orw, F.lane);
    }
    { const int gt = F.vcu * (NWAVES * 64) + F.tid, NT = F.G * NWAVES * 64;
      for (int i = gt; i < DB * 11 * 128; i += NT) { const int b = i / (11 * 128), rem = i % (11 * 128), j = rem >> 7, c4 = rem & 127;
          *(f32x4*)(F.out + O_PS + ((size_t)b * 15 + j) * 512 + 4 * c4) = *(const f32x4*)(F.in[4] + ((size_t)b * 15 + 4 + j) * 512 + 4 * c4); } }
}

__device__ __forceinline__ float max4g(float v) {
    auto a = __builtin_amdgcn_permlane16_swap(__float_as_uint(v), __float_as_uint(v), false, false); v = fmaxf(__uint_as_float(a[0]), __uint_as_float(a[1]));
    auto b = __builtin_amdgcn_permlane32_swap(__float_as_uint(v), __float_as_uint(v), false, false); return fmaxf(__uint_as_float(b[0]), __uint_as_float(b[1]));
}
__device__ __forceinline__ float sum4g(float v) {
    auto a = __builtin_amdgcn_permlane16_swap(__float_as_uint(v), __float_as_uint(v), false, false); v = __uint_as_float(a[0]) + __uint_as_float(a[1]);
    auto b = __builtin_amdgcn_permlane32_swap(__float_as_uint(v), __float_as_uint(v), false, false); return __uint_as_float(b[0]) + __uint_as_float(b[1]);
}
constexpr int VROW = 160;
constexpr int VTILE = 32 * VROW;
struct AState { float m, l; f32x4 o[4]; };
template <bool SAMPLE> struct KVRaw;
template <> struct KVRaw<false> { bf16x8 k[2][2]; bf16x8 v[4]; };
template <> struct KVRaw<true> { f32x4 k[2][2][2]; f32x4 v[8]; };
template <bool SAMPLE> __device__ __forceinline__ const void* kv_row(const void* base, const void* newb, int j, int rs, int cr, int b, int h) {
    int a = (j << rs) + cr;
    if (!SAMPLE) { a = a > SEQ - 1 ? SEQ - 1 : a; return (const bf16*)base + ((size_t)(b * SEQ + a) * AW + h * 64); }
    a = a > 2048 + DS - 1 ? 2048 + DS - 1 : a;
    return a < 2048 ? (const float*)base + ((size_t)(b * 2048 + a) * AW + h * 64) : (const float*)newb + ((size_t)(b * DS + a - 2048) * AW + h * 64);
}
template <bool SAMPLE> __device__ __forceinline__ void kv_load(KVRaw<SAMPLE>& R, const void* Kb, const void* Kn, const void* Vb, const void* Vn, int kb, int rs, int cr, int b, int h, int lane) {
    const int g = lane >> 4, c15 = lane & 15;
#pragma unroll
    for (int t = 0; t < 2; ++t) { const void* p = kv_row<SAMPLE>(Kb, Kn, 16 * (kb + t) + c15, rs, cr, b, h);
#pragma unroll
        for (int s = 0; s < 2; ++s) {
            if constexpr (!SAMPLE) R.k[t][s] = *(const bf16x8*)((const bf16*)p + 32 * s + 8 * g);
            else { R.k[t][s][0] = *(const f32x4*)((const float*)p + 32 * s + 8 * g); R.k[t][s][1] = *(const f32x4*)((const float*)p + 32 * s + 8 * g + 4); } } }
    { const void* p = kv_row<SAMPLE>(Vb, Vn, 16 * kb + (lane >> 1), rs, cr, b, h); const int hh = lane & 1;
        if constexpr (!SAMPLE) {
#pragma unroll
            for (int i = 0; i < 4; ++i) R.v[i] = *(const bf16x8*)((const bf16*)p + 32 * hh + 8 * i);
        } else {
#pragma unroll
            for (int i = 0; i < 8; ++i) R.v[i] = *(const f32x4*)((const float*)p + 32 * hh + 4 * i);
        } }
}
template <bool SAMPLE> __device__ __forceinline__ void attn_step(AState& st, const KVRaw<SAMPLE>& R, const bf16x8 (&qf)[2], int kb, int qsub, float sl2r, int dmin, int mt, LAS unsigned char* vl, int lane) {
    const int g = lane >> 4;
    { LAS unsigned char* wp = vl + (lane >> 1) * VROW + (lane & 1) * 64;
#pragma unroll
        for (int i = 0; i < 4; ++i) { bf16x8 x; if constexpr (!SAMPLE) x = R.v[i]; else x = cvt8(R.v[2 * i], R.v[2 * i + 1]); *(LAS bf16x8*)(wp + 16 * i) = x; } }
    f32x4 s[2];
#pragma unroll
    for (int t = 0; t < 2; ++t) { bf16x8 k0, k1; if constexpr (!SAMPLE) { k0 = R.k[t][0]; k1 = R.k[t][1]; } else { k0 = cvt8(R.k[t][0][0], R.k[t][0][1]); k1 = cvt8(R.k[t][1][0], R.k[t][1][1]); }
        s[t] = __builtin_amdgcn_mfma_f32_16x16x32_bf16(k0, qf[0], (f32x4){0.f, 0.f, 0.f, 0.f}, 0, 0, 0);
        s[t] = __builtin_amdgcn_mfma_f32_16x16x32_bf16(k1, qf[1], s[t], 0, 0, 0); }
    float mx = -INFINITY;
#pragma unroll
    for (int t = 0; t < 2; ++t)
#pragma unroll
        for (int i = 0; i < 4; ++i) { const int d = qsub - (16 * (kb + t) + 4 * g + i);
            const float lg = (mt >= 1 && (d & 3) == 0) ? ((mt == 2 && (d & 15) == 0) ? 1.5849625007211562f : 1.0f) : 0.f;
            const float x = ((unsigned)(d - dmin) <= (unsigned)(128 - dmin)) ? s[t][i] - sl2r * (float)d + lg : -INFINITY; s[t][i] = x; mx = fmaxf(mx, x); }
    mx = max4g(mx);
    const float mn = fmaxf(st.m, mx), alpha = __builtin_amdgcn_exp2f(st.m - mn); st.m = mn;
    float ps = 0.f;
#pragma unroll
    for (int t = 0; t < 2; ++t)
#pragma unroll
        for (int i = 0; i < 4; ++i) { const float p = __builtin_amdgcn_exp2f(s[t][i] - mn); s[t][i] = p; ps += p; }
    st.l = st.l * alpha + ps;
#pragma unroll
    for (int c = 0; c < 4; ++c) st.o[c] = st.o[c] * alpha;
    const bf16x8 pf = cvt8(s[0], s[1]);
    const LAS unsigned char* rp = vl + (4 * g + ((lane & 15) >> 2)) * VROW + (lane & 3) * 8;
#pragma unroll
    for (int c = 0; c < 4; ++c) {
        const v4i16_t a = __builtin_amdgcn_ds_read_tr16_b64_v4i16((LAS v4i16_t*)(rp + 32 * c));
        const v4i16_t bq = __builtin_amdgcn_ds_read_tr16_b64_v4i16((LAS v4i16_t*)(rp + 16 * VROW + 32 * c));
        const bf16x8 vf = (bf16x8){a[0], a[1], a[2], a[3], bq[0], bq[1], bq[2], bq[3]};
        st.o[c] = __builtin_amdgcn_mfma_f32_16x16x32_bf16(vf, pf, st.o[c], 0, 0, 0);
    }
}
__device__ __forceinline__ void attn_init(AState& st) { st.m = -1e30f; st.l = 0.f;
#pragma unroll
    for (int c = 0; c < 4; ++c) st.o[c] = (f32x4){0.f, 0.f, 0.f, 0.f}; }
__device__ __forceinline__ void attn_store(const AState& st, bf16* orow  , int lane) {
    const float l = sum4g(st.l);
    const float il = 1.0f / l; const int g = lane >> 4;
    if (orow) {
#pragma unroll
        for (int c = 0; c < 4; ++c) { u32x2_t w; w.x = cvtpk(st.o[c][0] * il, st.o[c][1] * il); w.y = cvtpk(st.o[c][2] * il, st.o[c][3] * il); *(u32x2_t*)(orow + 16 * c + 4 * g) = w; } }
}
constexpr int KP = 144, VP = 160, KT_ROWS = 256;
constexpr int KT_OFF = 0, VT_OFF = KT_ROWS * KP, SV_OFF = VT_OFF + KT_ROWS * VP;
static_assert(SV_OFF + 8 * VTILE <= RING_BYTES, "attention LDS map");
struct Chunk { int b, h, rs, c, ci, p; };
__device__ __forceinline__ Chunk chunk_decode(int bh  , int e  ) {
    Chunk k; k.b = bh >> 3; k.h = bh & 7;
    if (e < 16) { k.p = 0; k.rs = 0; k.c = 0; k.ci = e; }
    else if (e < 32) { k.p = 1; k.rs = 2; k.c = (e - 16) >> 2; k.ci = (e - 16) & 3; }
    else { k.p = 2; k.rs = 4; k.c = e - 32; k.ci = 0; }
    return k;
}
struct ChunkRegs { bf16x8 k[2], v[2]; };
__device__ __forceinline__ void chunk_load(ChunkRegs& R, const Chunk& k, int j0  , const bf16* Kb, const bf16* Vb, int tid) {
    const int j = j0 + (tid >> 2); const size_t off = (size_t)(k.b * SEQ + (j << k.rs) + k.c) * AW + k.h * 64 + 16 * (tid & 3);
#pragma unroll
    for (int i = 0; i < 2; ++i) { R.k[i] = *(const bf16x8*)(Kb + off + 8 * i); R.v[i] = *(const bf16x8*)(Vb + off + 8 * i); }
}
__device__ __forceinline__ void chunk_store(const ChunkRegs& R, LAS unsigned char* ring, int half, int tid) {
    const int rowp = half * 128 + (tid >> 2), q = tid & 3;
#pragma unroll
    for (int i = 0; i < 2; ++i) { *(LAS bf16x8*)(ring + KT_OFF + rowp * KP + q * 32 + 16 * i) = R.k[i]; *(LAS bf16x8*)(ring + VT_OFF + rowp * VP + q * 32 + 16 * i) = R.v[i]; }
}
__device__ __forceinline__ void chunk_step(AState& st, int kb, int own, int qk, float sl2r, const bf16x8 (&qf)[2], const LAS unsigned char* kp, const LAS unsigned char* vp, int g) {
    f32x4 s[2]; int rowb[2];
#pragma unroll
    for (int t = 0; t < 2; ++t) { const int kk0 = 16 * (kb + t); rowb[t] = ((((kk0 >> 7) + own + 1) & 1) << 7) + (kk0 & 127);
        const LAS unsigned char* r = kp + rowb[t] * KP;
        const bf16x8 k0 = *(const LAS bf16x8*)r, k1 = *(const LAS bf16x8*)(r + 64);
        s[t] = __builtin_amdgcn_mfma_f32_16x16x32_bf16(k0, qf[0], (f32x4){0.f, 0.f, 0.f, 0.f}, 0, 0, 0);
        s[t] = __builtin_amdgcn_mfma_f32_16x16x32_bf16(k1, qf[1], s[t], 0, 0, 0); }
    float mx = -INFINITY;
#pragma unroll
    for (int t = 0; t < 2; ++t)
#pragma unroll
        for (int i = 0; i < 4; ++i) { const int d = qk - (16 * (kb + t) + 4 * g + i); const float x = ((unsigned)d <= 128u) ? s[t][i] - sl2r * (float)d : -INFINITY; s[t][i] = x; mx = fmaxf(mx, x); }
    mx = max4g(mx);
    const float mn = fmaxf(st.m, mx), alpha = __builtin_amdgcn_exp2f(st.m - mn); st.m = mn;
    float ps = 0.f;
#pragma unroll
    for (int t = 0; t < 2; ++t)
#pragma unroll
        for (int i = 0; i < 4; ++i) { const float pe = __builtin_amdgcn_exp2f(s[t][i] - mn); s[t][i] = pe; ps += pe; }
    st.l = st.l * alpha + ps;
#pragma unroll
    for (int c = 0; c < 4; ++c) st.o[c] = st.o[c] * alpha;
    const bf16x8 pf = cvt8(s[0], s[1]);
#pragma unroll
    for (int c = 0; c < 4; ++c) {
        const v4i16_t a = __builtin_amdgcn_ds_read_tr16_b64_v4i16((LAS v4i16_t*)(vp + rowb[0] * VP + 32 * c));
        const v4i16_t bq = __builtin_amdgcn_ds_read_tr16_b64_v4i16((LAS v4i16_t*)(vp + rowb[1] * VP + 32 * c));
        const bf16x8 vf = (bf16x8){a[0], a[1], a[2], a[3], bq[0], bq[1], bq[2], bq[3]};
        st.o[c] = __builtin_amdgcn_mfma_f32_16x16x32_bf16(vf, pf, st.o[c], 0, 0, 0);
    }
}
template <bool SC1> __device__ __forceinline__ void chunk_compute(Frame& F, const Chunk& k, int own, const bf16x8 (&qf)[2], LAS unsigned char* ring) {
    const int lane = F.lane, c15 = lane & 15, g = lane >> 4, w = F.wave;
    AState st; attn_init(st);
    const float sl2r = __builtin_amdgcn_exp2f(-(float)(k.h + 1)) * 1.4426950408889634f * (float)(1 << k.rs);
    const int blk_lo = (k.ci == 0) ? 8 : w, blk_hi = w + 8;
    const int qk = 16 * w + c15 + 128;
    const LAS unsigned char* kp = ring + KT_OFF + c15 * KP + 16 * g;
    const LAS unsigned char* vp = ring + VT_OFF + (4 * g + (c15 >> 2)) * VP + (lane & 3) * 8;
    for (int kb = blk_lo; kb <= blk_hi; kb += 2) chunk_step(st, kb, own, qk, sl2r, qf, kp, vp, g);
    const float l = sum4g(st.l);
    const float il = 1.0f / l;
    const size_t row = (size_t)(k.b * SEQ + (((128 * k.ci + 16 * w + c15) << k.rs) + k.c));
    bf16* orow = (bf16*)(F.ws + WS_OP) + ((size_t)k.p * MP + row) * AW + k.h * 64;
#pragma unroll
    for (int c = 0; c < 4; ++c) { u32x2_t wv; wv.x = cvtpk(st.o[c][0] * il, st.o[c][1] * il); wv.y = cvtpk(st.o[c][2] * il, st.o[c][3] * il);
        if (SC1) __hip_atomic_store((unsigned long long*)(orow + 16 * c + 4 * g), (unsigned long long)wv.x | ((unsigned long long)wv.y << 32), __ATOMIC_RELAXED, __HIP_MEMORY_SCOPE_AGENT);
        else *(u32x2_t*)(orow + 16 * c + 4 * g) = wv; }
    if (g == 0) { float* lp = (float*)(F.ws + WS_LSE) + ((size_t)k.p * MP + row) * NH + k.h; const float lv = st.m + __builtin_amdgcn_logf(l);
        if (SC1) __hip_atomic_store((unsigned*)lp, __float_as_uint(lv), __ATOMIC_RELAXED, __HIP_MEMORY_SCOPE_AGENT); else *lp = lv; }
}
struct SDesc { int rs, cr, kb, qsub, dmin, mt; float sl2r; };
__device__ __forceinline__ SDesc sample_desc(int s, int qp, int c15, float slope2) {
    SDesc d; const int NEGQ = -(1 << 20);
    if (s < 5) { d.rs = 0; d.cr = 0; d.kb = 120 + 2 * s; d.qsub = c15 < 2 ? 2048 + 2 * qp + c15 : NEGQ; d.sl2r = slope2; d.dmin = 0; d.mt = 2; }
    else if (s < 11) { const int q = (s - 5) / 3, st = (s - 5) - 3 * q; d.rs = 2; d.cr = 2 * qp + q; d.kb = 24 + 2 * st; d.qsub = c15 == q ? 512 : NEGQ; d.sl2r = slope2 * 4.0f; d.dmin = 33; d.mt = 1; }
    else { const int q = (s - 11) / 3, st = (s - 11) - 3 * q; d.rs = 4; d.cr = 2 * qp + (q & 1); d.kb = 2 * st; d.qsub = (s < 17 && c15 == q) ? 128 : NEGQ; d.sl2r = slope2 * 16.0f; d.dmin = 33; d.mt = 0; }
    return d;
}
constexpr int A_CHUNKS = 32;
constexpr int CW_PAIR = 8192;
template <bool ROLE_B> __device__ __forceinline__ void attn_prompt_role(Frame& F, int bh) {
    constexpr int E0 = ROLE_B ? A_CHUNKS : 0, E1 = ROLE_B ? 48 : A_CHUNKS;
    LAS unsigned char* ring = F.lds + RING_OFF;
    LAS unsigned char* vl = ring + SV_OFF + F.wave * VTILE;
    const bf16* Qb = (const bf16*)(F.ws + WS_Q); const bf16* Kb = (const bf16*)(F.ws + WS_Q + QKVU_STRIDE); const bf16* Vb = (const bf16*)(F.ws + WS_Q + 2 * QKVU_STRIDE);
    const float* Kc = F.in[2]; const float* Vc = F.in[3]; const float* Kn = F.out + O_KS; const float* Vn = F.out + O_VS;
    const int lane = F.lane, c15 = lane & 15, g = lane >> 4;
    __syncthreads();
    for (int i = F.tid; i < SV_OFF / 4; i += NWAVES * 64) ((LAS unsigned*)(ring))[i] = 0u;
    const int bS = bh, qpS = 0, hS = F.wave;
    bf16x8 qs[2]; AState sst; attn_init(sst);
    const float slope2S = __builtin_amdgcn_exp2f(-(float)(hS + 1)) * 1.4426950408889634f;
    if (!ROLE_B) { const bf16* qptr = Qb + ((size_t)(MP + bS * DS + 2 * qpS + (c15 & 1)) * AW + hS * 64 + 8 * g); qs[0] = *(const bf16x8*)qptr; qs[1] = *(const bf16x8*)(qptr + 32); }
    ChunkRegs R0, R1; Chunk c0 = chunk_decode(bh, E0), c1 = chunk_decode(bh, E0 + 1); chunk_load(R0, c0, 128 * c0.ci, Kb, Vb, F.tid); chunk_load(R1, c1, 128 * c1.ci, Kb, Vb, F.tid);
#define CHUNK_ITER(E, RR, CC, OWN, WS) do { \
        SDesc sd; KVRaw<true> sraw; \
        if (WS) { sd = sample_desc((E), qpS, c15, slope2S); kv_load<true>(sraw, Kc, Kn, Vc, Vn, sd.kb, sd.rs, sd.cr, bS, hS, lane); } \
        bf16x8 qf[2]; \
        { const size_t qrow = (size_t)(CC.b * SEQ + (((128 * CC.ci + 16 * F.wave + c15) << CC.rs) + CC.c)); \
          const bf16* qp = Qb + qrow * AW + CC.h * 64 + 8 * g; qf[0] = *(const bf16x8*)qp; qf[1] = *(const bf16x8*)(qp + 32); } \
        __syncthreads(); \
        chunk_store(RR, ring, (OWN), F.tid); \
        __syncthreads(); \
        const Chunk now = CC; \
        if ((E) + 2 < E1) { CC = chunk_decode(bh, (E) + 2); chunk_load(RR, CC, 128 * CC.ci, Kb, Vb, F.tid); } \
        chunk_compute<ROLE_B>(F, now, (OWN), qf, ring); \
        if (WS) attn_step<true>(sst, sraw, qs, sd.kb, sd.qsub, sd.sl2r, sd.dmin, sd.mt, vl, lane); } while (0)
    if (!ROLE_B) {
#pragma unroll 1
        for (int e = 0; e < 18; e += 2) { CHUNK_ITER(e, R0, c0, 0, true); CHUNK_ITER(e + 1, R1, c1, 1, true); }
#pragma unroll 1
        for (int e = 18; e < E1; e += 2) { CHUNK_ITER(e, R0, c0, 0, false); CHUNK_ITER(e + 1, R1, c1, 1, false); }
        attn_store(sst, c15 < 2 ? (bf16*)(F.ws + WS_MIX) + ((size_t)(MP + bS * DS + 2 * qpS + c15) * DM + hS * 64) : nullptr, lane);
    } else {
#pragma unroll 1
        for (int e = E0; e < E1; e += 2) { CHUNK_ITER(e, R0, c0, 0, false); CHUNK_ITER(e + 1, R1, c1, 1, false); }
    }
#undef CHUNK_ITER
    asm volatile("s_waitcnt vmcnt(0)" ::: "memory"); __syncthreads();
    gu32* flag = F.ctl + CW_PAIR + 64 * bh;
    if (ROLE_B) { if (F.tid == 0) __hip_atomic_store(flag, 1u, RLX_AGENT); return; }
    if (F.wave == 0) { unsigned sp = 0; while (__hip_atomic_load(flag, RLX_AGENT) == 0u) { __builtin_amdgcn_s_sleep(2); if (++sp > (1u << 22)) { if (lane == 0) __hip_atomic_store(F.ctl + CW_TMO, 0xA77Eu, RLX_AGENT); break; } }
        __builtin_amdgcn_fence(__ATOMIC_ACQUIRE, "agent"); asm volatile("s_waitcnt vmcnt(0)" ::: "memory"); }
    __syncthreads();
    { const int b = bh >> 3, h = bh & 7; const bf16* OP = (const bf16*)(F.ws + WS_OP); const float* LSE = (const float*)(F.ws + WS_LSE); bf16* MIX = (bf16*)(F.ws + WS_MIX);
#pragma unroll 4
      for (int it = 0; it < SEQ / 64; ++it) { const size_t row = (size_t)b * SEQ + it * 64 + F.wave * 8 + (lane >> 3); const size_t off = row * AW + h * 64 + 8 * (lane & 7);
          const float l0 = LSE[row * NH + h], l1 = LSE[((size_t)MP + row) * NH + h], l2 = LSE[((size_t)2 * MP + row) * NH + h];
          const bf16x8 pa = *(const bf16x8*)(OP + off), pb = *(const bf16x8*)(OP + (size_t)MP * AW + off), pc = *(const bf16x8*)(OP + (size_t)2 * MP * AW + off);
          const float mx = fmaxf(l0, fmaxf(l1, l2)); float w0 = __builtin_amdgcn_exp2f(l0 - mx), w1 = __builtin_amdgcn_exp2f(l1 - mx), w2 = __builtin_amdgcn_exp2f(l2 - mx);
          const float inv = 1.0f / (w0 + w1 + w2); w0 *= inv; w1 *= inv; w2 *= inv;
          float o[8];
#pragma unroll
          for (int e = 0; e < 8; ++e) o[e] = w0 * bf2f((unsigned short)pa[e]) + w1 * bf2f((unsigned short)pb[e]) + w2 * bf2f((unsigned short)pc[e]);
          u32x4_t wv; wv.x = cvtpk(o[0], o[1]); wv.y = cvtpk(o[2], o[3]); wv.z = cvtpk(o[4], o[5]); wv.w = cvtpk(o[6], o[7]);
          *(u32x4_t*)(MIX + row * DM + h * 64 + 8 * (lane & 7)) = wv; } }
}
__device__ __forceinline__ void attn_sample_role(Frame& F, int bS, int qp0, int qp1) {
    const bf16* Qb = (const bf16*)(F.ws + WS_Q);
    const float* Kc = F.in[2]; const float* Vc = F.in[3]; const float* Kn = F.out + O_KS; const float* Vn = F.out + O_VS;
    const int lane = F.lane, c15 = lane & 15, g = lane >> 4, hS = F.wave;
    LAS unsigned char* vl = F.lds + RING_OFF + SV_OFF + F.wave * VTILE;
    const float slope2S = __builtin_amdgcn_exp2f(-(float)(hS + 1)) * 1.4426950408889634f;
#pragma unroll 1
    for (int qpS = qp0; qpS < qp1; ++qpS) {
        bf16x8 qs[2];
        { const bf16* qptr = Qb + ((size_t)(MP + bS * DS + 2 * qpS + (c15 & 1)) * AW + hS * 64 + 8 * g); qs[0] = *(const bf16x8*)qptr; qs[1] = *(const bf16x8*)(qptr + 32); }
        AState sst; attn_init(sst);
        KVRaw<true> cur, nxt;
        { const SDesc sd = sample_desc(0, qpS, c15, slope2S); kv_load<true>(cur, Kc, Kn, Vc, Vn, sd.kb, sd.rs, sd.cr, bS, hS, lane); }
#pragma unroll 1
        for (int s = 0; s < 17; ++s) {
            const SDesc sd = sample_desc(s, qpS, c15, slope2S), sn = sample_desc(s + 1, qpS, c15, slope2S);
            kv_load<true>(nxt, Kc, Kn, Vc, Vn, sn.kb, sn.rs, sn.cr, bS, hS, lane);
            attn_step<true>(sst, cur, qs, sd.kb, sd.qsub, sd.sl2r, sd.dmin, sd.mt, vl, lane);
            cur = nxt;
        }
        attn_store(sst, c15 < 2 ? (bf16*)(F.ws + WS_MIX) + ((size_t)(MP + bS * DS + 2 * qpS + c15) * DM + hS * 64) : nullptr, lane);
    }
}
template <int K> __device__ __forceinline__ float dpp_ror(float v) { return __builtin_bit_cast(float, __builtin_amdgcn_update_dpp(0, __builtin_bit_cast(int, v), 0x120 + K, 0xf, 0xf, false)); }
template <int K> __device__ __forceinline__ void win_step(float (&S)[8], float (&P)[8], int c15) {
#pragma unroll
    for (int e = 0; e < 8; ++e) { const float y = c15 >= 16 - K ? P[e] : S[e]; const float s2 = S[e] + dpp_ror<K>(y); const float p2 = P[e] + dpp_ror<K>(P[e]); S[e] = s2; P[e] = p2; }
}
__device__ __forceinline__ void pool_mma_store(const bf16* WP, const float* PS, bf16* MIX, f32x4 (&acc)[8], const bf16x8 (&df)[4], int gi, int row, int c15, int g) {
#pragma unroll
    for (int ks = 0; ks < 4; ++ks)
#pragma unroll
        for (int nt = 0; nt < 8; ++nt) { const bf16x8 wf = *(const bf16x8*)(WP + ((size_t)(gi * 128 + 16 * nt + c15) * 128 + 32 * ks + 8 * g));
            acc[nt] = __builtin_amdgcn_mfma_f32_16x16x32_bf16(wf, df[ks], acc[nt], 0, 0, 0); }
#pragma unroll
    for (int nt = 0; nt < 8; ++nt) { const int col = 128 * gi + 16 * nt + 4 * g; const f32x4 sc = *(const f32x4*)(PS + col); const f32x4 o = acc[nt] * sc;
        u32x2_t wv; wv.x = cvtpk(o[0], o[1]); wv.y = cvtpk(o[2], o[3]); *(u32x2_t*)(MIX + (size_t)row * DM + 512 + col) = wv; }
}
template <int NTL> __device__ __forceinline__ void pool_group_prompt(Frame& F, int T0, int TS, const int GI) {
    const int lane = F.lane, c15 = lane & 15, g = lane >> 4;
    const bf16* U = (const bf16*)(F.ws + WS_Q + 3 * QKVU_STRIDE); const bf16* WP = (const bf16*)(F.ws + WS_WPOOL); const float* PS = F.in[11]; bf16* MIX = (bf16*)(F.ws + WS_MIX);
    const int w = 2 << GI;
    bf16x8 xc[NTL][4], xp[NTL][4];
#pragma unroll
    for (int tl = 0; tl < NTL; ++tl) { const int T = T0 + tl * TS, row = T * 16 + c15; const bool has_prev = ((T * 16) & (SEQ - 1)) != 0;
#pragma unroll
        for (int ks = 0; ks < 4; ++ks) { const int ch = 128 * GI + 32 * ks + 8 * g; xc[tl][ks] = *(const bf16x8*)(U + (size_t)row * AW + ch);
            xp[tl][ks] = (bf16x8){0, 0, 0, 0, 0, 0, 0, 0}; if (has_prev) xp[tl][ks] = *(const bf16x8*)(U + (size_t)(row - 16) * AW + ch); } }
    bf16x8 df[NTL][4];
#pragma unroll
    for (int tl = 0; tl < NTL; ++tl) { const int t = ((T0 + tl * TS) * 16 + c15) & (SEQ - 1); const float ic = 1.0f / (float)(w < t + 1 ? w : t + 1);
#pragma unroll
        for (int ks = 0; ks < 4; ++ks) {
            float S[8], P[8], cur[8];
#pragma unroll
            for (int e = 0; e < 8; ++e) { cur[e] = bf2f((unsigned short)xc[tl][ks][e]); S[e] = cur[e]; P[e] = bf2f((unsigned short)xp[tl][ks][e]); }
            win_step<1>(S, P, c15);
            if (GI >= 1) win_step<2>(S, P, c15);
            if (GI >= 2) win_step<4>(S, P, c15);
            if (GI >= 3) win_step<8>(S, P, c15);
            f32x4 d0, d1;
#pragma unroll
            for (int e = 0; e < 4; ++e) { d0[e] = S[e] * ic - cur[e]; d1[e] = S[4 + e] * ic - cur[4 + e]; }
            df[tl][ks] = cvt8(d0, d1);
        } }
    f32x4 acc[NTL][8];
#pragma unroll
    for (int tl = 0; tl < NTL; ++tl)
#pragma unroll
        for (int nt = 0; nt < 8; ++nt) acc[tl][nt] = (f32x4){0.f, 0.f, 0.f, 0.f};
#pragma unroll
    for (int ks = 0; ks < 4; ++ks)
#pragma unroll
        for (int nt = 0; nt < 8; ++nt) { const bf16x8 wf = *(const bf16x8*)(WP + ((size_t)(GI * 128 + 16 * nt + c15) * 128 + 32 * ks + 8 * g));
#pragma unroll
            for (int tl = 0; tl < NTL; ++tl) acc[tl][nt] = __builtin_amdgcn_mfma_f32_16x16x32_bf16(wf, df[tl][ks], acc[tl][nt], 0, 0, 0); }
#pragma unroll
    for (int nt = 0; nt < 8; ++nt) { const int col = 128 * GI + 16 * nt + 4 * g; const f32x4 sc = *(const f32x4*)(PS + col);
#pragma unroll
        for (int tl = 0; tl < NTL; ++tl) { const f32x4 o = acc[tl][nt] * sc; const int row = (T0 + tl * TS) * 16 + c15;
            u32x2_t wv; wv.x = cvtpk(o[0], o[1]); wv.y = cvtpk(o[2], o[3]); *(u32x2_t*)(MIX + (size_t)row * DM + 512 + col) = wv; } }
}
__device__ __forceinline__ void pool_sample_item(Frame& F, int T, int gi) {
    const int lane = F.lane, c15 = lane & 15, g = lane >> 4, row = T * 16 + c15, t = (row - MP) & 3, bs = (row - MP) >> 2;
    const bf16* U = (const bf16*)(F.ws + WS_Q + 3 * QKVU_STRIDE); const float* SP = F.in[4];
    const int w = 2 << gi; const float ic = 1.0f / (float)w;
    bf16x8 df[4];
#pragma unroll
    for (int ks = 0; ks < 4; ++ks) df[ks] = (bf16x8){0, 0, 0, 0, 0, 0, 0, 0};
#pragma unroll 1
    for (int ks = 0; ks < 4; ++ks) {
        const int ch = 128 * gi + 32 * ks + 8 * g;
        float S[8], cur[8];
#pragma unroll
        for (int e = 0; e < 8; ++e) { S[e] = 0.f; cur[e] = 0.f; }
#pragma unroll 1
        for (int i0 = 0; i0 < w; i0 += 8) {
            bf16x8 xu[8]; f32x4 x0[8], x1[8];
#pragma unroll
            for (int u = 0; u < 8; ++u) { const int i = i0 + u < w ? i0 + u : w - 1; const int idx = t - i, iu = idx < 0 ? 0 : idx, is = idx >= 0 ? 14 : 15 + idx;
                xu[u] = *(const bf16x8*)(U + (size_t)(row - t + iu) * AW + ch);
                const float* sp = SP + ((size_t)bs * 15 + is) * 512 + ch; x0[u] = *(const f32x4*)sp; x1[u] = *(const f32x4*)(sp + 4); }
            __builtin_amdgcn_sched_barrier(0);
#pragma unroll
            for (int u = 0; u < 8; ++u) { const int i = i0 + u, idx = t - i; const bool use = i < w;
#pragma unroll
                for (int e = 0; e < 8; ++e) { const float vs = e < 4 ? x0[u][e & 3] : x1[u][e & 3]; float v = idx >= 0 ? bf2f((unsigned short)xu[u][e]) : vs; v = use ? v : 0.f; S[e] += v; if (i == 0) cur[e] = v; } }
        }
        f32x4 d0, d1;
#pragma unroll
        for (int e = 0; e < 4; ++e) { d0[e] = S[e] * ic - cur[e]; d1[e] = S[4 + e] * ic - cur[4 + e]; }
        const bf16x8 dd = cvt8(d0, d1); if (ks == 0) df[0] = dd; else if (ks == 1) df[1] = dd; else if (ks == 2) df[2] = dd; else df[3] = dd;
    }
    f32x4 acc[8];
#pragma unroll
    for (int nt = 0; nt < 8; ++nt) acc[nt] = (f32x4){0.f, 0.f, 0.f, 0.f};
    pool_mma_store((const bf16*)(F.ws + WS_WPOOL), F.in[11], (bf16*)(F.ws + WS_MIX), acc, df, gi, row, c15, g);
}
template <int NTL> __device__ __forceinline__ void pool_tiles(Frame& F, int T0, int TS) {
#pragma unroll 1
    for (int gi = 0; gi < 4; ++gi) pool_group_prompt<NTL>(F, T0, TS, gi);
}
__device__ __forceinline__ void p2_attn(Frame& F) {
    const int role = F.vcu & 1, idx = F.vcu >> 1, nidx = F.G >> 1;
    if (role == 0) { for (int bh = idx; bh < NB * NH; bh += nidx) attn_prompt_role<false>(F, bh); }
    else {
        for (int bh = idx; bh < NB * NH; bh += nidx) attn_prompt_role<true>(F, bh);
        for (int b = idx; b < DB; b += nidx) attn_sample_role(F, b, 1, 2);
        const int gw = idx * NWAVES + F.wave, NGW = nidx * NWAVES;
        if (2 * NGW == MP / 16) pool_tiles<2>(F, gw, NGW); else for (int T = gw; T < MP / 16; T += NGW) pool_tiles<1>(F, T, 0);
        for (int it = gw; it < 128 * 8; it += NGW) if ((it & 7) == 0) pool_sample_item(F, MP / 16 + (it >> 5), (it >> 3) & 3);
    }
}
template <int NTW, int KS, int UNR, class BR> __device__ __forceinline__ void mini_mma(const bf16* A, int K, const bf16* Bt, const BR& br, int arow, LAS float* tile, int pitch, int wave, int lane) {
    const int c15 = lane & 15, g = lane >> 4, ks = wave % KS, cg = wave / KS;
    const int kbeg = ks * (K / KS), ksteps = K / KS / 32, joff = cg * 16 * NTW;
    const bf16* ap = A + (size_t)(arow + c15) * K + kbeg + 8 * g;
    const bf16* bp[NTW];
#pragma unroll
    for (int nt = 0; nt < NTW; ++nt) bp[nt] = Bt + (size_t)br(joff + nt * 16 + c15) * K + kbeg + 8 * g;
    f32x4 acc[4][NTW];
#pragma unroll
    for (int rb = 0; rb < 4; ++rb)
#pragma unroll
        for (int nt = 0; nt < NTW; ++nt) acc[rb][nt] = (f32x4){0.f, 0.f, 0.f, 0.f};
    for (int s0 = 0; s0 < ksteps; s0 += UNR) {
        bf16x8 a[UNR][4], b[UNR][NTW];
#pragma unroll
        for (int u = 0; u < UNR; ++u) { const int s = s0 + u < ksteps ? s0 + u : ksteps - 1;
#pragma unroll
            for (int rb = 0; rb < 4; ++rb) a[u][rb] = *(const bf16x8*)(ap + (size_t)(16 * rb) * K + 32 * s);
#pragma unroll
            for (int nt = 0; nt < NTW; ++nt) b[u][nt] = *(const bf16x8*)(bp[nt] + 32 * s); }
        __builtin_amdgcn_sched_barrier(0);
#pragma unroll
        for (int u = 0; u < UNR; ++u) if (s0 + u < ksteps) {
#pragma unroll
            for (int rb = 0; rb < 4; ++rb)
#pragma unroll
                for (int nt = 0; nt < NTW; ++nt) acc[rb][nt] = __builtin_amdgcn_mfma_f32_16x16x32_bf16(b[u][nt], a[u][rb], acc[rb][nt], 0, 0, 0); }
        __builtin_amdgcn_sched_barrier(0);
    }
#pragma unroll
    for (int rb = 0; rb < 4; ++rb)
#pragma unroll
        for (int nt = 0; nt < NTW; ++nt) *(LAS f32x4*)(tile + (ks * 64 + 16 * rb + c15) * pitch + joff + 16 * nt + 4 * g) = acc[rb][nt];
}
struct BrLin { int c0; __device__ __forceinline__ int operator()(int j) const { return c0 + j; } };
struct BrHead { int base; __device__ __forceinline__ int operator()(int j) const { return base + 128 * (j >> 5) + (j & 31); } };
struct BrUp { int ch0; __device__ __forceinline__ int operator()(int j) const { const int half = j >= 96 ? 1 : 0; int ch = ch0 + j - 96 * half; ch = ch > FF - 1 ? FF - 1 : ch; return 256 * (ch >> 7) + 128 * half + (ch & 127); } };
__device__ __forceinline__ void mini_inproj(Frame& F, int tl) {
    LAS float* tile = (LAS float*)(F.lds + RING_OFF); constexpr int PT = 68;
    const int rg = tl >> 5, hd = tl & 31, type = hd >> 3, h = hd & 7;
    BrHead br{256 * (type * 2 + (h >> 2)) + 32 * (h & 3)};
    mini_mma<2, 4, 4>((const bf16*)(F.ws + WS_XN), DM, (const bf16*)(F.ws + WS_WIN), br, MP + 64 * rg, tile, PT, F.wave, F.lane);
    __syncthreads();
    const int r = F.tid >> 3, d0 = 8 * (F.tid & 7), row = 64 * rg + r;
    float v[8];
#pragma unroll
    for (int e = 0; e < 8; ++e) v[e] = (tile[r * PT + d0 + e] + tile[(64 + r) * PT + d0 + e]) + (tile[(128 + r) * PT + d0 + e] + tile[(192 + r) * PT + d0 + e]);
    if (type < 2) { float ss = 0.f;
#pragma unroll
        for (int e = 0; e < 8; ++e) ss += v[e] * v[e];
        ss += __shfl_xor(ss, 1); ss += __shfl_xor(ss, 2); ss += __shfl_xor(ss, 4);
        const float rr = 1.0f / sqrtf(ss * (1.0f / 64.0f) + EPS) * (type == 0 ? QSCALE : 1.0f); const float* gs = (type == 0 ? F.in[8] : F.in[9]) + h * 64 + d0;
#pragma unroll
        for (int e = 0; e < 8; ++e) v[e] = v[e] * rr * gs[e]; }
    u32x4_t wv; wv.x = cvtpk(v[0], v[1]); wv.y = cvtpk(v[2], v[3]); wv.z = cvtpk(v[4], v[5]); wv.w = cvtpk(v[6], v[7]);
    *(u32x4_t*)((bf16*)(F.ws + WS_Q + (size_t)type * QKVU_STRIDE) + (size_t)(MP + row) * AW + h * 64 + d0) = wv;
    float* o = nullptr;
    if (type == 1) o = F.out + O_KS + (size_t)row * AW + h * 64 + d0; else if (type == 2) o = F.out + O_VS + (size_t)row * AW + h * 64 + d0;
    else if (type == 3) o = F.out + O_PS + ((size_t)(row >> 2) * 15 + 11 + (row & 3)) * 512 + h * 64 + d0;
    if (o) { *(f32x4*)o = (f32x4){v[0], v[1], v[2], v[3]}; *(f32x4*)(o + 4) = (f32x4){v[4], v[5], v[6], v[7]}; }
    __syncthreads();
}
__device__ __forceinline__ void mini_outproj(Frame& F, int tl) {
    LAS float* tile = (LAS float*)(F.lds + RING_OFF); constexpr int PT = 36;
    const int rg = tl >> 5, cg = tl & 31;
    BrLin br{32 * cg};
    mini_mma<2, 8, 4>((const bf16*)(F.ws + WS_MIX), DM, (const bf16*)(F.ws + WS_WOUT), br, MP + 64 * rg, tile, PT, F.wave, F.lane);
    __syncthreads();
    const int r = F.tid >> 3, c0 = 4 * (F.tid & 7), row = 64 * rg + r, col = 32 * cg + c0;
    f32x4 a = (f32x4){0.f, 0.f, 0.f, 0.f}, b = (f32x4){0.f, 0.f, 0.f, 0.f};
#pragma unroll
    for (int k2 = 0; k2 < 8; k2 += 2) { a = a + *(const LAS f32x4*)(tile + (k2 * 64 + r) * PT + c0); b = b + *(const LAS f32x4*)(tile + ((k2 + 1) * 64 + r) * PT + c0); }
    const f32x4 hv = *(const f32x4*)(F.in[1] + (size_t)row * DM + col) + a + b;
    u32x2_t wv; wv.x = cvtpk(hv[0], hv[1]); wv.y = cvtpk(hv[2], hv[3]); *(u32x2_t*)((bf16*)(F.ws + WS_HB) + (size_t)(MP + row) * DM + col) = wv;
    float ss = (hv[0] * hv[0] + hv[1] * hv[1]) + (hv[2] * hv[2] + hv[3] * hv[3]);
    ss += __shfl_xor(ss, 1); ss += __shfl_xor(ss, 2); ss += __shfl_xor(ss, 4);
    if ((F.tid & 7) == 0) ((float*)(F.ws + WS_SSPS))[row * 32 + cg] = ss;
    __syncthreads();
}
__device__ __forceinline__ void mini_up(Frame& F, int tl) {
    LAS float* tile = (LAS float*)(F.lds + RING_OFF); constexpr int PT = 196;
    const int rg = tl >> 5, cg = tl & 31, ch0 = 88 * cg;
    BrUp br{ch0};
    mini_mma<3, 2, 4>((const bf16*)(F.ws + WS_HB), DM, (const bf16*)(F.ws + WS_WUP), br, MP + 64 * rg, tile, PT, F.wave, F.lane);
    __syncthreads();
    { const int r = F.tid >> 3, row = 64 * rg + r; const float* sp = (const float*)(F.ws + WS_SSPS) + row * 32 + 4 * (F.tid & 7);
      const f32x4 t = *(const f32x4*)sp; float ss = (t[0] + t[1]) + (t[2] + t[3]); ss += __shfl_xor(ss, 1); ss += __shfl_xor(ss, 2); ss += __shfl_xor(ss, 4);
      const float rr = 1.0f / sqrtf(ss * (1.0f / DM) + EPS);
      for (int c = (F.tid & 7); c < 192; c += 8) tile[r * PT + c] = (tile[r * PT + c] + tile[(64 + r) * PT + c]) * rr; }
    __syncthreads();
    { const int r = F.tid >> 3, row = 64 * rg + r, n = row & 3, b = row >> 2; const float* cw = F.in[15]; const float* cbp = F.in[16]; const float* hist = F.in[5] + (size_t)b * 2 * FF2;
#pragma unroll
      for (int k = 0; k < 11; ++k) { const int cl = 11 * (F.tid & 7) + k, ch = ch0 + cl; float cv[2];
#pragma unroll
          for (int hf = 0; hf < 2; ++hf) { const int col = hf * FF + ch, lc = hf * 96 + cl;
              const float cur = tile[r * PT + lc];
              const float p1 = n >= 1 ? tile[(r - 1) * PT + lc] : hist[FF2 + col];
              const float p2 = n >= 2 ? tile[(r - 2) * PT + lc] : (n == 1 ? hist[FF2 + col] : hist[col]);
              cv[hf] = cbp[col] + cw[col] * p2 + cw[FF2 + col] * p1 + cw[2 * FF2 + col] * cur;
              if (n >= 2) F.out[O_FS + ((size_t)b * 2 + n - 2) * FF2 + col] = cur; }
          ((bf16*)(F.ws + WS_ACT))[(size_t)(MP + row) * FF + ch] = (bf16)f2bf(pg8::silu_mul(cv[0], cv[1])); } }
    __syncthreads();
}
__device__ __forceinline__ void mini_down(Frame& F, int tl) {
    LAS float* tile = (LAS float*)(F.lds + RING_OFF); constexpr int PT = 36;
    const int rg = tl >> 5, cg = tl & 31;
    BrLin br{32 * cg};
    mini_mma<2, 8, 4>((const bf16*)(F.ws + WS_ACT), FF, (const bf16*)(F.ws + WS_WDN), br, MP + 64 * rg, tile, PT, F.wave, F.lane);
    __syncthreads();
    const int r = F.tid >> 3, c0 = 4 * (F.tid & 7), row = 64 * rg + r, col = 32 * cg + c0;
    f32x4 a = (f32x4){0.f, 0.f, 0.f, 0.f}, b = (f32x4){0.f, 0.f, 0.f, 0.f};
#pragma unroll
    for (int k2 = 0; k2 < 8; k2 += 2) { a = a + *(const LAS f32x4*)(tile + (k2 * 64 + r) * PT + c0); b = b + *(const LAS f32x4*)(tile + ((k2 + 1) * 64 + r) * PT + c0); }
    const u32x2_t hb = *(const u32x2_t*)((const bf16*)(F.ws + WS_HB) + (size_t)(MP + row) * DM + col);
    const f32x4 hv = (f32x4){__builtin_bit_cast(float, hb.x << 16), __builtin_bit_cast(float, hb.x & 0xffff0000u), __builtin_bit_cast(float, hb.y << 16), __builtin_bit_cast(float, hb.y & 0xffff0000u)};
    *(f32x4*)(F.out + O_Y + (size_t)(MP + row) * DM + col) = hv + a + b;
    __syncthreads();
}
__device__ __forceinline__ void p6_fix_rows(Frame& F) {
    const float* halo = (const float*)(F.ws + WS_HALO); const float* cw = F.in[15]; const float* cbp = F.in[16]; bf16* ACT = (bf16*)(F.ws + WS_ACT);
    for (int it = blockIdx.x; it < NPANEL_P * 2; it += F.G) {
        const int pm = it >> 1, e = it & 1; const bool first = (pm & 7) == 0;
#pragma unroll
        for (int it2 = 0; it2 < 6; ++it2) { const int ch = F.tid + it2 * NWAVES * 64; if (ch < FF) {
            float cv[2];
#pragma unroll
            for (int bj = 0; bj < 2; ++bj) { const int col = bj * FF + ch;
                const float um2 = first ? 0.f : halo[(size_t)((pm - 1) * 4 + 2) * FF2 + col], um1 = first ? 0.f : halo[(size_t)((pm - 1) * 4 + 3) * FF2 + col];
                const float u0 = halo[(size_t)(pm * 4 + 0) * FF2 + col], u1 = halo[(size_t)(pm * 4 + 1) * FF2 + col];
                const float w0 = cw[col], w1 = cw[FF2 + col], w2 = cw[2 * FF2 + col], cb = cbp[col];
                cv[bj] = e == 0 ? cb + w0 * um2 + w1 * um1 + w2 * u0 : cb + w0 * um1 + w1 * u0 + w2 * u1; }
            ACT[(size_t)(pm * 256 + e) * FF + ch] = (bf16)f2bf(pg8::silu_mul(cv[0], cv[1]));
        } }
    }
}


struct Args { const float* in[18]; float* out; unsigned char* ws; int ph_lo, ph_hi, li, pad; };
__global__ void __launch_bounds__(NWAVES * 64, 2) mk_fwd(Args args) {
    extern __shared__ __attribute__((aligned(16))) unsigned char lds[];
    Frame F;
    F.lds = (LAS unsigned char*)lds;
    F.MISC = (volatile LAS unsigned*)(F.lds + MISC_OFF);
    F.tid = threadIdx.x; F.lane = F.tid & 63; F.wave = __builtin_amdgcn_readfirstlane(F.tid >> 6);
    F.G = gridDim.x; { const int bx = blockIdx.x; F.vcu = (F.G % 8 == 0) ? (bx % 8) * (F.G / 8) + bx / 8 : bx; }
    unsigned char* ws = args.ws; F.ws = ws; F.out = args.out;
    F.ctl = (gu32*)(ws + WS_CTL);
#pragma unroll
    for (int i = 0; i < 18; ++i) F.in[i] = args.in[i];
    for (int u = F.tid; u < (LDS_BYTES - LDSCTL_OFF) / 4; u += NWAVES * 64) ((LAS unsigned*)(F.lds + LDSCTL_OFF))[u] = 0u;
    __syncthreads();
    XcdBarrier bar; bar.bar = (unsigned*)(F.ctl + CW_BAR); bar.x = 0; bar.st = nullptr;
    if (N_LAUNCHES != PER_PHASE) bar = xcd_barrier_post((unsigned*)(F.ctl + CW_BAR), F.MISC + 8);
#define GRID_BAR(seam) do { if (N_LAUNCHES == PER_PHASE) { if (F.tid == 0) __hip_atomic_store(F.ctl + CW_TMO, 0xBADBA0u | (unsigned)(seam), RLX_AGENT); } else { xcd_barrier(bar); } } while (0)
    const int lo = args.ph_lo, hi = args.ph_hi;
#ifndef PH_MASK
#define PH_MASK 127
#endif
#define IN(k) ((((PH_MASK) >> (k)) & 1) && lo <= (k) && (k) < hi)
#define BOTH(k) (IN(k) && IN((k) + 1))
    bf16* const XN = (bf16*)(ws + WS_XN); bf16* const QB = (bf16*)(ws + WS_Q); bf16* const MIX = (bf16*)(ws + WS_MIX); bf16* const HB = (bf16*)(ws + WS_HB); bf16* const ACT = (bf16*)(ws + WS_ACT);

    if (IN(0)) { p0_prologue(F); if (BOTH(0)) GRID_BAR(0); }

    if (IN(1)) {
        pg8::Gemm g{XN, (const bf16*)(ws + WS_WIN), MP, PJ, DM}; pg8::StaticOrder S; S.init(MP, PJ, F.G, (int)blockIdx.x);
        pg8::EpiInProj E{QB, QKVU_STRIDE / 2, F.out, F.in[8], F.in[9]};
        pg8::gemm_phase<pg8::EpiInProj, pg8::StaticOrder, true, true>(F.lds + RING_OFF, g, S, E);
        for (int tl = blockIdx.x; tl < 256; tl += F.G) mini_inproj(F, tl);
        if (BOTH(1)) GRID_BAR(1);
    }

    if (IN(2)) { p2_attn(F); if (BOTH(2)) GRID_BAR(2); }

    if (IN(3)) {
        pg8::Gemm g{MIX, (const bf16*)(ws + WS_WOUT), MP, DM, DM}; pg8::StaticOrder S; S.init(MP, DM, F.G, (int)blockIdx.x);
        pg8::EpiOutProj E{F.in[0], HB, (float*)(ws + WS_SSP), (PG8_LAS float*)(F.lds + TAB_OFF)};
        pg8::gemm_phase<pg8::EpiOutProj, pg8::StaticOrder, true, true>(F.lds + RING_OFF, g, S, E);
        for (int tl = blockIdx.x; tl < 256; tl += F.G) mini_outproj(F, tl);
        if (BOTH(3)) GRID_BAR(3);
    }

    if (IN(4)) {
        pg8::Gemm g{HB, (const bf16*)(ws + WS_WUP), MP, FF2, DM}; pg8::StaticOrder S; S.init(MP, FF2, F.G, (int)blockIdx.x);
        pg8::EpiUp E{ACT, (const float*)(ws + WS_SSP), (float*)(ws + WS_HALO), F.out, F.in[15], F.in[16], (PG8_LAS float*)(F.lds + TAB_OFF)};
        pg8::gemm_phase<pg8::EpiUp, pg8::StaticOrder, true, true>(F.lds + RING_OFF, g, S, E);
        for (int tl = blockIdx.x; tl < 256; tl += F.G) mini_up(F, tl);
        if (BOTH(4)) GRID_BAR(4);
    }

    if (IN(5)) { p6_fix_rows(F); if (BOTH(5)) GRID_BAR(5); }

    if (IN(6)) {
        pg8::Gemm g{ACT, (const bf16*)(ws + WS_WDN), MP, DM, FF}; pg8::StaticOrder S; S.init(MP, DM, F.G, (int)blockIdx.x);
        pg8::EpiDown E{F.out + O_Y, HB};
        pg8::gemm_phase<pg8::EpiDown, pg8::StaticOrder, true, true>(F.lds + RING_OFF, g, S, E);
        for (int tl = blockIdx.x; tl < 256; tl += F.G) mini_down(F, tl);
    }
#undef IN
#undef BOTH
}

extern "C" void kernel_launch(void* const* d_in, const int* in_sizes, int n_in, void* d_out, int out_size, void* d_ws, size_t ws_size, hipStream_t stream) {
    static int grid = 0;
    if (grid == 0) {
        if (n_in != 18 || in_sizes[0] != MP * DM || out_size != (int)O_END || ws_size < WS_END) { fprintf(stderr, "kernel_launch: unexpected shapes: n_in %d, in0 %d, out %d, ws %zu (need %zu); nothing launched\n", n_in, n_in > 0 ? in_sizes[0] : -1, out_size, ws_size, (size_t)WS_END); grid = -1; return; }
        int dev = 0, cus = 0, per_cu = 0;
        if (hipGetDevice(&dev) != hipSuccess || hipDeviceGetAttribute(&cus, hipDeviceAttributeMultiprocessorCount, dev) != hipSuccess) { fprintf(stderr, "kernel_launch: hipGetDevice / hipDeviceGetAttribute failed\n"); grid = -1; return; }
        if (hipFuncSetAttribute((const void*)mk_fwd, hipFuncAttributeMaxDynamicSharedMemorySize, LDS_BYTES) != hipSuccess) { fprintf(stderr, "kernel_launch: hipFuncSetAttribute failed\n"); grid = -1; return; }
        if (hipOccupancyMaxActiveBlocksPerMultiprocessor(&per_cu, (const void*)mk_fwd, NWAVES * 64, LDS_BYTES) != hipSuccess || per_cu < 1)
            fprintf(stderr, "kernel_launch: note: occupancy query reports %d workgroups per CU\n", per_cu);
        (void)hipGetLastError();
        grid = cus;
    }
    if (grid < 0) return;
    if (hipMemsetAsync((char*)d_ws + WS_CTL, 0, CTL_ZERO_BYTES, stream) != hipSuccess) { fprintf(stderr, "kernel_launch: hipMemsetAsync failed\n"); return; }
    Args a{};
    for (int i = 0; i < 18; ++i) a.in[i] = (const float*)d_in[i];
    a.out = (float*)d_out; a.ws = (unsigned char*)d_ws;
    static_assert(N_LAUNCHES == 1 || N_LAUNCHES == PER_PHASE, "-DMK_N_LAUNCHES must be 1 or 7");
    for (int li = 0; li < N_LAUNCHES; ++li) {
        a.ph_lo = (N_LAUNCHES == PER_PHASE) ? li : 0; a.ph_hi = (N_LAUNCHES == PER_PHASE) ? li + 1 : PER_PHASE; a.li = li;
        hipLaunchKernelGGL(mk_fwd, dim3(grid), dim3(NWAVES * 64), LDS_BYTES, stream, a);
        const hipError_t le = hipPeekAtLastError();
        if (le != hipSuccess) { fprintf(stderr, "kernel_launch: launch %d failed: %s\n", li, hipGetErrorName(le)); break; }
    }
}
```

```cpp
#include <hip/hip_runtime.h>
#include <hip/hip_bf16.h>
#include <cstdio>
#include <cstdint>
#ifndef MK_N_LAUNCHES
#define MK_N_LAUNCHES 1
#endif
constexpr int DM = 1024, NB = 16, SEQ = 2048, DB = 128, DS = 4;
constexpr int NH = 8, AW = 512, PJ = 2048, FF = 2816, FF2 = 5632;
constexpr int MP = NB * SEQ, MS = DB * DS, M = MP + MS;
constexpr int NPANEL = M / 256, NPANEL_P = MP / 256;
constexpr float EPS = 1e-6f;
constexpr float QSCALE = 0.125f * 1.4426950408889634f;
constexpr size_t O_Y = 0, O_KP = 34078720, O_VP = 50855936, O_PP = 67633152, O_FP = 67756032, O_KS = 67936256, O_VS = 68198400, O_PS = 68460544, O_FS = 69443584, O_END = 70885376;
namespace pg8 {
#define PG8_LAS __attribute__((address_space(3)))
typedef unsigned short bf16_t;
typedef short bf16x8 __attribute__((ext_vector_type(8)));
typedef float f32x4 __attribute__((ext_vector_type(4)));
typedef unsigned u32x4 __attribute__((ext_vector_type(4)));
constexpr int BM = 256, BK = 64, HALF = 128, HTB = HALF * BK * 2  , STAGE_BYTES = 8 * HTB, NXCD = 8, WGM = 8;

__host__ __device__ __forceinline__ int lds_byte(int r, int c) { const int st = (r >> 4) * 2 + (c >> 5), rr = r & 15, cc = c & 31, ob = rr * 64 + cc * 2; return st * 1024 + (ob ^ (((ob >> 9) & 1) << 5)); }
__host__ __device__ __forceinline__ void stage_rc(int b, int& R, int& C) { const int st = b / 1024, sb = b % 1024, swz = sb ^ (((sb >> 9) & 1) << 5); R = (st >> 1) * 16 + swz / 64; C = (st & 1) * 32 + (swz % 64) / 2; }
__host__ __device__ __forceinline__ int perm32(int rho) { const int n = rho >> 4, i = rho & 15; return 8 * (i >> 2) + 4 * n + (i & 3); }

struct Unit { int pm, pn; };
struct Gemm { const bf16_t* A; const bf16_t* Bt; int M, N, K; };

struct StaticOrder {
    int nM, nN, nwg, G, c;
    __host__ __device__ void init(int M, int N, int G_, int c_) { nM = M / BM; nN = N / BM; nwg = nM * nN; G = G_; c = c_; }
    __host__ __device__ bool next(int i, Unit& u) const {
        const long L = (long)i * G + c; if (L >= nwg) return false;
        int wgid = (int)L; { const int q = nwg / NXCD, r = nwg % NXCD, xcd = wgid % NXCD, off = wgid / NXCD; wgid = (xcd < r ? xcd * (q + 1) : r * (q + 1) + (xcd - r) * q) + off; }
        const int nig = WGM * nN, gid = wgid / nig, fm = gid * WGM, gsz = (nM - fm) < WGM ? (nM - fm) : WGM;
        u.pm = fm + ((wgid % nig) % gsz); u.pn = (wgid % nig) / gsz; return true;
    }
    __device__ __forceinline__ void a_ready(const Unit&) const {}
    __device__ __forceinline__ void done(const Unit&) const {}
};

typedef float f32x2c __attribute__((ext_vector_type(2))); typedef __bf16 bf16x2c __attribute__((ext_vector_type(2)));
__device__ __forceinline__ unsigned cvt_pk_bf16(float lo, float hi) { const f32x2c v = {lo, hi}; const bf16x2c b = __builtin_convertvector(v, bf16x2c); return __builtin_bit_cast(unsigned, b); }
typedef float f32x2 __attribute__((ext_vector_type(2)));
typedef unsigned u32x2 __attribute__((ext_vector_type(2)));
__device__ __forceinline__ float dpp_ror1(float v) { return __builtin_bit_cast(float, __builtin_amdgcn_update_dpp(0, __builtin_bit_cast(int, v), 0x121, 0xf, 0xf, false)); }
__device__ __forceinline__ float dpp_ror2(float v) { return __builtin_bit_cast(float, __builtin_amdgcn_update_dpp(0, __builtin_bit_cast(int, v), 0x122, 0xf, 0xf, false)); }
__device__ __forceinline__ f32x4 ror1v(f32x4 v) { return (f32x4){dpp_ror1(v[0]), dpp_ror1(v[1]), dpp_ror1(v[2]), dpp_ror1(v[3])}; }
__device__ __forceinline__ f32x4 ror2v(f32x4 v) { return (f32x4){dpp_ror2(v[0]), dpp_ror2(v[1]), dpp_ror2(v[2]), dpp_ror2(v[3])}; }
__device__ __forceinline__ float silu_mul(float g, float v) { return g * v * __builtin_amdgcn_rcpf(1.0f + __builtin_amdgcn_exp2f(-1.4426950408889634f * g)); }

struct EpiInProj {
    static constexpr bool PERM = true, AFTER_DRAIN = false, STAGED = false;
    bf16_t* QKVU; size_t tstride; float* out; const float* gq; const float* gk;
    __device__ __forceinline__ void operator()(f32x4 (&acc)[2][2][4][2], const Unit& u, int wr, int wc, int fr, int fq) const {
        const int type = u.pn >> 1, half = u.pn & 1;
        const int cbase = half * 256 + wc * 64 + 8 * fq;
        bf16_t* dst = QKVU + (size_t)type * tstride;
        f32x4 gv[2][2];
        if (type < 2) { const float* gs = (type == 0 ? gq : gk) + (half * 4 + wc) * 64 + 8 * fq; const float qs = type == 0 ? QSCALE : 1.0f;
#pragma unroll
            for (int bj = 0; bj < 2; ++bj)
#pragma unroll
                for (int n = 0; n < 2; ++n) gv[bj][n] = *(const f32x4*)(gs + 32 * bj + 4 * n) * qs; }
#pragma unroll
        for (int ai = 0; ai < 2; ++ai)
#pragma unroll
            for (int m = 0; m < 4; ++m) {
                const int row = u.pm * BM + ai * HALF + wr * 64 + m * 16 + fr;
                f32x4 v[2][2];
#pragma unroll
                for (int bj = 0; bj < 2; ++bj)
#pragma unroll
                    for (int n = 0; n < 2; ++n) v[bj][n] = acc[ai][bj][m][n];
                if (type < 2) {
                    float ss = 0.f;
#pragma unroll
                    for (int bj = 0; bj < 2; ++bj)
#pragma unroll
                        for (int n = 0; n < 2; ++n) { const f32x4 x = v[bj][n]; ss += (x[0] * x[0] + x[1] * x[1]) + (x[2] * x[2] + x[3] * x[3]); }
                    ss += __shfl_xor(ss, 16); ss += __shfl_xor(ss, 32);
                    const float r = 1.0f / sqrtf(ss * (1.0f / 64.0f) + EPS);
#pragma unroll
                    for (int bj = 0; bj < 2; ++bj)
#pragma unroll
                        for (int n = 0; n < 2; ++n) v[bj][n] = v[bj][n] * r * gv[bj][n];
                }
                bf16_t* rowp = dst + (size_t)row * 512 + cbase;
#pragma unroll
                for (int bj = 0; bj < 2; ++bj) { u32x4 w; w.x = cvt_pk_bf16(v[bj][0][0], v[bj][0][1]); w.y = cvt_pk_bf16(v[bj][0][2], v[bj][0][3]); w.z = cvt_pk_bf16(v[bj][1][0], v[bj][1][1]); w.w = cvt_pk_bf16(v[bj][1][2], v[bj][1][3]);
                    *(u32x4*)(rowp + 32 * bj) = w; }
                if (type == 1 || type == 2) {
                    float* o = out + (type == 1 ? O_KP : O_VP) + (size_t)row * 512 + cbase;
#pragma unroll
                    for (int bj = 0; bj < 2; ++bj) { __builtin_nontemporal_store(v[bj][0], (f32x4*)(o + 32 * bj)); __builtin_nontemporal_store(v[bj][1], (f32x4*)(o + 32 * bj + 4)); }
                } else if (type == 3) {
                    float* o = nullptr;
                    { const int t = row & (SEQ - 1); if (t >= SEQ - 15) o = out + O_PP + ((size_t)(row >> 11) * 15 + (t - (SEQ - 15))) * 512 + cbase; }
                    if (o) {
#pragma unroll
                        for (int bj = 0; bj < 2; ++bj) { *(f32x4*)(o + 32 * bj) = v[bj][0]; *(f32x4*)(o + 32 * bj + 4) = v[bj][1]; } }
                }
            }
    }
};

struct EpiOutProj {
    static constexpr bool PERM = true, AFTER_DRAIN = false, STAGED = false;
    const float* xp; bf16_t* HB; float* ssp; PG8_LAS float* tab;
    __device__ __forceinline__ void operator()(f32x4 (&acc)[2][2][4][2], const Unit& u, int wr, int wc, int fr, int fq) const {
        const size_t off0 = (size_t)(u.pm * BM + wr * 64 + fr) * DM + u.pn * BM + wc * 32 + 8 * fq;
#pragma unroll
        for (int ai = 0; ai < 2; ++ai) {
            f32x4 xv[4][2][2];
#pragma unroll
            for (int m = 0; m < 4; ++m)
#pragma unroll
                for (int bj = 0; bj < 2; ++bj) { const float* xr = xp + off0 + (size_t)(ai * HALF + m * 16) * DM + bj * HALF; xv[m][bj][0] = __builtin_nontemporal_load((const f32x4*)xr); xv[m][bj][1] = __builtin_nontemporal_load((const f32x4*)(xr + 4)); }
            __builtin_amdgcn_sched_barrier(0);
#pragma unroll
            for (int m = 0; m < 4; ++m) {
                const int lrow = ai * HALF + wr * 64 + m * 16 + fr;
                float part = 0.f;
#pragma unroll
                for (int bj = 0; bj < 2; ++bj) {
                    const f32x4 h0 = xv[m][bj][0] + acc[ai][bj][m][0], h1 = xv[m][bj][1] + acc[ai][bj][m][1];
                    u32x4 w; w.x = cvt_pk_bf16(h0[0], h0[1]); w.y = cvt_pk_bf16(h0[2], h0[3]); w.z = cvt_pk_bf16(h1[0], h1[1]); w.w = cvt_pk_bf16(h1[2], h1[3]);
                    *(u32x4*)(HB + off0 + (size_t)(ai * HALF + m * 16) * DM + bj * HALF) = w;
                    part += (h0[0] * h0[0] + h0[1] * h0[1]) + (h0[2] * h0[2] + h0[3] * h0[3]) + (h1[0] * h1[0] + h1[1] * h1[1]) + (h1[2] * h1[2] + h1[3] * h1[3]);
                }
                part += __shfl_xor(part, 16); part += __shfl_xor(part, 32);
                if (fq == 0) tab[lrow * 4 + wc] = part;
            }
            __builtin_amdgcn_sched_barrier(0);
        }
        asm volatile("s_waitcnt lgkmcnt(0)" ::: "memory"); __builtin_amdgcn_s_barrier(); asm volatile("" ::: "memory");
        const int tid = (wr * 4 + wc) * 64 + fq * 16 + fr;
        if (tid < BM) { const f32x4 t = *(const PG8_LAS f32x4*)(tab + tid * 4); ssp[(size_t)(u.pm * BM + tid) * 4 + u.pn] = (t[0] + t[1]) + (t[2] + t[3]); }
    }
};

struct EpiUp {
    static constexpr bool PERM = true, AFTER_DRAIN = false, STAGED = true;
    bf16_t* ACT; const float* ssp; float* halo; float* out; const float* convw; const float* convb; PG8_LAS float* tab; PG8_LAS unsigned char* epf;
    __device__ __forceinline__ void stage(const Unit& u, int slot, int wid, int lane) const {
        const float* src;
        if (wid < 4) src = ssp + (size_t)(u.pm * BM + wid * 64 + lane) * 4;
        else { const int sl = 2 * (wid - 4) + (lane >> 5), arr = sl >> 1, bj = sl & 1; src = (arr < 3 ? convw + arr * FF2 : convb) + bj * FF + u.pn * 128 + 4 * (lane & 31); }
        __builtin_amdgcn_global_load_lds((const unsigned*)src, (PG8_LAS unsigned*)(epf + slot * 8192 + wid * 1024), 16, 0, 0);
    }
    __device__ __forceinline__ void run(f32x4 (&acc)[2][2][4][2], const Unit& u, int slot, int wr, int wc, int fr, int fq) const {
        const int chb = 32 * wc + 8 * fq, ch0 = u.pn * 128 + chb;
        const PG8_LAS unsigned char* sl = epf + slot * 8192;
#pragma unroll
        for (int ai = 0; ai < 2; ++ai)
#pragma unroll
            for (int m = 0; m < 4; ++m) {
                const int row = u.pm * BM + ai * HALF + wr * 64 + m * 16 + fr;
                const f32x4 t = *(const PG8_LAS f32x4*)(sl + 16 * (ai * HALF + wr * 64 + m * 16 + fr));
                const float rr = 1.0f / sqrtf(((t[0] + t[1]) + (t[2] + t[3])) * (1.0f / DM) + EPS);
#pragma unroll
                for (int bj = 0; bj < 2; ++bj)
#pragma unroll
                    for (int n = 0; n < 2; ++n) acc[ai][bj][m][n] = acc[ai][bj][m][n] * rr;
            }
        if (fr >= 14) {
#pragma unroll
            for (int ai = 0; ai < 2; ++ai)
#pragma unroll
                for (int bj = 0; bj < 2; ++bj)
#pragma unroll
                    for (int n = 0; n < 2; ++n) *(PG8_LAS f32x4*)(tab + ((ai * 2 + wr) * 2 + (fr - 14)) * 256 + bj * 128 + chb + 4 * n) = acc[ai][bj][3][n];
        }
        {
            if (wr == 0 && fr < 2) {
#pragma unroll
                for (int bj = 0; bj < 2; ++bj)
#pragma unroll
                    for (int n = 0; n < 2; ++n) *(f32x4*)(halo + (size_t)(u.pm * 4 + fr) * FF2 + bj * FF + ch0 + 4 * n) = acc[0][bj][0][n];
            }
            if (wr == 1 && fr >= 14) {
#pragma unroll
                for (int bj = 0; bj < 2; ++bj)
#pragma unroll
                    for (int n = 0; n < 2; ++n) { *(f32x4*)(halo + (size_t)(u.pm * 4 + 2 + fr - 14) * FF2 + bj * FF + ch0 + 4 * n) = acc[1][bj][3][n];
                        if ((u.pm & 7) == 7) *(f32x4*)(out + O_FP + (size_t)((u.pm >> 3) * 2 + fr - 14) * FF2 + bj * FF + ch0 + 4 * n) = acc[1][bj][3][n]; }
            }
        }
        asm volatile("s_waitcnt lgkmcnt(0)" ::: "memory"); __builtin_amdgcn_s_barrier(); asm volatile("" ::: "memory");
#pragma unroll
        for (int n = 0; n < 2; ++n) {
            f32x4 w0[2], w1[2], w2[2], cb[2];
#pragma unroll
            for (int bj = 0; bj < 2; ++bj) { const PG8_LAS unsigned char* cp = sl + 4096 + bj * 512 + (chb + 4 * n) * 4; w0[bj] = *(const PG8_LAS f32x4*)cp; w1[bj] = *(const PG8_LAS f32x4*)(cp + 1024); w2[bj] = *(const PG8_LAS f32x4*)(cp + 2048); cb[bj] = *(const PG8_LAS f32x4*)(cp + 3072); }
#pragma unroll
            for (int ai = 0; ai < 2; ++ai) {
                f32x4 pv[2];
                {
                    const int sb = (wr == 1) ? ai * 2 : 1;
#pragma unroll
                    for (int bj = 0; bj < 2; ++bj) { pv[bj] = (f32x4){0.f, 0.f, 0.f, 0.f}; if (fr >= 14) pv[bj] = *(const PG8_LAS f32x4*)(tab + (sb * 2 + (fr - 14)) * 256 + bj * 128 + chb + 4 * n); }
                }
#pragma unroll
                for (int m = 0; m < 4; ++m) {
                    const int row = u.pm * BM + ai * HALF + wr * 64 + m * 16 + fr;
                    f32x4 cv[2];
                    {
#pragma unroll
                        for (int bj = 0; bj < 2; ++bj) { const f32x4 cur = acc[ai][bj][m][n]; const f32x4 prv = m > 0 ? acc[ai][bj][m - 1][n] : pv[bj];
                            const f32x4 p1 = ror1v(fr == 15 ? prv : cur), p2 = ror2v(fr >= 14 ? prv : cur);
                            cv[bj] = cb[bj] + w0[bj] * p2 + w1[bj] * p1 + w2[bj] * cur; }
                    }
                    u32x2 w; w.x = cvt_pk_bf16(silu_mul(cv[0][0], cv[1][0]), silu_mul(cv[0][1], cv[1][1])); w.y = cvt_pk_bf16(silu_mul(cv[0][2], cv[1][2]), silu_mul(cv[0][3], cv[1][3]));
                    const bool skip = ai == 0 && m == 0 && wr == 0 && fr < 2;
                    if (!skip) *(u32x2*)(ACT + (size_t)row * FF + ch0 + 4 * n) = w;
                }
            }
        }
    }
};

struct EpiDown {
    static constexpr bool PERM = true, AFTER_DRAIN = false, STAGED = false;
    float* Y; const bf16_t* HB;
    __device__ __forceinline__ void operator()(f32x4 (&acc)[2][2][4][2], const Unit& u, int wr, int wc, int fr, int fq) const {
        const size_t off0 = (size_t)(u.pm * BM + wr * 64 + fr) * DM + u.pn * BM + wc * 32 + 8 * fq;
        u32x4 hb[2][4][2];
#pragma unroll
        for (int ai = 0; ai < 2; ++ai)
#pragma unroll
            for (int m = 0; m < 4; ++m)
#pragma unroll
                for (int bj = 0; bj < 2; ++bj) hb[ai][m][bj] = *(const u32x4*)(HB + off0 + (size_t)(ai * HALF + m * 16) * DM + bj * HALF);
        __builtin_amdgcn_sched_barrier(0);
#pragma unroll
        for (int ai = 0; ai < 2; ++ai)
#pragma unroll
            for (int m = 0; m < 4; ++m)
#pragma unroll
                for (int bj = 0; bj < 2; ++bj) { const u32x4 h = hb[ai][m][bj]; float* yo = Y + off0 + (size_t)(ai * HALF + m * 16) * DM + bj * HALF;
                    const f32x4 a = (f32x4){__builtin_bit_cast(float, h.x << 16), __builtin_bit_cast(float, h.x & 0xffff0000u), __builtin_bit_cast(float, h.y << 16), __builtin_bit_cast(float, h.y & 0xffff0000u)} + acc[ai][bj][m][0];
                    const f32x4 b = (f32x4){__builtin_bit_cast(float, h.z << 16), __builtin_bit_cast(float, h.z & 0xffff0000u), __builtin_bit_cast(float, h.w << 16), __builtin_bit_cast(float, h.w & 0xffff0000u)} + acc[ai][bj][m][1];
                    __builtin_nontemporal_store(a, (f32x4*)yo); __builtin_nontemporal_store(b, (f32x4*)(yo + 4)); }
    }
};

template <class Epi, class Sched, bool ALIGN_EPI = false, bool SP2 = false>
__device__ __forceinline__ void gemm_phase(PG8_LAS unsigned char* lds, const Gemm g, const Sched& S, const Epi& E) {
    const int tid = threadIdx.x, wid = __builtin_amdgcn_readfirstlane(tid >> 6), lane = tid & 63, wr = wid >> 2, wc = wid & 3, fr = lane & 15, fq = lane >> 4;
    const int K = g.K, nt = K / BK;
    unsigned voffA[2], voffB[2];
#pragma unroll
    for (int i = 0; i < 2; ++i) { int R, C; stage_rc(tid * 16 + i * 8192, R, C); const int Rb = Epi::PERM ? ((R & ~31) + perm32(R & 31)) : R;
        voffA[i] = (unsigned)(R * K + C) * 2u; voffB[i] = (unsigned)(Rb * K + C) * 2u; }
    const size_t kstep = (size_t)(BK * 2);
    const size_t hstep = (size_t)HALF * K * 2;
    const size_t tstep = 2 * hstep;
    const unsigned ldsw = (unsigned)wid * 1024u;
    const int aoff = lds_byte(wr * 64 + fr, fq * 8), boff = lds_byte(wc * 32 + fr, fq * 8);
#define PG8_SA(b, h) (((b) * 2 + (h)) * HTB)
#define PG8_SB(b, h) ((4 + (b) * 2 + (h)) * HTB)
#define PG8_STAGE(bufoff, gbase, voff) do { _Pragma("unroll") for (int _i = 0; _i < 2; ++_i) \
        __builtin_amdgcn_global_load_lds((const unsigned*)((const char*)(gbase) + (voff)[_i]), (PG8_LAS unsigned*)(lds + (bufoff) + ldsw + _i * 8192), 16, 0, 0); } while (0)
#define PG8_LDA(dst, b, h) do { _Pragma("unroll") for (int m = 0; m < 4; ++m) _Pragma("unroll") for (int k = 0; k < 2; ++k) dst[m][k] = *(const PG8_LAS bf16x8*)(lds + PG8_SA(b, h) + aoff + m * 2048 + k * 1024); } while (0)
#define PG8_LDB(dst, b, h) do { _Pragma("unroll") for (int n = 0; n < 2; ++n) _Pragma("unroll") for (int k = 0; k < 2; ++k) dst[n][k] = *(const PG8_LAS bf16x8*)(lds + PG8_SB(b, h) + boff + n * 2048 + k * 1024); } while (0)
#define PG8_MMA(ai, bj, At, Bt) do { __builtin_amdgcn_s_setprio(1); _Pragma("unroll") for (int m = 0; m < 4; ++m) _Pragma("unroll") for (int n = 0; n < 2; ++n) _Pragma("unroll") for (int k = 0; k < 2; ++k) \
        acc[ai][bj][m][n] = __builtin_amdgcn_mfma_f32_16x16x32_bf16(Bt[n][k], At[m][k], acc[ai][bj][m][n], 0, 0, 0); __builtin_amdgcn_s_setprio(0); } while (0)
#define PG8_WAIT_V(n) asm volatile("s_waitcnt vmcnt(" #n ")" ::: "memory")
#define PG8_WAIT_L(n) asm volatile("s_waitcnt lgkmcnt(" #n ")" ::: "memory")
#define PG8_BAR __builtin_amdgcn_s_barrier()
#define PG8_SCHED __builtin_amdgcn_sched_barrier(0)
    Unit cur, nxt; int ui = 0;
    if (!S.next(0, cur)) return;
    if constexpr (Epi::STAGED) E.stage(cur, 0, wid, lane);
    f32x4 acc[2][2][4][2];
#pragma unroll
    for (int a = 0; a < 2; ++a)
#pragma unroll
        for (int b = 0; b < 2; ++b)
#pragma unroll
            for (int m = 0; m < 4; ++m)
#pragma unroll
                for (int n = 0; n < 2; ++n) acc[a][b][m][n] = (f32x4){0.f, 0.f, 0.f, 0.f};
    bf16x8 At[4][2], B0[2][2], B1[2][2];
    const char* cA = (const char*)g.A + (size_t)cur.pm * tstep; const char* cB = (const char*)g.Bt + (size_t)cur.pn * tstep;
    S.a_ready(cur);
    if constexpr (SP2) {
        PG8_STAGE(PG8_SB(0, 0), cB, voffB); PG8_STAGE(PG8_SB(0, 1), cB + hstep, voffB); PG8_STAGE(PG8_SA(0, 0), cA, voffA); PG8_STAGE(PG8_SA(0, 1), cA + hstep, voffA);
        if (wr == 1) PG8_BAR;
        PG8_WAIT_V(2); PG8_BAR;
        PG8_STAGE(PG8_SB(1, 0), cB + kstep, voffB); PG8_STAGE(PG8_SA(1, 0), cA + kstep, voffA); PG8_STAGE(PG8_SB(1, 1), cB + hstep + kstep, voffB);
        PG8_WAIT_V(6); PG8_BAR;
    } else {
        PG8_STAGE(PG8_SB(0, 0), cB, voffB); PG8_STAGE(PG8_SA(0, 0), cA, voffA); PG8_STAGE(PG8_SB(0, 1), cB + hstep, voffB); PG8_STAGE(PG8_SA(0, 1), cA + hstep, voffA);
        if (wr == 1) PG8_BAR;
        PG8_WAIT_V(4); PG8_BAR;
        PG8_STAGE(PG8_SB(1, 0), cB + kstep, voffB); PG8_STAGE(PG8_SA(1, 0), cA + kstep, voffA); PG8_STAGE(PG8_SB(1, 1), cB + hstep + kstep, voffB);
        PG8_WAIT_V(6); PG8_BAR;
    }
    for (;;) {
        const bool has_next = S.next(ui + 1, nxt);
        const char* nA = has_next ? (const char*)g.A + (size_t)nxt.pm * tstep : cA; const char* nB = has_next ? (const char*)g.Bt + (size_t)nxt.pn * tstep : cB;
        for (int t = 0; t < nt; t += 2) {
            const bool last = (t == nt - 2);
            const char* a1 = cA + (size_t)(t + 1) * kstep;
            const char* a2 = last ? nA : cA + (size_t)(t + 2) * kstep; const char* b2 = last ? nB : cB + (size_t)(t + 2) * kstep;
            const char* a3 = a2 + kstep; const char* b3 = b2 + kstep;
            if (last && has_next) S.a_ready(nxt);
            if constexpr (SP2) {
            PG8_LDB(B0, 0, 0); PG8_LDB(B1, 0, 1); PG8_SCHED; PG8_LDA(At, 0, 0); PG8_STAGE(PG8_SA(1, 1), a1 + hstep, voffA);
            PG8_WAIT_V(8); PG8_WAIT_L(0); PG8_BAR; PG8_MMA(0, 0, At, B0); PG8_MMA(0, 1, At, B1); PG8_BAR; PG8_SCHED;
            PG8_LDA(At, 0, 1); PG8_STAGE(PG8_SB(0, 0), b2, voffB); PG8_STAGE(PG8_SB(0, 1), b2 + hstep, voffB); PG8_STAGE(PG8_SA(0, 0), a2, voffA);
            PG8_WAIT_V(8); PG8_WAIT_L(0); PG8_BAR; PG8_MMA(1, 0, At, B0); PG8_MMA(1, 1, At, B1); PG8_BAR; PG8_SCHED;
            PG8_LDB(B0, 1, 0); PG8_LDB(B1, 1, 1); PG8_SCHED; PG8_LDA(At, 1, 0); PG8_STAGE(PG8_SA(0, 1), a2 + hstep, voffA);
            PG8_WAIT_V(8); PG8_WAIT_L(0); PG8_BAR; PG8_MMA(0, 0, At, B0); PG8_MMA(0, 1, At, B1); PG8_BAR; PG8_SCHED;
            PG8_LDA(At, 1, 1); PG8_STAGE(PG8_SB(1, 0), b3, voffB); PG8_STAGE(PG8_SB(1, 1), b3 + hstep, voffB); PG8_STAGE(PG8_SA(1, 0), a3, voffA);
            PG8_WAIT_V(8); PG8_WAIT_L(0); PG8_BAR; PG8_MMA(1, 0, At, B0); PG8_MMA(1, 1, At, B1); PG8_BAR; PG8_SCHED;
            } else {
            PG8_LDB(B0, 0, 0); PG8_SCHED; PG8_LDA(At, 0, 0); PG8_STAGE(PG8_SA(1, 1), a1 + hstep, voffA);
            PG8_WAIT_L(8); PG8_BAR; PG8_WAIT_L(0); PG8_MMA(0, 0, At, B0); PG8_BAR; PG8_SCHED;
            PG8_LDB(B1, 0, 1); PG8_STAGE(PG8_SB(0, 0), b2, voffB);
            PG8_BAR; PG8_WAIT_L(0); PG8_MMA(0, 1, At, B1); PG8_BAR;
            PG8_LDA(At, 0, 1); PG8_STAGE(PG8_SA(0, 0), a2, voffA);
            PG8_BAR; PG8_WAIT_L(0); PG8_MMA(1, 0, At, B0); PG8_BAR; PG8_SCHED;
            PG8_STAGE(PG8_SB(0, 1), b2 + hstep, voffB);
            PG8_WAIT_V(6); PG8_BAR; PG8_MMA(1, 1, At, B1); PG8_BAR;
            PG8_LDB(B0, 1, 0); PG8_SCHED; PG8_LDA(At, 1, 0); PG8_STAGE(PG8_SA(0, 1), a2 + hstep, voffA);
            PG8_WAIT_L(8); PG8_BAR; PG8_WAIT_L(0); PG8_MMA(0, 0, At, B0); PG8_BAR; PG8_SCHED;
            PG8_LDB(B1, 1, 1); PG8_STAGE(PG8_SB(1, 0), b3, voffB);
            PG8_BAR; PG8_WAIT_L(0); PG8_MMA(0, 1, At, B1); PG8_BAR;
            PG8_LDA(At, 1, 1); PG8_STAGE(PG8_SA(1, 0), a3, voffA);
            PG8_BAR; PG8_WAIT_L(0); PG8_MMA(1, 0, At, B0); PG8_BAR; PG8_SCHED;
            PG8_STAGE(PG8_SB(1, 1), b3 + hstep, voffB);
            PG8_WAIT_V(6); PG8_BAR; PG8_MMA(1, 1, At, B1); PG8_BAR;
            }
        }
        if constexpr (ALIGN_EPI) { if (wr == 0) PG8_BAR; }
        if constexpr (Epi::STAGED) { if (has_next) E.stage(nxt, (ui + 1) & 1, wid, lane); E.run(acc, cur, ui & 1, wr, wc, fr, fq); S.done(cur); }
        else if constexpr (!Epi::AFTER_DRAIN) { E(acc, cur, wr, wc, fr, fq); S.done(cur); }
        if (!has_next) break;
#pragma unroll
        for (int a = 0; a < 2; ++a)
#pragma unroll
            for (int b = 0; b < 2; ++b)
#pragma unroll
                for (int m = 0; m < 4; ++m)
#pragma unroll
                    for (int n = 0; n < 2; ++n) acc[a][b][m][n] = (f32x4){0.f, 0.f, 0.f, 0.f};
        cur = nxt; cA = nA; cB = nB; ++ui;
        if constexpr (ALIGN_EPI) { if (wr == 1) PG8_BAR; }
    }
    PG8_WAIT_V(0);
    if constexpr (!ALIGN_EPI) { if (wr == 0) PG8_BAR; }
    PG8_BAR;
    if constexpr (Epi::AFTER_DRAIN) { E.fused(acc, cur, wr, wc, fr, fq, lds, wid, lane); S.done(cur); }
#undef PG8_SA
#undef PG8_SB
#undef PG8_STAGE
#undef PG8_LDA
#undef PG8_LDB
#undef PG8_MMA
#undef PG8_WAIT_V
#undef PG8_WAIT_L
#undef PG8_BAR
#undef PG8_SCHED
}
}

constexpr int NWAVES = 8;
constexpr int N_LAUNCHES = MK_N_LAUNCHES;
constexpr int PER_PHASE = 7;
constexpr size_t MiB = 1u << 20;
constexpr size_t WS_CTL = 0, CTL_ZERO_BYTES = 64 * 1024;
constexpr size_t WS_WIN = 2 * MiB, WS_WOUT = 6 * MiB, WS_WUP = 8 * MiB, WS_WDN = 20 * MiB, WS_WPOOL = 26 * MiB;
constexpr size_t WS_HALO = 28 * MiB;
constexpr size_t WS_SSP = 40 * MiB;
constexpr size_t WS_SSPS = 42 * MiB;
constexpr size_t WS_XN = 44 * MiB;
constexpr size_t WS_Q = 110 * MiB, QKVU_STRIDE = 33 * MiB;
constexpr size_t WS_MIX = 242 * MiB;
constexpr size_t WS_HB = 308 * MiB;
constexpr size_t WS_ACT = 374 * MiB;
constexpr size_t WS_OP = 554 * MiB;
constexpr size_t WS_LSE = 650 * MiB;
constexpr size_t WS_END = 654 * MiB;
static_assert(WS_XN + (size_t)M * DM * 2 <= WS_Q && WS_Q + 4 * QKVU_STRIDE <= WS_MIX && WS_MIX + (size_t)M * DM * 2 <= WS_HB && WS_HB + (size_t)M * DM * 2 <= WS_ACT && WS_ACT + (size_t)M * FF * 2 <= WS_OP && WS_OP + (size_t)3 * MP * 512 * 2 <= WS_LSE && WS_LSE + (size_t)3 * MP * 8 * 4 <= WS_END, "d_ws map");
static_assert(WS_HALO + (size_t)NPANEL * 4 * FF2 * 4 <= WS_SSP && WS_SSP + (size_t)M * 16 * 4 <= WS_XN && (size_t)M * 512 * 2 <= QKVU_STRIDE, "d_ws map 2");
constexpr int CW_TMO = 0, CW_CODE = 1, CW_BAR = 4096;
constexpr int RING_OFF = 0, RING_BYTES = 131072;
constexpr int TAB_OFF = RING_BYTES;
constexpr int LDSCTL_OFF = RING_BYTES + 8192, MISC_OFF = LDSCTL_OFF + 320;
constexpr int EPF_OFF = 140288;
constexpr int LDS_BYTES = 163840;
static_assert(MISC_OFF + 128 <= EPF_OFF && EPF_OFF + 2 * 8192 <= LDS_BYTES, "LDS map 2");
static_assert(MISC_OFF + 128 <= LDS_BYTES, "LDS map");
#define GAS __attribute__((address_space(1)))
#define LAS __attribute__((address_space(3)))
typedef unsigned short bf16;
typedef unsigned v4u __attribute__((ext_vector_type(4)));
typedef float f32x4 __attribute__((ext_vector_type(4)));
typedef short bf16x8 __attribute__((ext_vector_type(8)));
typedef GAS unsigned gu32;
typedef GAS unsigned long long gu64;
#define RLX_AGENT __ATOMIC_RELAXED, __HIP_MEMORY_SCOPE_AGENT
#define LDS_WAIT() asm volatile("s_waitcnt lgkmcnt(0)" ::: "memory")
#define VM_WAIT() asm volatile("s_waitcnt vmcnt(0)" ::: "memory")
__device__ __forceinline__ unsigned long long rt() { return __builtin_amdgcn_s_memrealtime(); }
__device__ __forceinline__ unsigned f2bf(float f) { unsigned u = __builtin_bit_cast(unsigned, f); return (u + 0x7fffu + ((u >> 16) & 1u)) >> 16; }
__device__ __forceinline__ unsigned pk2(float lo, float hi) { return f2bf(lo) | (f2bf(hi) << 16); }

#define XB_TMO      128
#define XB_XCNT(j)  (256  + 64 * (j))
#define XB_XSUB(j)  (1280 + 64 * (j))
#define XB_XGEN(j)  (2304 + 64 * (j))
#define XB_TOP      3328
#define XB_TOPGEN   3392
#define XCD_BAR_WORDS 3456
#define XB_SPIN_CAP (1u << 18)

__device__ __forceinline__ unsigned xb_ld(unsigned* p)              { return __hip_atomic_load(p, __ATOMIC_RELAXED, __HIP_MEMORY_SCOPE_AGENT); }
__device__ __forceinline__ unsigned xb_add(unsigned* p, unsigned v) { return __hip_atomic_fetch_add(p, v, __ATOMIC_RELAXED, __HIP_MEMORY_SCOPE_AGENT); }
__device__ __forceinline__ unsigned xb_xcc_id() { return (unsigned)__builtin_amdgcn_s_getreg((3 << 11) | 20) & 0xFu; }
#define XB_SPIN(cond, bar) do { unsigned _sp = 0; while (cond) { __builtin_amdgcn_s_sleep(1); \
    if ((++_sp & 255u) == 0u) { if (xb_ld(&(bar)[XB_TMO])) break; if (_sp > XB_SPIN_CAP) { atomicAdd(&(bar)[XB_TMO], 1u); break; } } } } while (0)

struct XcdBarrier {
    unsigned* bar; unsigned x;
    volatile LAS unsigned* st;
};

__device__ __forceinline__ XcdBarrier xcd_barrier_post(unsigned* bar, volatile LAS unsigned* st) {
    XcdBarrier b; b.bar = bar; b.x = xb_xcc_id(); b.st = st;
    if (threadIdx.x == 0) (void)xb_add(&bar[XB_XCNT(b.x)], 1u);
    return b;
}
__device__ __forceinline__ void xcd_barrier_complete(unsigned* bar, unsigned x, unsigned& nloc, unsigned& nx) {
    const unsigned G = gridDim.x * gridDim.y * gridDim.z;
    unsigned sum, cnt, mine, sp = 0u;
    for (;;) {
        sum = 0u; cnt = 0u; mine = 0u;
#pragma unroll
        for (unsigned j = 0; j < 16; ++j) { const unsigned c = xb_ld(&bar[XB_XCNT(j)]); sum += c; cnt += (c > 0u) ? 1u : 0u; mine = (j == x) ? c : mine; }
        if (sum == G) break;
        __builtin_amdgcn_s_sleep(1);
        if ((++sp & 255u) == 0u) { if (xb_ld(&bar[XB_TMO])) break; if (sp > XB_SPIN_CAP) { atomicAdd(&bar[XB_TMO], 1u); break; } }
    }
    nloc = mine > 0u ? mine : 1u; nx = cnt > 0u ? cnt : 1u;
}

__device__ __forceinline__ void xcd_barrier(const XcdBarrier& b) {
    asm volatile("s_waitcnt vmcnt(0)" ::: "memory");
    __syncthreads();
    if (threadIdx.x == 0) {
        unsigned* bar = b.bar;
        __builtin_amdgcn_s_waitcnt(0);
        unsigned nloc = b.st[0], nx = b.st[1];
        if (nloc == 0u) { xcd_barrier_complete(bar, b.x, nloc, nx); b.st[0] = nloc; b.st[1] = nx; }
        const unsigned old = xb_add(&bar[XB_XSUB(b.x)], 1u);
        const unsigned gen = old / nloc;
        if (old + 1u == (gen + 1u) * nloc) {
            __builtin_amdgcn_fence(__ATOMIC_RELEASE, "agent");
            asm volatile("s_waitcnt vmcnt(0)" ::: "memory");
            const unsigned og = xb_add(&bar[XB_TOP], 1u);
            const unsigned tg = og / nx;
            if (og + 1u == (tg + 1u) * nx) xb_add(&bar[XB_TOPGEN], 1u);
            else XB_SPIN(xb_ld(&bar[XB_TOPGEN]) == tg, bar);
            __builtin_amdgcn_fence(__ATOMIC_ACQUIRE, "agent");
            xb_add(&bar[XB_XGEN(b.x)], 1u);
            asm volatile("s_waitcnt vmcnt(0)" ::: "memory");
        } else {
            XB_SPIN(xb_ld(&bar[XB_XGEN(b.x)]) == gen, bar);
            __builtin_amdgcn_fence(__ATOMIC_ACQUIRE, "agent");
            asm volatile("s_waitcnt vmcnt(0)" ::: "memory");
        }
    }
    __syncthreads();
}

typedef unsigned u32x4_t __attribute__((ext_vector_type(4)));
typedef unsigned u32x2_t __attribute__((ext_vector_type(2)));
typedef short v4i16_t __attribute__((ext_vector_type(4)));
struct Frame {
    LAS unsigned char* lds;
    volatile LAS unsigned* MISC;
    gu32* ctl;
    int tid, lane, wave;
    int vcu, G;
    const float* in[18]; float* out; unsigned char* ws;
};
__device__ __forceinline__ float wave_sum(float v) {
#pragma unroll
    for (int o = 1; o < 64; o <<= 1) v += __shfl_xor(v, o);
    return v;
}
typedef float f32x2_t __attribute__((ext_vector_type(2))); typedef __bf16 bf16x2_t __attribute__((ext_vector_type(2)));
__device__ __forceinline__ unsigned cvtpk(float lo, float hi) { const f32x2_t v = {lo, hi}; const bf16x2_t b = __builtin_convertvector(v, bf16x2_t); return __builtin_bit_cast(unsigned, b); }
__device__ __forceinline__ bf16x8 cvt8(f32x4 a, f32x4 b) { u32x4_t w; w.x = cvtpk(a[0], a[1]); w.y = cvtpk(a[2], a[3]); w.z = cvtpk(b[0], b[1]); w.w = cvtpk(b[2], b[3]); return __builtin_bit_cast(bf16x8, w); }
__device__ __forceinline__ float bf2f(unsigned short b) { return __builtin_bit_cast(float, (unsigned)b << 16); }

__device__ __forceinline__ int dest_row_base(int mode, int n0) {
    if (mode == 1) { const int c0 = n0 & 255; return (n0 & ~255) + 128 * ((c0 >> 5) & 1) + 32 * (c0 >> 6); }
    if (mode == 2) { const int half = n0 >= FF ? 1 : 0, chn = n0 - half * FF; return 256 * (chn >> 7) + 128 * half + (chn & 127); }
    return n0;
}
__device__ __forceinline__ void p0_transpose_item(const float* W, int K, int N, bf16* WT, int mode, const float* kscale, LAS float* scr, int item, int lane) {
    const int nblk = N / 32, kb = item / nblk, nb = item % nblk, k0 = 64 * kb, n0 = 32 * nb;
    { f32x4 v[8]; const int n4 = 4 * (lane & 7);
#pragma unroll
      for (int i = 0; i < 8; ++i) v[i] = __builtin_nontemporal_load((const f32x4*)(W + (size_t)(k0 + 8 * i + (lane >> 3)) * N + n0 + n4));
#pragma unroll
      for (int i = 0; i < 8; ++i) { const int kk = 8 * i + (lane >> 3); const float sc = kscale ? kscale[k0 + kk] : 1.0f;
#pragma unroll
          for (int j = 0; j < 4; ++j) scr[kk * 33 + n4 + j] = v[i][j] * sc; } }
    LDS_WAIT(); asm volatile("" ::: "memory");
    const int c = lane & 7, rb = dest_row_base(mode, n0);
#pragma unroll
    for (int j = 0; j < 4; ++j) { const int n = (lane >> 3) + 8 * j; const LAS float* s = scr + (8 * c) * 33 + n;
        v4u o; o.x = pk2(s[0 * 33], s[1 * 33]); o.y = pk2(s[2 * 33], s[3 * 33]); o.z = pk2(s[4 * 33], s[5 * 33]); o.w = pk2(s[6 * 33], s[7 * 33]);
        *(GAS v4u*)(WT + (size_t)(rb + n) * K + k0 + 8 * c) = o; }
    LDS_WAIT(); asm volatile("" ::: "memory");
}
template <int NR> __device__ __forceinline__ void rms_rows_to_bf16(const float* const (&xrow)[NR], const float* g, bf16* const (&orow)[NR], int lane) {
    f32x4 v[NR][4]; float s[NR];
#pragma unroll
    for (int r = 0; r < NR; ++r) { const GAS f32x4* xr = (const GAS f32x4*)xrow[r] + 2 * lane;
#pragma unroll
        for (int j = 0; j < 2; ++j) { v[r][2 * j] = __builtin_nontemporal_load(xr + 128 * j); v[r][2 * j + 1] = __builtin_nontemporal_load(xr + 128 * j + 1); } }
    const GAS f32x4* gr = (const GAS f32x4*)g + 2 * lane; f32x4 gg[4];
#pragma unroll
    for (int j = 0; j < 2; ++j) { gg[2 * j] = gr[128 * j]; gg[2 * j + 1] = gr[128 * j + 1]; }
#pragma unroll
    for (int r = 0; r < NR; ++r) { s[r] = 0.f;
#pragma unroll
        for (int j = 0; j < 4; ++j) s[r] += (v[r][j].x * v[r][j].x + v[r][j].y * v[r][j].y) + (v[r][j].z * v[r][j].z + v[r][j].w * v[r][j].w); }
#pragma unroll
    for (int r = 0; r < NR; ++r) { const float rr = 1.f / sqrtf(wave_sum(s[r]) * (1.f / DM) + EPS);
        GAS v4u* o16 = (GAS v4u*)orow[r] + lane;
#pragma unroll
        for (int j = 0; j < 2; ++j) { const f32x4 a = v[r][2 * j] * rr * gg[2 * j], c = v[r][2 * j + 1] * rr * gg[2 * j + 1];
            v4u o; o.x = pk2(a.x, a.y); o.y = pk2(a.z, a.w); o.z = pk2(c.x, c.y); o.w = pk2(c.z, c.w); o16[64 * j] = o; } }
}
__device__ __forceinline__ void p0_prologue(Frame& F) {
    LAS float* scr = (LAS float*)(F.lds + RING_OFF + F.wave * 16384);
    const int gw = F.vcu * NWAVES + F.wave, NGW = F.G * NWAVES;
    constexpr int I_IN = (DM / 64) * (PJ / 32), I_OUT = (DM / 64) * (DM / 32), I_UP = (DM / 64) * (FF2 / 32), I_DN = (FF / 64) * (DM / 32), I_PL = (128 / 64) * (128 / 32);
    constexpr int NITEMS = I_IN + I_OUT + I_UP + I_DN + 4 * I_PL;
    bf16* ws16 = (bf16*)F.ws;
    for (int it = gw; it < NITEMS; it += NGW) {
        int r = it;
        if (r < I_IN) { p0_transpose_item(F.in[7], DM, PJ, (bf16*)(F.ws + WS_WIN), 1, nullptr, scr, r, F.lane); continue; } r -= I_IN;
        if (r < I_OUT) { p0_transpose_item(F.in[12], DM, DM, (bf16*)(F.ws + WS_WOUT), 0, nullptr, scr, r, F.lane); continue; } r -= I_OUT;
        if (r < I_UP) { p0_transpose_item(F.in[14], DM, FF2, (bf16*)(F.ws + WS_WUP), 2, F.in[13], scr, r, F.lane); continue; } r -= I_UP;
        if (r < I_DN) { p0_transpose_item(F.in[17], FF, DM, (bf16*)(F.ws + WS_WDN), 0, nullptr, scr, r, F.lane); continue; } r -= I_DN;
        { const int g = r / I_PL; p0_transpose_item(F.in[10] + (size_t)g * 128 * 128, 128, 128, (bf16*)(F.ws + WS_WPOOL) + (size_t)g * 128 * 128, 0, nullptr, scr, r % I_PL, F.lane); }
    }
    (void)ws16;
    for (int m0 = gw * 8; m0 < M; m0 += NGW * 8) {
        const float* xr[8]; bf16* orw[8];
#pragma unroll
        for (int r = 0; r < 8; ++r) { const int m = m0 + r; xr[r] = m < MP ? F.in[0] + (size_t)m * DM : F.in[1] + (size_t)(m - MP) * DM; orw[r] = (bf16*)(F.ws + WS_XN) + (size_t)m * DM; }
        rms_rows_to_bf16<8>(xr, F.in[6], orw, F.lane);
    }
    { const int gt = F.vcu * (NWAVES * 64) + F.tid, NT = F.G * NWAVES * 64;
      for (int i = gt; i < DB * 11 * 128; i += NT) { const int b = i / (11 * 128), rem = i % (11 * 128), j = rem >> 7, c4 = rem & 127;
          *(f32x4*)(F.out + O_PS + ((size_t)b * 15 + j) * 512 + 4 * c4) = *(const f32x4*)(F.in[4] + ((size_t)b * 15 + 4 + j) * 512 + 4 * c4); } }
}

__device__ __forceinline__ float max4g(float v) {
    auto a = __builtin_amdgcn_permlane16_swap(__float_as_uint(v), __float_as_uint(v), false, false); v = fmaxf(__uint_as_float(a[0]), __uint_as_float(a[1]));
    auto b = __builtin_amdgcn_permlane32_swap(__float_as_uint(v), __float_as_uint(v), false, false); return fmaxf(__uint_as_float(b[0]), __uint_as_float(b[1]));
}
__device__ __forceinline__ float sum4g(float v) {
    auto a = __builtin_amdgcn_permlane16_swap(__float_as_uint(v), __float_as_uint(v), false, false); v = __uint_as_float(a[0]) + __uint_as_float(a[1]);
    auto b = __builtin_amdgcn_permlane32_swap(__float_as_uint(v), __float_as_uint(v), false, false); return __uint_as_float(b[0]) + __uint_as_float(b[1]);
}
constexpr int VROW = 160;
constexpr int VTILE = 32 * VROW;
struct AState { float m, l; f32x4 o[4]; };
template <bool SAMPLE> struct KVRaw;
template <> struct KVRaw<false> { bf16x8 k[2][2]; bf16x8 v[4]; };
template <> struct KVRaw<true> { f32x4 k[2][2][2]; f32x4 v[8]; };
template <bool SAMPLE> __device__ __forceinline__ const void* kv_row(const void* base, const void* newb, int j, int rs, int cr, int b, int h) {
    int a = (j << rs) + cr;
    if (!SAMPLE) { a = a > SEQ - 1 ? SEQ - 1 : a; return (const bf16*)base + ((size_t)(b * SEQ + a) * AW + h * 64); }
    a = a > 2048 + DS - 1 ? 2048 + DS - 1 : a;
    return a < 2048 ? (const float*)base + ((size_t)(b * 2048 + a) * AW + h * 64) : (const float*)newb + ((size_t)(b * DS + a - 2048) * AW + h * 64);
}
template <bool SAMPLE> __device__ __forceinline__ void kv_load(KVRaw<SAMPLE>& R, const void* Kb, const void* Kn, const void* Vb, const void* Vn, int kb, int rs, int cr, int b, int h, int lane) {
    const int g = lane >> 4, c15 = lane & 15;
#pragma unroll
    for (int t = 0; t < 2; ++t) { const void* p = kv_row<SAMPLE>(Kb, Kn, 16 * (kb + t) + c15, rs, cr, b, h);
#pragma unroll
        for (int s = 0; s < 2; ++s) {
            if constexpr (!SAMPLE) R.k[t][s] = *(const bf16x8*)((const bf16*)p + 32 * s + 8 * g);
            else { R.k[t][s][0] = *(const f32x4*)((const float*)p + 32 * s + 8 * g); R.k[t][s][1] = *(const f32x4*)((const float*)p + 32 * s + 8 * g + 4); } } }
    { const void* p = kv_row<SAMPLE>(Vb, Vn, 16 * kb + (lane >> 1), rs, cr, b, h); const int hh = lane & 1;
        if constexpr (!SAMPLE) {
#pragma unroll
            for (int i = 0; i < 4; ++i) R.v[i] = *(const bf16x8*)((const bf16*)p + 32 * hh + 8 * i);
        } else {
#pragma unroll
            for (int i = 0; i < 8; ++i) R.v[i] = *(const f32x4*)((const float*)p + 32 * hh + 4 * i);
        } }
}
template <bool SAMPLE> __device__ __forceinline__ void attn_step(AState& st, const KVRaw<SAMPLE>& R, const bf16x8 (&qf)[2], int kb, int qsub, float sl2r, int dmin, int mt, LAS unsigned char* vl, int lane) {
    const int g = lane >> 4;
    { LAS unsigned char* wp = vl + (lane >> 1) * VROW + (lane & 1) * 64;
#pragma unroll
        for (int i = 0; i < 4; ++i) { bf16x8 x; if constexpr (!SAMPLE) x = R.v[i]; else x = cvt8(R.v[2 * i], R.v[2 * i + 1]); *(LAS bf16x8*)(wp + 16 * i) = x; } }
    f32x4 s[2];
#pragma unroll
    for (int t = 0; t < 2; ++t) { bf16x8 k0, k1; if constexpr (!SAMPLE) { k0 = R.k[t][0]; k1 = R.k[t][1]; } else { k0 = cvt8(R.k[t][0][0], R.k[t][0][1]); k1 = cvt8(R.k[t][1][0], R.k[t][1][1]); }
        s[t] = __builtin_amdgcn_mfma_f32_16x16x32_bf16(k0, qf[0], (f32x4){0.f, 0.f, 0.f, 0.f}, 0, 0, 0);
        s[t] = __builtin_amdgcn_mfma_f32_16x16x32_bf16(k1, qf[1], s[t], 0, 0, 0); }
    float mx = -INFINITY;
#pragma unroll
    for (int t = 0; t < 2; ++t)
#pragma unroll
        for (int i = 0; i < 4; ++i) { const int d = qsub - (16 * (kb + t) + 4 * g + i);
            const float lg = (mt >= 1 && (d & 3) == 0) ? ((mt == 2 && (d & 15) == 0) ? 1.5849625007211562f : 1.0f) : 0.f;
            const float x = ((unsigned)(d - dmin) <= (unsigned)(128 - dmin)) ? s[t][i] - sl2r * (float)d + lg : -INFINITY; s[t][i] = x; mx = fmaxf(mx, x); }
    mx = max4g(mx);
    const float mn = fmaxf(st.m, mx), alpha = __builtin_amdgcn_exp2f(st.m - mn); st.m = mn;
    float ps = 0.f;
#pragma unroll
    for (int t = 0; t < 2; ++t)
#pragma unroll
        for (int i = 0; i < 4; ++i) { const float p = __builtin_amdgcn_exp2f(s[t][i] - mn); s[t][i] = p; ps += p; }
    st.l = st.l * alpha + ps;
#pragma unroll
    for (int c = 0; c < 4; ++c) st.o[c] = st.o[c] * alpha;
    const bf16x8 pf = cvt8(s[0], s[1]);
    const LAS unsigned char* rp = vl + (4 * g + ((lane & 15) >> 2)) * VROW + (lane & 3) * 8;
#pragma unroll
    for (int c = 0; c < 4; ++c) {
        const v4i16_t a = __builtin_amdgcn_ds_read_tr16_b64_v4i16((LAS v4i16_t*)(rp + 32 * c));
        const v4i16_t bq = __builtin_amdgcn_ds_read_tr16_b64_v4i16((LAS v4i16_t*)(rp + 16 * VROW + 32 * c));
        const bf16x8 vf = (bf16x8){a[0], a[1], a[2], a[3], bq[0], bq[1], bq[2], bq[3]};
        st.o[c] = __builtin_amdgcn_mfma_f32_16x16x32_bf16(vf, pf, st.o[c], 0, 0, 0);
    }
}
__device__ __forceinline__ void attn_init(AState& st) { st.m = -1e30f; st.l = 0.f;
#pragma unroll
    for (int c = 0; c < 4; ++c) st.o[c] = (f32x4){0.f, 0.f, 0.f, 0.f}; }
__device__ __forceinline__ void attn_store(const AState& st, bf16* orow  , int lane) {
    const float l = sum4g(st.l);
    const float il = 1.0f / l; const int g = lane >> 4;
    if (orow) {
#pragma unroll
        for (int c = 0; c < 4; ++c) { u32x2_t w; w.x = cvtpk(st.o[c][0] * il, st.o[c][1] * il); w.y = cvtpk(st.o[c][2] * il, st.o[c][3] * il); *(u32x2_t*)(orow + 16 * c + 4 * g) = w; } }
}
constexpr int KP = 144, VP = 160, KT_ROWS = 256;
constexpr int KT_OFF = 0, VT_OFF = KT_ROWS * KP, SV_OFF = VT_OFF + KT_ROWS * VP;
static_assert(SV_OFF + 8 * VTILE <= RING_BYTES, "attention LDS map");
struct Chunk { int b, h, rs, c, ci, p; };
__device__ __forceinline__ Chunk chunk_decode(int bh  , int e  ) {
    Chunk k; k.b = bh >> 3; k.h = bh & 7;
    if (e < 16) { k.p = 0; k.rs = 0; k.c = 0; k.ci = e; }
    else if (e < 32) { k.p = 1; k.rs = 2; k.c = (e - 16) >> 2; k.ci = (e - 16) & 3; }
    else { k.p = 2; k.rs = 4; k.c = e - 32; k.ci = 0; }
    return k;
}
struct ChunkRegs { bf16x8 k[2], v[2]; };
__device__ __forceinline__ void chunk_load(ChunkRegs& R, const Chunk& k, int j0  , const bf16* Kb, const bf16* Vb, int tid) {
    const int j = j0 + (tid >> 2); const size_t off = (size_t)(k.b * SEQ + (j << k.rs) + k.c) * AW + k.h * 64 + 16 * (tid & 3);
#pragma unroll
    for (int i = 0; i < 2; ++i) { R.k[i] = *(const bf16x8*)(Kb + off + 8 * i); R.v[i] = *(const bf16x8*)(Vb + off + 8 * i); }
}
__device__ __forceinline__ void chunk_store(const ChunkRegs& R, LAS unsigned char* ring, int half, int tid) {
    const int rowp = half * 128 + (tid >> 2), q = tid & 3;
#pragma unroll
    for (int i = 0; i < 2; ++i) { *(LAS bf16x8*)(ring + KT_OFF + rowp * KP + q * 32 + 16 * i) = R.k[i]; *(LAS bf16x8*)(ring + VT_OFF + rowp * VP + q * 32 + 16 * i) = R.v[i]; }
}
__device__ __forceinline__ void chunk_step(AState& st, int kb, int own, int qk, float sl2r, const bf16x8 (&qf)[2], const LAS unsigned char* kp, const LAS unsigned char* vp, int g) {
    f32x4 s[2]; int rowb[2];
#pragma unroll
    for (int t = 0; t < 2; ++t) { const int kk0 = 16 * (kb + t); rowb[t] = ((((kk0 >> 7) + own + 1) & 1) << 7) + (kk0 & 127);
        const LAS unsigned char* r = kp + rowb[t] * KP;
        const bf16x8 k0 = *(const LAS bf16x8*)r, k1 = *(const LAS bf16x8*)(r + 64);
        s[t] = __builtin_amdgcn_mfma_f32_16x16x32_bf16(k0, qf[0], (f32x4){0.f, 0.f, 0.f, 0.f}, 0, 0, 0);
        s[t] = __builtin_amdgcn_mfma_f32_16x16x32_bf16(k1, qf[1], s[t], 0, 0, 0); }
    float mx = -INFINITY;
#pragma unroll
    for (int t = 0; t < 2; ++t)
#pragma unroll
        for (int i = 0; i < 4; ++i) { const int d = qk - (16 * (kb + t) + 4 * g + i); const float x = ((unsigned)d <= 128u) ? s[t][i] - sl2r * (float)d : -INFINITY; s[t][i] = x; mx = fmaxf(mx, x); }
    mx = max4g(mx);
    const float mn = fmaxf(st.m, mx), alpha = __builtin_amdgcn_exp2f(st.m - mn); st.m = mn;
    float ps = 0.f;
#pragma unroll
    for (int t = 0; t < 2; ++t)
#pragma unroll
        for (int i = 0; i < 4; ++i) { const float pe = __builtin_amdgcn_exp2f(s[t][i] - mn); s[t][i] = pe; ps += pe; }
    st.l = st.l * alpha + ps;
#pragma unroll
    for (int c = 0; c < 4; ++c) st.o[c] = st.o[c] * alpha;
    const bf16x8 pf = cvt8(s[0], s[1]);
#pragma unroll
    for (int c = 0; c < 4; ++c) {
        const v4i16_t a = __builtin_amdgcn_ds_read_tr16_b64_v4i16((LAS v4i16_t*)(vp + rowb[0] * VP + 32 * c));
        const v4i16_t bq = __builtin_amdgcn_ds_read_tr16_b64_v4i16((LAS v4i16_t*)(vp + rowb[1] * VP + 32 * c));
        const bf16x8 vf = (bf16x8){a[0], a[1], a[2], a[3], bq[0], bq[1], bq[2], bq[3]};
        st.o[c] = __builtin_amdgcn_mfma_f32_16x16x32_bf16(vf, pf, st.o[c], 0, 0, 0);
    }
}
__device__ __forceinline__ void chunk_compute(Frame& F, const Chunk& k, int own, const bf16x8 (&qf)[2], LAS unsigned char* ring) {
    const int lane = F.lane, c15 = lane & 15, g = lane >> 4, w = F.wave;
    AState sx, sy; attn_init(sx); attn_init(sy);
    const float sl2r = __builtin_amdgcn_exp2f(-(float)(k.h + 1)) * 1.4426950408889634f * (float)(1 << k.rs);
    const int blk_lo = (k.ci == 0) ? 8 : w, blk_hi = w + 8;
    const int qk = 16 * w + c15 + 128;
    const LAS unsigned char* kp = ring + KT_OFF + c15 * KP + 16 * g;
    const LAS unsigned char* vp = ring + VT_OFF + (4 * g + (c15 >> 2)) * VP + (lane & 3) * 8;
    int kb = blk_lo;
    for (; kb + 2 <= blk_hi; kb += 4) { chunk_step(sx, kb, own, qk, sl2r, qf, kp, vp, g); chunk_step(sy, kb + 2, own, qk, sl2r, qf, kp, vp, g); }
    if (kb <= blk_hi) chunk_step(sx, kb, own, qk, sl2r, qf, kp, vp, g);
    AState st; st.m = fmaxf(sx.m, sy.m); const float ax = __builtin_amdgcn_exp2f(sx.m - st.m), ay = __builtin_amdgcn_exp2f(sy.m - st.m);
    st.l = sx.l * ax + sy.l * ay;
#pragma unroll
    for (int c = 0; c < 4; ++c) st.o[c] = sx.o[c] * ax + sy.o[c] * ay;
    const float l = sum4g(st.l);
    const float il = 1.0f / l;
    const size_t row = (size_t)(k.b * SEQ + (((128 * k.ci + 16 * w + c15) << k.rs) + k.c));
    bf16* orow = (bf16*)(F.ws + WS_OP) + ((size_t)k.p * MP + row) * AW + k.h * 64;
#pragma unroll
    for (int c = 0; c < 4; ++c) { u32x2_t wv; wv.x = cvtpk(st.o[c][0] * il, st.o[c][1] * il); wv.y = cvtpk(st.o[c][2] * il, st.o[c][3] * il); *(u32x2_t*)(orow + 16 * c + 4 * g) = wv; }
    if (g == 0) ((float*)(F.ws + WS_LSE))[((size_t)k.p * MP + row) * NH + k.h] = st.m + __builtin_amdgcn_logf(l);
}
struct SDesc { int rs, cr, kb, qsub, dmin, mt; float sl2r; };
__device__ __forceinline__ SDesc sample_desc(int s, int qp, int c15, float slope2) {
    SDesc d; const int NEGQ = -(1 << 20);
    if (s < 5) { d.rs = 0; d.cr = 0; d.kb = 120 + 2 * s; d.qsub = c15 < 2 ? 2048 + 2 * qp + c15 : NEGQ; d.sl2r = slope2; d.dmin = 0; d.mt = 2; }
    else if (s < 11) { const int q = (s - 5) / 3, st = (s - 5) - 3 * q; d.rs = 2; d.cr = 2 * qp + q; d.kb = 24 + 2 * st; d.qsub = c15 == q ? 512 : NEGQ; d.sl2r = slope2 * 4.0f; d.dmin = 33; d.mt = 1; }
    else { const int q = (s - 11) / 3, st = (s - 11) - 3 * q; d.rs = 4; d.cr = 2 * qp + (q & 1); d.kb = 2 * st; d.qsub = (s < 17 && c15 == q) ? 128 : NEGQ; d.sl2r = slope2 * 16.0f; d.dmin = 33; d.mt = 0; }
    return d;
}
__device__ __forceinline__ void attn_prompt_role(Frame& F, int bh) {
    LAS unsigned char* ring = F.lds + RING_OFF;
    const bf16* Qb = (const bf16*)(F.ws + WS_Q); const bf16* Kb = (const bf16*)(F.ws + WS_Q + QKVU_STRIDE); const bf16* Vb = (const bf16*)(F.ws + WS_Q + 2 * QKVU_STRIDE);
    const int lane = F.lane, c15 = lane & 15, g = lane >> 4;
    __syncthreads();
    for (int i = F.tid; i < SV_OFF / 4; i += NWAVES * 64) ((LAS unsigned*)(ring))[i] = 0u;
    ChunkRegs R0, R1; Chunk c0 = chunk_decode(bh, 0), c1 = chunk_decode(bh, 1); chunk_load(R0, c0, 128 * c0.ci, Kb, Vb, F.tid); chunk_load(R1, c1, 128 * c1.ci, Kb, Vb, F.tid);
#define CHUNK_ITER(E, RR, CC, OWN) do { \
        bf16x8 qf[2]; \
        { const size_t qrow = (size_t)(CC.b * SEQ + (((128 * CC.ci + 16 * F.wave + c15) << CC.rs) + CC.c)); \
          const bf16* qp = Qb + qrow * AW + CC.h * 64 + 8 * g; qf[0] = *(const bf16x8*)qp; qf[1] = *(const bf16x8*)(qp + 32); } \
        __syncthreads(); \
        chunk_store(RR, ring, (OWN), F.tid); \
        __syncthreads(); \
        const Chunk now = CC; \
        if ((E) + 2 < 48) { CC = chunk_decode(bh, (E) + 2); chunk_load(RR, CC, 128 * CC.ci, Kb, Vb, F.tid); } \
        chunk_compute(F, now, (OWN), qf, ring); } while (0)
#pragma unroll 1
    for (int e = 0; e < 48; e += 2) { CHUNK_ITER(e, R0, c0, 0); CHUNK_ITER(e + 1, R1, c1, 1); }
#undef CHUNK_ITER
    asm volatile("s_waitcnt vmcnt(0)" ::: "memory"); __syncthreads();
    { const int b = bh >> 3, h = bh & 7; const bf16* OP = (const bf16*)(F.ws + WS_OP); const float* LSE = (const float*)(F.ws + WS_LSE); bf16* MIX = (bf16*)(F.ws + WS_MIX);
#pragma unroll 4
      for (int it = 0; it < SEQ / 64; ++it) { const size_t row = (size_t)b * SEQ + it * 64 + F.wave * 8 + (lane >> 3); const size_t off = row * AW + h * 64 + 8 * (lane & 7);
          const float l0 = LSE[row * NH + h], l1 = LSE[((size_t)MP + row) * NH + h], l2 = LSE[((size_t)2 * MP + row) * NH + h];
          const bf16x8 pa = *(const bf16x8*)(OP + off), pb = *(const bf16x8*)(OP + (size_t)MP * AW + off), pc = *(const bf16x8*)(OP + (size_t)2 * MP * AW + off);
          const float mx = fmaxf(l0, fmaxf(l1, l2)); float w0 = __builtin_amdgcn_exp2f(l0 - mx), w1 = __builtin_amdgcn_exp2f(l1 - mx), w2 = __builtin_amdgcn_exp2f(l2 - mx);
          const float inv = 1.0f / (w0 + w1 + w2); w0 *= inv; w1 *= inv; w2 *= inv;
          float o[8];
#pragma unroll
          for (int e = 0; e < 8; ++e) o[e] = w0 * bf2f((unsigned short)pa[e]) + w1 * bf2f((unsigned short)pb[e]) + w2 * bf2f((unsigned short)pc[e]);
          u32x4_t wv; wv.x = cvtpk(o[0], o[1]); wv.y = cvtpk(o[2], o[3]); wv.z = cvtpk(o[4], o[5]); wv.w = cvtpk(o[6], o[7]);
          *(u32x4_t*)(MIX + row * DM + h * 64 + 8 * (lane & 7)) = wv; } }
}
__device__ __forceinline__ void attn_sample_role(Frame& F, int bS) {
    const bf16* Qb = (const bf16*)(F.ws + WS_Q);
    const float* Kc = F.in[2]; const float* Vc = F.in[3]; const float* Kn = F.out + O_KS; const float* Vn = F.out + O_VS;
    const int lane = F.lane, c15 = lane & 15, g = lane >> 4, hS = F.wave;
    LAS unsigned char* vl = F.lds + RING_OFF + SV_OFF + F.wave * VTILE;
    const float slope2S = __builtin_amdgcn_exp2f(-(float)(hS + 1)) * 1.4426950408889634f;
#pragma unroll 1
    for (int qpS = 0; qpS < 2; ++qpS) {
        bf16x8 qs[2];
        { const bf16* qptr = Qb + ((size_t)(MP + bS * DS + 2 * qpS + (c15 & 1)) * AW + hS * 64 + 8 * g); qs[0] = *(const bf16x8*)qptr; qs[1] = *(const bf16x8*)(qptr + 32); }
        AState sst; attn_init(sst);
        KVRaw<true> cur, nxt;
        { const SDesc sd = sample_desc(0, qpS, c15, slope2S); kv_load<true>(cur, Kc, Kn, Vc, Vn, sd.kb, sd.rs, sd.cr, bS, hS, lane); }
#pragma unroll 1
        for (int s = 0; s < 17; ++s) {
            const SDesc sd = sample_desc(s, qpS, c15, slope2S), sn = sample_desc(s + 1, qpS, c15, slope2S);
            kv_load<true>(nxt, Kc, Kn, Vc, Vn, sn.kb, sn.rs, sn.cr, bS, hS, lane);
            attn_step<true>(sst, cur, qs, sd.kb, sd.qsub, sd.sl2r, sd.dmin, sd.mt, vl, lane);
            cur = nxt;
        }
        attn_store(sst, c15 < 2 ? (bf16*)(F.ws + WS_MIX) + ((size_t)(MP + bS * DS + 2 * qpS + c15) * DM + hS * 64) : nullptr, lane);
    }
}
template <int K> __device__ __forceinline__ float dpp_ror(float v) { return __builtin_bit_cast(float, __builtin_amdgcn_update_dpp(0, __builtin_bit_cast(int, v), 0x120 + K, 0xf, 0xf, false)); }
template <int K> __device__ __forceinline__ void win_step(float (&S)[8], float (&P)[8], int c15) {
#pragma unroll
    for (int e = 0; e < 8; ++e) { const float y = c15 >= 16 - K ? P[e] : S[e]; const float s2 = S[e] + dpp_ror<K>(y); const float p2 = P[e] + dpp_ror<K>(P[e]); S[e] = s2; P[e] = p2; }
}
__device__ __forceinline__ void pool_mma_store(const bf16* WP, const float* PS, bf16* MIX, f32x4 (&acc)[8], const bf16x8 (&df)[4], int gi, int row, int c15, int g) {
#pragma unroll
    for (int ks = 0; ks < 4; ++ks)
#pragma unroll
        for (int nt = 0; nt < 8; ++nt) { const bf16x8 wf = *(const bf16x8*)(WP + ((size_t)(gi * 128 + 16 * nt + c15) * 128 + 32 * ks + 8 * g));
            acc[nt] = __builtin_amdgcn_mfma_f32_16x16x32_bf16(wf, df[ks], acc[nt], 0, 0, 0); }
#pragma unroll
    for (int nt = 0; nt < 8; ++nt) { const int col = 128 * gi + 16 * nt + 4 * g; const f32x4 sc = *(const f32x4*)(PS + col); const f32x4 o = acc[nt] * sc;
        u32x2_t wv; wv.x = cvtpk(o[0], o[1]); wv.y = cvtpk(o[2], o[3]); *(u32x2_t*)(MIX + (size_t)row * DM + 512 + col) = wv; }
}
template <int NTL> __device__ __forceinline__ void pool_group_prompt(Frame& F, int T0, int TS, const int GI) {
    const int lane = F.lane, c15 = lane & 15, g = lane >> 4;
    const bf16* U = (const bf16*)(F.ws + WS_Q + 3 * QKVU_STRIDE); const bf16* WP = (const bf16*)(F.ws + WS_WPOOL); const float* PS = F.in[11]; bf16* MIX = (bf16*)(F.ws + WS_MIX);
    const int w = 2 << GI;
    bf16x8 xc[NTL][4], xp[NTL][4];
#pragma unroll
    for (int tl = 0; tl < NTL; ++tl) { const int T = T0 + tl * TS, row = T * 16 + c15; const bool has_prev = ((T * 16) & (SEQ - 1)) != 0;
#pragma unroll
        for (int ks = 0; ks < 4; ++ks) { const int ch = 128 * GI + 32 * ks + 8 * g; xc[tl][ks] = *(const bf16x8*)(U + (size_t)row * AW + ch);
            xp[tl][ks] = (bf16x8){0, 0, 0, 0, 0, 0, 0, 0}; if (has_prev) xp[tl][ks] = *(const bf16x8*)(U + (size_t)(row - 16) * AW + ch); } }
    bf16x8 df[NTL][4];
#pragma unroll
    for (int tl = 0; tl < NTL; ++tl) { const int t = ((T0 + tl * TS) * 16 + c15) & (SEQ - 1); const float ic = 1.0f / (float)(w < t + 1 ? w : t + 1);
#pragma unroll
        for (int ks = 0; ks < 4; ++ks) {
            float S[8], P[8], cur[8];
#pragma unroll
            for (int e = 0; e < 8; ++e) { cur[e] = bf2f((unsigned short)xc[tl][ks][e]); S[e] = cur[e]; P[e] = bf2f((unsigned short)xp[tl][ks][e]); }
            win_step<1>(S, P, c15);
            if (GI >= 1) win_step<2>(S, P, c15);
            if (GI >= 2) win_step<4>(S, P, c15);
            if (GI >= 3) win_step<8>(S, P, c15);
            f32x4 d0, d1;
#pragma unroll
            for (int e = 0; e < 4; ++e) { d0[e] = S[e] * ic - cur[e]; d1[e] = S[4 + e] * ic - cur[4 + e]; }
            df[tl][ks] = cvt8(d0, d1);
        } }
    f32x4 acc[NTL][8];
#pragma unroll
    for (int tl = 0; tl < NTL; ++tl)
#pragma unroll
        for (int nt = 0; nt < 8; ++nt) acc[tl][nt] = (f32x4){0.f, 0.f, 0.f, 0.f};
#pragma unroll
    for (int ks = 0; ks < 4; ++ks)
#pragma unroll
        for (int nt = 0; nt < 8; ++nt) { const bf16x8 wf = *(const bf16x8*)(WP + ((size_t)(GI * 128 + 16 * nt + c15) * 128 + 32 * ks + 8 * g));
#pragma unroll
            for (int tl = 0; tl < NTL; ++tl) acc[tl][nt] = __builtin_amdgcn_mfma_f32_16x16x32_bf16(wf, df[tl][ks], acc[tl][nt], 0, 0, 0); }
#pragma unroll
    for (int nt = 0; nt < 8; ++nt) { const int col = 128 * GI + 16 * nt + 4 * g; const f32x4 sc = *(const f32x4*)(PS + col);
#pragma unroll
        for (int tl = 0; tl < NTL; ++tl) { const f32x4 o = acc[tl][nt] * sc; const int row = (T0 + tl * TS) * 16 + c15;
            u32x2_t wv; wv.x = cvtpk(o[0], o[1]); wv.y = cvtpk(o[2], o[3]); *(u32x2_t*)(MIX + (size_t)row * DM + 512 + col) = wv; } }
}
__device__ __forceinline__ void pool_sample_item(Frame& F, int T, int gi) {
    const int lane = F.lane, c15 = lane & 15, g = lane >> 4, row = T * 16 + c15, t = (row - MP) & 3, bs = (row - MP) >> 2;
    const bf16* U = (const bf16*)(F.ws + WS_Q + 3 * QKVU_STRIDE); const float* SP = F.in[4];
    const int w = 2 << gi; const float ic = 1.0f / (float)w;
    bf16x8 df[4];
#pragma unroll
    for (int ks = 0; ks < 4; ++ks) df[ks] = (bf16x8){0, 0, 0, 0, 0, 0, 0, 0};
#pragma unroll 1
    for (int ks = 0; ks < 4; ++ks) {
        const int ch = 128 * gi + 32 * ks + 8 * g;
        float S[8], cur[8];
#pragma unroll
        for (int e = 0; e < 8; ++e) { S[e] = 0.f; cur[e] = 0.f; }
#pragma unroll 1
        for (int i0 = 0; i0 < w; i0 += 8) {
            bf16x8 xu[8]; f32x4 x0[8], x1[8];
#pragma unroll
            for (int u = 0; u < 8; ++u) { const int i = i0 + u < w ? i0 + u : w - 1; const int idx = t - i, iu = idx < 0 ? 0 : idx, is = idx >= 0 ? 14 : 15 + idx;
                xu[u] = *(const bf16x8*)(U + (size_t)(row - t + iu) * AW + ch);
                const float* sp = SP + ((size_t)bs * 15 + is) * 512 + ch; x0[u] = *(const f32x4*)sp; x1[u] = *(const f32x4*)(sp + 4); }
            __builtin_amdgcn_sched_barrier(0);
#pragma unroll
            for (int u = 0; u < 8; ++u) { const int i = i0 + u, idx = t - i; const bool use = i < w;
#pragma unroll
                for (int e = 0; e < 8; ++e) { const float vs = e < 4 ? x0[u][e & 3] : x1[u][e & 3]; float v = idx >= 0 ? bf2f((unsigned short)xu[u][e]) : vs; v = use ? v : 0.f; S[e] += v; if (i == 0) cur[e] = v; } }
        }
        f32x4 d0, d1;
#pragma unroll
        for (int e = 0; e < 4; ++e) { d0[e] = S[e] * ic - cur[e]; d1[e] = S[4 + e] * ic - cur[4 + e]; }
        const bf16x8 dd = cvt8(d0, d1); if (ks == 0) df[0] = dd; else if (ks == 1) df[1] = dd; else if (ks == 2) df[2] = dd; else df[3] = dd;
    }
    f32x4 acc[8];
#pragma unroll
    for (int nt = 0; nt < 8; ++nt) acc[nt] = (f32x4){0.f, 0.f, 0.f, 0.f};
    pool_mma_store((const bf16*)(F.ws + WS_WPOOL), F.in[11], (bf16*)(F.ws + WS_MIX), acc, df, gi, row, c15, g);
}
template <int NTL> __device__ __forceinline__ void pool_tiles(Frame& F, int T0, int TS) {
#pragma unroll 1
    for (int gi = 0; gi < 4; ++gi) pool_group_prompt<NTL>(F, T0, TS, gi);
}
__device__ __forceinline__ void p2_attn(Frame& F) {
    const int role = F.vcu & 1, idx = F.vcu >> 1, nidx = F.G >> 1;
    if (role == 0) { for (int bh = idx; bh < NB * NH; bh += nidx) attn_prompt_role(F, bh); }
    else {
        for (int b = idx; b < DB; b += nidx) attn_sample_role(F, b);
        const int gw = idx * NWAVES + F.wave, NGW = nidx * NWAVES;
        if (2 * NGW == MP / 16) pool_tiles<2>(F, gw, NGW); else for (int T = gw; T < MP / 16; T += NGW) pool_tiles<1>(F, T, 0);
        for (int it = gw; it < 128 * 8; it += NGW) if ((it & 7) == 0) pool_sample_item(F, MP / 16 + (it >> 5), (it >> 3) & 3);
    }
}
template <int NTW, int KS, int UNR, class BR> __device__ __forceinline__ void mini_mma(const bf16* A, int K, const bf16* Bt, const BR& br, int arow, LAS float* tile, int pitch, int wave, int lane) {
    const int c15 = lane & 15, g = lane >> 4, ks = wave % KS, cg = wave / KS;
    const int kbeg = ks * (K / KS), ksteps = K / KS / 32, joff = cg * 16 * NTW;
    const bf16* ap = A + (size_t)(arow + c15) * K + kbeg + 8 * g;
    const bf16* bp[NTW];
#pragma unroll
    for (int nt = 0; nt < NTW; ++nt) bp[nt] = Bt + (size_t)br(joff + nt * 16 + c15) * K + kbeg + 8 * g;
    f32x4 acc[4][NTW];
#pragma unroll
    for (int rb = 0; rb < 4; ++rb)
#pragma unroll
        for (int nt = 0; nt < NTW; ++nt) acc[rb][nt] = (f32x4){0.f, 0.f, 0.f, 0.f};
    for (int s0 = 0; s0 < ksteps; s0 += UNR) {
        bf16x8 a[UNR][4], b[UNR][NTW];
#pragma unroll
        for (int u = 0; u < UNR; ++u) { const int s = s0 + u < ksteps ? s0 + u : ksteps - 1;
#pragma unroll
            for (int rb = 0; rb < 4; ++rb) a[u][rb] = *(const bf16x8*)(ap + (size_t)(16 * rb) * K + 32 * s);
#pragma unroll
            for (int nt = 0; nt < NTW; ++nt) b[u][nt] = *(const bf16x8*)(bp[nt] + 32 * s); }
        __builtin_amdgcn_sched_barrier(0);
#pragma unroll
        for (int u = 0; u < UNR; ++u) if (s0 + u < ksteps) {
#pragma unroll
            for (int rb = 0; rb < 4; ++rb)
#pragma unroll
                for (int nt = 0; nt < NTW; ++nt) acc[rb][nt] = __builtin_amdgcn_mfma_f32_16x16x32_bf16(b[u][nt], a[u][rb], acc[rb][nt], 0, 0, 0); }
        __builtin_amdgcn_sched_barrier(0);
    }
#pragma unroll
    for (int rb = 0; rb < 4; ++rb)
#pragma unroll
        for (int nt = 0; nt < NTW; ++nt) *(LAS f32x4*)(tile + (ks * 64 + 16 * rb + c15) * pitch + joff + 16 * nt + 4 * g) = acc[rb][nt];
}
struct BrLin { int c0; __device__ __forceinline__ int operator()(int j) const { return c0 + j; } };
struct BrHead { int base; __device__ __forceinline__ int operator()(int j) const { return base + 128 * (j >> 5) + (j & 31); } };
struct BrUp { int ch0; __device__ __forceinline__ int operator()(int j) const { const int half = j >= 96 ? 1 : 0; int ch = ch0 + j - 96 * half; ch = ch > FF - 1 ? FF - 1 : ch; return 256 * (ch >> 7) + 128 * half + (ch & 127); } };
__device__ __forceinline__ void mini_inproj(Frame& F, int tl) {
    LAS float* tile = (LAS float*)(F.lds + RING_OFF); constexpr int PT = 68;
    const int rg = tl >> 5, hd = tl & 31, type = hd >> 3, h = hd & 7;
    BrHead br{256 * (type * 2 + (h >> 2)) + 32 * (h & 3)};
    mini_mma<2, 4, 4>((const bf16*)(F.ws + WS_XN), DM, (const bf16*)(F.ws + WS_WIN), br, MP + 64 * rg, tile, PT, F.wave, F.lane);
    __syncthreads();
    const int r = F.tid >> 3, d0 = 8 * (F.tid & 7), row = 64 * rg + r;
    float v[8];
#pragma unroll
    for (int e = 0; e < 8; ++e) v[e] = (tile[r * PT + d0 + e] + tile[(64 + r) * PT + d0 + e]) + (tile[(128 + r) * PT + d0 + e] + tile[(192 + r) * PT + d0 + e]);
    if (type < 2) { float ss = 0.f;
#pragma unroll
        for (int e = 0; e < 8; ++e) ss += v[e] * v[e];
        ss += __shfl_xor(ss, 1); ss += __shfl_xor(ss, 2); ss += __shfl_xor(ss, 4);
        const float rr = 1.0f / sqrtf(ss * (1.0f / 64.0f) + EPS) * (type == 0 ? QSCALE : 1.0f); const float* gs = (type == 0 ? F.in[8] : F.in[9]) + h * 64 + d0;
#pragma unroll
        for (int e = 0; e < 8; ++e) v[e] = v[e] * rr * gs[e]; }
    u32x4_t wv; wv.x = cvtpk(v[0], v[1]); wv.y = cvtpk(v[2], v[3]); wv.z = cvtpk(v[4], v[5]); wv.w = cvtpk(v[6], v[7]);
    *(u32x4_t*)((bf16*)(F.ws + WS_Q + (size_t)type * QKVU_STRIDE) + (size_t)(MP + row) * AW + h * 64 + d0) = wv;
    float* o = nullptr;
    if (type == 1) o = F.out + O_KS + (size_t)row * AW + h * 64 + d0; else if (type == 2) o = F.out + O_VS + (size_t)row * AW + h * 64 + d0;
    else if (type == 3) o = F.out + O_PS + ((size_t)(row >> 2) * 15 + 11 + (row & 3)) * 512 + h * 64 + d0;
    if (o) { *(f32x4*)o = (f32x4){v[0], v[1], v[2], v[3]}; *(f32x4*)(o + 4) = (f32x4){v[4], v[5], v[6], v[7]}; }
    __syncthreads();
}
__device__ __forceinline__ void mini_outproj(Frame& F, int tl) {
    LAS float* tile = (LAS float*)(F.lds + RING_OFF); constexpr int PT = 36;
    const int rg = tl >> 5, cg = tl & 31;
    BrLin br{32 * cg};
    mini_mma<2, 8, 4>((const bf16*)(F.ws + WS_MIX), DM, (const bf16*)(F.ws + WS_WOUT), br, MP + 64 * rg, tile, PT, F.wave, F.lane);
    __syncthreads();
    const int r = F.tid >> 3, c0 = 4 * (F.tid & 7), row = 64 * rg + r, col = 32 * cg + c0;
    f32x4 a = (f32x4){0.f, 0.f, 0.f, 0.f}, b = (f32x4){0.f, 0.f, 0.f, 0.f};
#pragma unroll
    for (int k2 = 0; k2 < 8; k2 += 2) { a = a + *(const LAS f32x4*)(tile + (k2 * 64 + r) * PT + c0); b = b + *(const LAS f32x4*)(tile + ((k2 + 1) * 64 + r) * PT + c0); }
    const f32x4 hv = *(const f32x4*)(F.in[1] + (size_t)row * DM + col) + a + b;
    u32x2_t wv; wv.x = cvtpk(hv[0], hv[1]); wv.y = cvtpk(hv[2], hv[3]); *(u32x2_t*)((bf16*)(F.ws + WS_HB) + (size_t)(MP + row) * DM + col) = wv;
    float ss = (hv[0] * hv[0] + hv[1] * hv[1]) + (hv[2] * hv[2] + hv[3] * hv[3]);
    ss += __shfl_xor(ss, 1); ss += __shfl_xor(ss, 2); ss += __shfl_xor(ss, 4);
    if ((F.tid & 7) == 0) ((float*)(F.ws + WS_SSPS))[row * 32 + cg] = ss;
    __syncthreads();
}
__device__ __forceinline__ void mini_up(Frame& F, int tl) {
    LAS float* tile = (LAS float*)(F.lds + RING_OFF); constexpr int PT = 196;
    const int rg = tl >> 5, cg = tl & 31, ch0 = 88 * cg;
    BrUp br{ch0};
    mini_mma<3, 2, 4>((const bf16*)(F.ws + WS_HB), DM, (const bf16*)(F.ws + WS_WUP), br, MP + 64 * rg, tile, PT, F.wave, F.lane);
    __syncthreads();
    { const int r = F.tid >> 3, row = 64 * rg + r; const float* sp = (const float*)(F.ws + WS_SSPS) + row * 32 + 4 * (F.tid & 7);
      const f32x4 t = *(const f32x4*)sp; float ss = (t[0] + t[1]) + (t[2] + t[3]); ss += __shfl_xor(ss, 1); ss += __shfl_xor(ss, 2); ss += __shfl_xor(ss, 4);
      const float rr = 1.0f / sqrtf(ss * (1.0f / DM) + EPS);
      for (int c = (F.tid & 7); c < 192; c += 8) tile[r * PT + c] = (tile[r * PT + c] + tile[(64 + r) * PT + c]) * rr; }
    __syncthreads();
    { const int r = F.tid >> 3, row = 64 * rg + r, n = row & 3, b = row >> 2; const float* cw = F.in[15]; const float* cbp = F.in[16]; const float* hist = F.in[5] + (size_t)b * 2 * FF2;
#pragma unroll
      for (int k = 0; k < 11; ++k) { const int cl = 11 * (F.tid & 7) + k, ch = ch0 + cl; float cv[2];
#pragma unroll
          for (int hf = 0; hf < 2; ++hf) { const int col = hf * FF + ch, lc = hf * 96 + cl;
              const float cur = tile[r * PT + lc];
              const float p1 = n >= 1 ? tile[(r - 1) * PT + lc] : hist[FF2 + col];
              const float p2 = n >= 2 ? tile[(r - 2) * PT + lc] : (n == 1 ? hist[FF2 + col] : hist[col]);
              cv[hf] = cbp[col] + cw[col] * p2 + cw[FF2 + col] * p1 + cw[2 * FF2 + col] * cur;
              if (n >= 2) F.out[O_FS + ((size_t)b * 2 + n - 2) * FF2 + col] = cur; }
          ((bf16*)(F.ws + WS_ACT))[(size_t)(MP + row) * FF + ch] = (bf16)f2bf(pg8::silu_mul(cv[0], cv[1])); } }
    __syncthreads();
}
__device__ __forceinline__ void mini_down(Frame& F, int tl) {
    LAS float* tile = (LAS float*)(F.lds + RING_OFF); constexpr int PT = 36;
    const int rg = tl >> 5, cg = tl & 31;
    BrLin br{32 * cg};
    mini_mma<2, 8, 4>((const bf16*)(F.ws + WS_ACT), FF, (const bf16*)(F.ws + WS_WDN), br, MP + 64 * rg, tile, PT, F.wave, F.lane);
    __syncthreads();
    const int r = F.tid >> 3, c0 = 4 * (F.tid & 7), row = 64 * rg + r, col = 32 * cg + c0;
    f32x4 a = (f32x4){0.f, 0.f, 0.f, 0.f}, b = (f32x4){0.f, 0.f, 0.f, 0.f};
#pragma unroll
    for (int k2 = 0; k2 < 8; k2 += 2) { a = a + *(const LAS f32x4*)(tile + (k2 * 64 + r) * PT + c0); b = b + *(const LAS f32x4*)(tile + ((k2 + 1) * 64 + r) * PT + c0); }
    const u32x2_t hb = *(const u32x2_t*)((const bf16*)(F.ws + WS_HB) + (size_t)(MP + row) * DM + col);
    const f32x4 hv = (f32x4){__builtin_bit_cast(float, hb.x << 16), __builtin_bit_cast(float, hb.x & 0xffff0000u), __builtin_bit_cast(float, hb.y << 16), __builtin_bit_cast(float, hb.y & 0xffff0000u)};
    *(f32x4*)(F.out + O_Y + (size_t)(MP + row) * DM + col) = hv + a + b;
    __syncthreads();
}
__device__ __forceinline__ void p6_fix_rows(Frame& F) {
    const float* halo = (const float*)(F.ws + WS_HALO); const float* cw = F.in[15]; const float* cbp = F.in[16]; bf16* ACT = (bf16*)(F.ws + WS_ACT);
    for (int it = blockIdx.x; it < NPANEL_P * 2; it += F.G) {
        const int pm = it >> 1, e = it & 1; const bool first = (pm & 7) == 0;
#pragma unroll
        for (int it2 = 0; it2 < 6; ++it2) { const int ch = F.tid + it2 * NWAVES * 64; if (ch < FF) {
            float cv[2];
#pragma unroll
            for (int bj = 0; bj < 2; ++bj) { const int col = bj * FF + ch;
                const float um2 = first ? 0.f : halo[(size_t)((pm - 1) * 4 + 2) * FF2 + col], um1 = first ? 0.f : halo[(size_t)((pm - 1) * 4 + 3) * FF2 + col];
                const float u0 = halo[(size_t)(pm * 4 + 0) * FF2 + col], u1 = halo[(size_t)(pm * 4 + 1) * FF2 + col];
                const float w0 = cw[col], w1 = cw[FF2 + col], w2 = cw[2 * FF2 + col], cb = cbp[col];
                cv[bj] = e == 0 ? cb + w0 * um2 + w1 * um1 + w2 * u0 : cb + w0 * um1 + w1 * u0 + w2 * u1; }
            ACT[(size_t)(pm * 256 + e) * FF + ch] = (bf16)f2bf(pg8::silu_mul(cv[0], cv[1]));
        } }
    }
}


struct Args { const float* in[18]; float* out; unsigned char* ws; int ph_lo, ph_hi, li, pad; };
__global__ void __launch_bounds__(NWAVES * 64, 2) mk_fwd(Args args) {
    extern __shared__ __attribute__((aligned(16))) unsigned char lds[];
    Frame F;
    F.lds = (LAS unsigned char*)lds;
    F.MISC = (volatile LAS unsigned*)(F.lds + MISC_OFF);
    F.tid = threadIdx.x; F.lane = F.tid & 63; F.wave = __builtin_amdgcn_readfirstlane(F.tid >> 6);
    F.G = gridDim.x; { const int bx = blockIdx.x; F.vcu = (F.G % 8 == 0) ? (bx % 8) * (F.G / 8) + bx / 8 : bx; }
    unsigned char* ws = args.ws; F.ws = ws; F.out = args.out;
    F.ctl = (gu32*)(ws + WS_CTL);
#pragma unroll
    for (int i = 0; i < 18; ++i) F.in[i] = args.in[i];
    for (int u = F.tid; u < (LDS_BYTES - LDSCTL_OFF) / 4; u += NWAVES * 64) ((LAS unsigned*)(F.lds + LDSCTL_OFF))[u] = 0u;
    __syncthreads();
    XcdBarrier bar; bar.bar = (unsigned*)(F.ctl + CW_BAR); bar.x = 0; bar.st = nullptr;
    if (N_LAUNCHES != PER_PHASE) bar = xcd_barrier_post((unsigned*)(F.ctl + CW_BAR), F.MISC + 8);
#define GRID_BAR(seam) do { if (N_LAUNCHES == PER_PHASE) { if (F.tid == 0) __hip_atomic_store(F.ctl + CW_TMO, 0xBADBA0u | (unsigned)(seam), RLX_AGENT); } else { xcd_barrier(bar); } } while (0)
    const int lo = args.ph_lo, hi = args.ph_hi;
#ifndef PH_MASK
#define PH_MASK 127
#endif
#define IN(k) ((((PH_MASK) >> (k)) & 1) && lo <= (k) && (k) < hi)
#define BOTH(k) (IN(k) && IN((k) + 1))
    bf16* const XN = (bf16*)(ws + WS_XN); bf16* const QB = (bf16*)(ws + WS_Q); bf16* const MIX = (bf16*)(ws + WS_MIX); bf16* const HB = (bf16*)(ws + WS_HB); bf16* const ACT = (bf16*)(ws + WS_ACT);

    if (IN(0)) { p0_prologue(F); if (BOTH(0)) GRID_BAR(0); }

    if (IN(1)) {
        pg8::Gemm g{XN, (const bf16*)(ws + WS_WIN), MP, PJ, DM}; pg8::StaticOrder S; S.init(MP, PJ, F.G, (int)blockIdx.x);
        pg8::EpiInProj E{QB, QKVU_STRIDE / 2, F.out, F.in[8], F.in[9]};
        pg8::gemm_phase<pg8::EpiInProj, pg8::StaticOrder, true, true>(F.lds + RING_OFF, g, S, E);
        for (int tl = blockIdx.x; tl < 256; tl += F.G) mini_inproj(F, tl);
        if (BOTH(1)) GRID_BAR(1);
    }

    if (IN(2)) { p2_attn(F); if (BOTH(2)) GRID_BAR(2); }

    if (IN(3)) {
        pg8::Gemm g{MIX, (const bf16*)(ws + WS_WOUT), MP, DM, DM}; pg8::StaticOrder S; S.init(MP, DM, F.G, (int)blockIdx.x);
        pg8::EpiOutProj E{F.in[0], HB, (float*)(ws + WS_SSP), (PG8_LAS float*)(F.lds + TAB_OFF)};
        pg8::gemm_phase<pg8::EpiOutProj, pg8::StaticOrder, true, true>(F.lds + RING_OFF, g, S, E);
        for (int tl = blockIdx.x; tl < 256; tl += F.G) mini_outproj(F, tl);
        if (BOTH(3)) GRID_BAR(3);
    }

    if (IN(4)) {
        pg8::Gemm g{HB, (const bf16*)(ws + WS_WUP), MP, FF2, DM}; pg8::StaticOrder S; S.init(MP, FF2, F.G, (int)blockIdx.x);
        pg8::EpiUp E{ACT, (const float*)(ws + WS_SSP), (float*)(ws + WS_HALO), F.out, F.in[15], F.in[16], (PG8_LAS float*)(F.lds + TAB_OFF), F.lds + EPF_OFF};
        pg8::gemm_phase<pg8::EpiUp, pg8::StaticOrder, true, true>(F.lds + RING_OFF, g, S, E);
        for (int tl = blockIdx.x; tl < 256; tl += F.G) mini_up(F, tl);
        if (BOTH(4)) GRID_BAR(4);
    }

    if (IN(5)) { p6_fix_rows(F); if (BOTH(5)) GRID_BAR(5); }

    if (IN(6)) {
        pg8::Gemm g{ACT, (const bf16*)(ws + WS_WDN), MP, DM, FF}; pg8::StaticOrder S; S.init(MP, DM, F.G, (int)blockIdx.x);
        pg8::EpiDown E{F.out + O_Y, HB};
        pg8::gemm_phase<pg8::EpiDown, pg8::StaticOrder, true, true>(F.lds + RING_OFF, g, S, E);
        for (int tl = blockIdx.x; tl < 256; tl += F.G) mini_down(F, tl);
    }
#undef IN
#undef BOTH
}

extern "C" void kernel_launch(void* const* d_in, const int* in_sizes, int n_in, void* d_out, int out_size, void* d_ws, size_t ws_size, hipStream_t stream) {
    static int grid = 0;
    if (grid == 0) {
        if (n_in != 18 || in_sizes[0] != MP * DM || out_size != (int)O_END || ws_size < WS_END) { fprintf(stderr, "kernel_launch: unexpected shapes: n_in %d, in0 %d, out %d, ws %zu (need %zu); nothing launched\n", n_in, n_in > 0 ? in_sizes[0] : -1, out_size, ws_size, (size_t)WS_END); grid = -1; return; }
        int dev = 0, cus = 0, per_cu = 0;
        if (hipGetDevice(&dev) != hipSuccess || hipDeviceGetAttribute(&cus, hipDeviceAttributeMultiprocessorCount, dev) != hipSuccess) { fprintf(stderr, "kernel_launch: hipGetDevice / hipDeviceGetAttribute failed\n"); grid = -1; return; }
        if (hipFuncSetAttribute((const void*)mk_fwd, hipFuncAttributeMaxDynamicSharedMemorySize, LDS_BYTES) != hipSuccess) { fprintf(stderr, "kernel_launch: hipFuncSetAttribute failed\n"); grid = -1; return; }
        if (hipOccupancyMaxActiveBlocksPerMultiprocessor(&per_cu, (const void*)mk_fwd, NWAVES * 64, LDS_BYTES) != hipSuccess || per_cu < 1)
            fprintf(stderr, "kernel_launch: note: occupancy query reports %d workgroups per CU\n", per_cu);
        (void)hipGetLastError();
        grid = cus;
    }
    if (grid < 0) return;
    if (hipMemsetAsync((char*)d_ws + WS_CTL, 0, CTL_ZERO_BYTES, stream) != hipSuccess) { fprintf(stderr, "kernel_launch: hipMemsetAsync failed\n"); return; }
    Args a{};
    for (int i = 0; i < 18; ++i) a.in[i] = (const float*)d_in[i];
    a.out = (float*)d_out; a.ws = (unsigned char*)d_ws;
    static_assert(N_LAUNCHES == 1 || N_LAUNCHES == PER_PHASE, "-DMK_N_LAUNCHES must be 1 or 7");
    for (int li = 0; li < N_LAUNCHES; ++li) {
        a.ph_lo = (N_LAUNCHES == PER_PHASE) ? li : 0; a.ph_hi = (N_LAUNCHES == PER_PHASE) ? li + 1 : PER_PHASE; a.li = li;
        hipLaunchKernelGGL(mk_fwd, dim3(grid), dim3(NWAVES * 64), LDS_BYTES, stream, a);
        const hipError_t le = hipPeekAtLastError();
        if (le != hipSuccess) { fprintf(stderr, "kernel_launch: launch %d failed: %s\n", li, hipGetErrorName(le)); break; }
    }
}
```

```cpp
#include <hip/hip_runtime.h>
#include <hip/hip_bf16.h>
#include <cstdio>
#include <cstdint>
#ifndef MK_N_LAUNCHES
#define MK_N_LAUNCHES 1
#endif
constexpr int DM = 1024, NB = 16, SEQ = 2048, DB = 128, DS = 4;
constexpr int NH = 8, AW = 512, PJ = 2048, FF = 2816, FF2 = 5632;
constexpr int MP = NB * SEQ, MS = DB * DS, M = MP + MS;
constexpr int NPANEL = M / 256, NPANEL_P = MP / 256;
constexpr float EPS = 1e-6f;
constexpr float QSCALE = 0.125f * 1.4426950408889634f;
constexpr size_t O_Y = 0, O_KP = 34078720, O_VP = 50855936, O_PP = 67633152, O_FP = 67756032, O_KS = 67936256, O_VS = 68198400, O_PS = 68460544, O_FS = 69443584, O_END = 70885376;
namespace pg8 {
#define PG8_LAS __attribute__((address_space(3)))
typedef unsigned short bf16_t;
typedef short bf16x8 __attribute__((ext_vector_type(8)));
typedef float f32x4 __attribute__((ext_vector_type(4)));
typedef unsigned u32x4 __attribute__((ext_vector_type(4)));
constexpr int BM = 256, BK = 64, HALF = 128, HTB = HALF * BK * 2  , STAGE_BYTES = 8 * HTB, NXCD = 8, WGM = 8;

__host__ __device__ __forceinline__ int lds_byte(int r, int c) { const int st = (r >> 4) * 2 + (c >> 5), rr = r & 15, cc = c & 31, ob = rr * 64 + cc * 2; return st * 1024 + (ob ^ (((ob >> 9) & 1) << 5)); }
__host__ __device__ __forceinline__ void stage_rc(int b, int& R, int& C) { const int st = b / 1024, sb = b % 1024, swz = sb ^ (((sb >> 9) & 1) << 5); R = (st >> 1) * 16 + swz / 64; C = (st & 1) * 32 + (swz % 64) / 2; }
__host__ __device__ __forceinline__ int perm32(int rho) { const int n = rho >> 4, i = rho & 15; return 8 * (i >> 2) + 4 * n + (i & 3); }

struct Unit { int pm, pn; };
struct Gemm { const bf16_t* A; const bf16_t* Bt; int M, N, K; };

struct StaticOrder {
    int nM, nN, nwg, G, c;
    __host__ __device__ void init(int M, int N, int G_, int c_) { nM = M / BM; nN = N / BM; nwg = nM * nN; G = G_; c = c_; }
    __host__ __device__ bool next(int i, Unit& u) const {
        const long L = (long)i * G + c; if (L >= nwg) return false;
        int wgid = (int)L; { const int q = nwg / NXCD, r = nwg % NXCD, xcd = wgid % NXCD, off = wgid / NXCD; wgid = (xcd < r ? xcd * (q + 1) : r * (q + 1) + (xcd - r) * q) + off; }
        const int nig = WGM * nN, gid = wgid / nig, fm = gid * WGM, gsz = (nM - fm) < WGM ? (nM - fm) : WGM;
        u.pm = fm + ((wgid % nig) % gsz); u.pn = (wgid % nig) / gsz; return true;
    }
    __device__ __forceinline__ void a_ready(const Unit&) const {}
    __device__ __forceinline__ void done(const Unit&) const {}
};

typedef float f32x2c __attribute__((ext_vector_type(2))); typedef __bf16 bf16x2c __attribute__((ext_vector_type(2)));
__device__ __forceinline__ unsigned cvt_pk_bf16(float lo, float hi) { const f32x2c v = {lo, hi}; const bf16x2c b = __builtin_convertvector(v, bf16x2c); return __builtin_bit_cast(unsigned, b); }
typedef float f32x2 __attribute__((ext_vector_type(2)));
typedef unsigned u32x2 __attribute__((ext_vector_type(2)));
__device__ __forceinline__ float dpp_ror1(float v) { return __builtin_bit_cast(float, __builtin_amdgcn_update_dpp(0, __builtin_bit_cast(int, v), 0x121, 0xf, 0xf, false)); }
__device__ __forceinline__ float dpp_ror2(float v) { return __builtin_bit_cast(float, __builtin_amdgcn_update_dpp(0, __builtin_bit_cast(int, v), 0x122, 0xf, 0xf, false)); }
__device__ __forceinline__ float dpp_shr1_old(float old, float v) { return __builtin_bit_cast(float, __builtin_amdgcn_update_dpp(__builtin_bit_cast(int, old), __builtin_bit_cast(int, v), 0x111, 0xf, 0xf, false)); }
__device__ __forceinline__ float dpp_shr2_old(float old, float v) { return __builtin_bit_cast(float, __builtin_amdgcn_update_dpp(__builtin_bit_cast(int, old), __builtin_bit_cast(int, v), 0x112, 0xf, 0xf, false)); }
template <int CTRL> __device__ __forceinline__ float dppz(float v) { return __builtin_bit_cast(float, __builtin_amdgcn_update_dpp(0, __builtin_bit_cast(int, v), CTRL, 0xf, 0xf, true)); }
__device__ __forceinline__ f32x4 ror1v(f32x4 v) { return (f32x4){dpp_ror1(v[0]), dpp_ror1(v[1]), dpp_ror1(v[2]), dpp_ror1(v[3])}; }
__device__ __forceinline__ f32x4 ror2v(f32x4 v) { return (f32x4){dpp_ror2(v[0]), dpp_ror2(v[1]), dpp_ror2(v[2]), dpp_ror2(v[3])}; }
__device__ __forceinline__ float silu_mul(float g, float v) { return g * v * __builtin_amdgcn_rcpf(1.0f + __builtin_amdgcn_exp2f(-1.4426950408889634f * g)); }

struct EpiInProj {
    static constexpr bool PERM = true, AFTER_DRAIN = false, STAGED = false;
    bf16_t* QKVU; size_t tstride; float* out; const float* gq; const float* gk;
    __device__ __forceinline__ void operator()(f32x4 (&acc)[2][2][4][2], const Unit& u, int wr, int wc, int fr, int fq) const {
        const int type = u.pn >> 1, half = u.pn & 1;
        const int cbase = half * 256 + wc * 64 + 8 * fq;
        bf16_t* dst = QKVU + (size_t)type * tstride;
        f32x4 gv[2][2];
        if (type < 2) { const float* gs = (type == 0 ? gq : gk) + (half * 4 + wc) * 64 + 8 * fq; const float qs = type == 0 ? QSCALE : 1.0f;
#pragma unroll
            for (int bj = 0; bj < 2; ++bj)
#pragma unroll
                for (int n = 0; n < 2; ++n) gv[bj][n] = *(const f32x4*)(gs + 32 * bj + 4 * n) * qs; }
#pragma unroll
        for (int ai = 0; ai < 2; ++ai)
#pragma unroll
            for (int m = 0; m < 4; ++m) {
                const int row = u.pm * BM + ai * HALF + wr * 64 + m * 16 + fr;
                f32x4 v[2][2];
#pragma unroll
                for (int bj = 0; bj < 2; ++bj)
#pragma unroll
                    for (int n = 0; n < 2; ++n) v[bj][n] = acc[ai][bj][m][n];
                if (type < 2) {
                    float ss = 0.f;
#pragma unroll
                    for (int bj = 0; bj < 2; ++bj)
#pragma unroll
                        for (int n = 0; n < 2; ++n) { const f32x4 x = v[bj][n]; ss += (x[0] * x[0] + x[1] * x[1]) + (x[2] * x[2] + x[3] * x[3]); }
                    ss += __shfl_xor(ss, 16); ss += __shfl_xor(ss, 32);
                    const float r = __builtin_amdgcn_rsqf(ss * (1.0f / 64.0f) + EPS);
#pragma unroll
                    for (int bj = 0; bj < 2; ++bj)
#pragma unroll
                        for (int n = 0; n < 2; ++n) v[bj][n] = v[bj][n] * r * gv[bj][n];
                }
                bf16_t* rowp = dst + (size_t)row * 512 + cbase;
#pragma unroll
                for (int bj = 0; bj < 2; ++bj) { u32x4 w; w.x = cvt_pk_bf16(v[bj][0][0], v[bj][0][1]); w.y = cvt_pk_bf16(v[bj][0][2], v[bj][0][3]); w.z = cvt_pk_bf16(v[bj][1][0], v[bj][1][1]); w.w = cvt_pk_bf16(v[bj][1][2], v[bj][1][3]);
                    *(u32x4*)(rowp + 32 * bj) = w; }
                if (type == 1 || type == 2) {
                    float* o = out + (type == 1 ? O_KP : O_VP) + (size_t)row * 512 + cbase;
#pragma unroll
                    for (int bj = 0; bj < 2; ++bj) { __builtin_nontemporal_store(v[bj][0], (f32x4*)(o + 32 * bj)); __builtin_nontemporal_store(v[bj][1], (f32x4*)(o + 32 * bj + 4)); }
                } else if (type == 3) {
                    float* o = nullptr;
                    { const int t = row & (SEQ - 1); if (t >= SEQ - 15) o = out + O_PP + ((size_t)(row >> 11) * 15 + (t - (SEQ - 15))) * 512 + cbase; }
                    if (o) {
#pragma unroll
                        for (int bj = 0; bj < 2; ++bj) { *(f32x4*)(o + 32 * bj) = v[bj][0]; *(f32x4*)(o + 32 * bj + 4) = v[bj][1]; } }
                }
            }
    }
};

struct EpiOutProj {
    static constexpr bool PERM = true, AFTER_DRAIN = false, STAGED = false;
    const float* xp; bf16_t* HB; float* ssp; PG8_LAS float* tab;
    __device__ __forceinline__ void operator()(f32x4 (&acc)[2][2][4][2], const Unit& u, int wr, int wc, int fr, int fq) const {
        const size_t off0 = (size_t)(u.pm * BM + wr * 64 + fr) * DM + u.pn * BM + wc * 32 + 8 * fq;
#pragma unroll
        for (int ai = 0; ai < 2; ++ai) {
            f32x4 xv[4][2][2];
#pragma unroll
            for (int m = 0; m < 4; ++m)
#pragma unroll
                for (int bj = 0; bj < 2; ++bj) { const float* xr = xp + off0 + (size_t)(ai * HALF + m * 16) * DM + bj * HALF; xv[m][bj][0] = __builtin_nontemporal_load((const f32x4*)xr); xv[m][bj][1] = __builtin_nontemporal_load((const f32x4*)(xr + 4)); }
            __builtin_amdgcn_sched_barrier(0);
#pragma unroll
            for (int m = 0; m < 4; ++m) {
                const int lrow = ai * HALF + wr * 64 + m * 16 + fr;
                float part = 0.f;
#pragma unroll
                for (int bj = 0; bj < 2; ++bj) {
                    const f32x4 h0 = xv[m][bj][0] + acc[ai][bj][m][0], h1 = xv[m][bj][1] + acc[ai][bj][m][1];
                    u32x4 w; w.x = cvt_pk_bf16(h0[0], h0[1]); w.y = cvt_pk_bf16(h0[2], h0[3]); w.z = cvt_pk_bf16(h1[0], h1[1]); w.w = cvt_pk_bf16(h1[2], h1[3]);
                    *(u32x4*)(HB + off0 + (size_t)(ai * HALF + m * 16) * DM + bj * HALF) = w;
                    part += (h0[0] * h0[0] + h0[1] * h0[1]) + (h0[2] * h0[2] + h0[3] * h0[3]) + (h1[0] * h1[0] + h1[1] * h1[1]) + (h1[2] * h1[2] + h1[3] * h1[3]);
                }
                part += __shfl_xor(part, 16); part += __shfl_xor(part, 32);
                if (fq == 0) tab[lrow * 4 + wc] = part;
            }
            __builtin_amdgcn_sched_barrier(0);
        }
        asm volatile("s_waitcnt lgkmcnt(0)" ::: "memory"); __builtin_amdgcn_s_barrier(); asm volatile("" ::: "memory");
        const int tid = (wr * 4 + wc) * 64 + fq * 16 + fr;
        if (tid < BM) { const f32x4 t = *(const PG8_LAS f32x4*)(tab + tid * 4); ssp[(size_t)(u.pm * BM + tid) * 4 + u.pn] = (t[0] + t[1]) + (t[2] + t[3]); }
    }
};

struct EpiUp {
    static constexpr bool PERM = true, AFTER_DRAIN = false, STAGED = true;
    bf16_t* ACT; const float* ssp; float* halo; float* out; const float* convw; const float* convb; PG8_LAS float* tab; PG8_LAS unsigned char* epf;
    __device__ __forceinline__ void stage(const Unit& u, int slot, int wid, int lane) const {
        const float* src;
        if (wid < 4) src = ssp + (size_t)(u.pm * BM + wid * 64 + lane) * 4;
        else { const int sl = 2 * (wid - 4) + (lane >> 5), arr = sl >> 1, bj = sl & 1; src = (arr < 3 ? convw + arr * FF2 : convb) + bj * FF + u.pn * 128 + 4 * (lane & 31); }
        __builtin_amdgcn_global_load_lds((const unsigned*)src, (PG8_LAS unsigned*)(epf + slot * 8192 + wid * 1024), 16, 0, 0);
    }
    __device__ __forceinline__ void run(f32x4 (&acc)[2][2][4][2], const Unit& u, int slot, int wr, int wc, int fr, int fq) const {
        const int chb = 32 * wc + 8 * fq, ch0 = u.pn * 128 + chb;
        const PG8_LAS unsigned char* sl = epf + slot * 8192;
#pragma unroll
        for (int ai = 0; ai < 2; ++ai)
#pragma unroll
            for (int m = 0; m < 4; ++m) {
                const int row = u.pm * BM + ai * HALF + wr * 64 + m * 16 + fr;
                const f32x4 t = *(const PG8_LAS f32x4*)(sl + 16 * (ai * HALF + wr * 64 + m * 16 + fr));
                const float rr = __builtin_amdgcn_rsqf(((t[0] + t[1]) + (t[2] + t[3])) * (1.0f / DM) + EPS);
#pragma unroll
                for (int bj = 0; bj < 2; ++bj)
#pragma unroll
                    for (int n = 0; n < 2; ++n) acc[ai][bj][m][n] = acc[ai][bj][m][n] * rr;
            }
        if (fr >= 14) {
#pragma unroll
            for (int ai = 0; ai < 2; ++ai)
#pragma unroll
                for (int bj = 0; bj < 2; ++bj)
#pragma unroll
                    for (int n = 0; n < 2; ++n) *(PG8_LAS f32x4*)(tab + ((ai * 2 + wr) * 2 + (fr - 14)) * 256 + bj * 128 + chb + 4 * n) = acc[ai][bj][3][n];
        }
        {
            if (wr == 0 && fr < 2) {
#pragma unroll
                for (int bj = 0; bj < 2; ++bj)
#pragma unroll
                    for (int n = 0; n < 2; ++n) *(f32x4*)(halo + (size_t)(u.pm * 4 + fr) * FF2 + bj * FF + ch0 + 4 * n) = acc[0][bj][0][n];
            }
            if (wr == 1 && fr >= 14) {
#pragma unroll
                for (int bj = 0; bj < 2; ++bj)
#pragma unroll
                    for (int n = 0; n < 2; ++n) { *(f32x4*)(halo + (size_t)(u.pm * 4 + 2 + fr - 14) * FF2 + bj * FF + ch0 + 4 * n) = acc[1][bj][3][n];
                        if ((u.pm & 7) == 7) *(f32x4*)(out + O_FP + (size_t)((u.pm >> 3) * 2 + fr - 14) * FF2 + bj * FF + ch0 + 4 * n) = acc[1][bj][3][n]; }
            }
        }
        asm volatile("s_waitcnt lgkmcnt(0)" ::: "memory"); __builtin_amdgcn_s_barrier(); asm volatile("" ::: "memory");
#pragma unroll
        for (int n = 0; n < 2; ++n) {
            f32x4 w0[2], w1[2], w2[2], cb[2];
#pragma unroll
            for (int bj = 0; bj < 2; ++bj) { const PG8_LAS unsigned char* cp = sl + 4096 + bj * 512 + (chb + 4 * n) * 4; w0[bj] = *(const PG8_LAS f32x4*)cp; w1[bj] = *(const PG8_LAS f32x4*)(cp + 1024); w2[bj] = *(const PG8_LAS f32x4*)(cp + 2048); cb[bj] = *(const PG8_LAS f32x4*)(cp + 3072); }
            f32x4 w1m[2], w0m[2];
#pragma unroll
            for (int bj = 0; bj < 2; ++bj) { w1m[bj] = fr == 0 ? w1[bj] : (f32x4){0.f, 0.f, 0.f, 0.f}; w0m[bj] = fr < 2 ? w0[bj] : (f32x4){0.f, 0.f, 0.f, 0.f}; }
#pragma unroll
            for (int ai = 0; ai < 2; ++ai) {
                f32x4 pv[2];
                {
                    const int sb = (wr == 1) ? ai * 2 : 1;
#pragma unroll
                    for (int bj = 0; bj < 2; ++bj) { pv[bj] = (f32x4){0.f, 0.f, 0.f, 0.f}; if (fr >= 14) pv[bj] = *(const PG8_LAS f32x4*)(tab + (sb * 2 + (fr - 14)) * 256 + bj * 128 + chb + 4 * n); }
                }
#pragma unroll
                for (int m = 0; m < 4; ++m) {
                    const int row = u.pm * BM + ai * HALF + wr * 64 + m * 16 + fr;
                    f32x4 cv[2];
                    {
#pragma unroll
                        for (int bj = 0; bj < 2; ++bj) { const f32x4 cur = acc[ai][bj][m][n]; const f32x4 prv = m > 0 ? acc[ai][bj][m - 1][n] : pv[bj];
                            f32x4 c4 = cb[bj] + w2[bj] * cur;
#define FD4(CTRL, X, W) "v_fmac_f32_dpp %0, %" #X ", %" #W " " CTRL " row_mask:0xf bank_mask:0xf\n\t"
                            float c0 = c4[0], c1 = c4[1], c2 = c4[2], c3 = c4[3];
                            asm("s_nop 1\n\t"
                                "v_fmac_f32_dpp %0, %4, %12 row_shr:1 row_mask:0xf bank_mask:0xf bound_ctrl:1\n\tv_fmac_f32_dpp %1, %5, %13 row_shr:1 row_mask:0xf bank_mask:0xf bound_ctrl:1\n\t"
                                "v_fmac_f32_dpp %2, %6, %14 row_shr:1 row_mask:0xf bank_mask:0xf bound_ctrl:1\n\tv_fmac_f32_dpp %3, %7, %15 row_shr:1 row_mask:0xf bank_mask:0xf bound_ctrl:1\n\t"
                                "v_fmac_f32_dpp %0, %4, %16 row_shr:2 row_mask:0xf bank_mask:0xf bound_ctrl:1\n\tv_fmac_f32_dpp %1, %5, %17 row_shr:2 row_mask:0xf bank_mask:0xf bound_ctrl:1\n\t"
                                "v_fmac_f32_dpp %2, %6, %18 row_shr:2 row_mask:0xf bank_mask:0xf bound_ctrl:1\n\tv_fmac_f32_dpp %3, %7, %19 row_shr:2 row_mask:0xf bank_mask:0xf bound_ctrl:1\n\t"
                                "v_fmac_f32_dpp %0, %8, %20 row_ror:1 row_mask:0xf bank_mask:0xf\n\tv_fmac_f32_dpp %1, %9, %21 row_ror:1 row_mask:0xf bank_mask:0xf\n\t"
                                "v_fmac_f32_dpp %2, %10, %22 row_ror:1 row_mask:0xf bank_mask:0xf\n\tv_fmac_f32_dpp %3, %11, %23 row_ror:1 row_mask:0xf bank_mask:0xf\n\t"
                                "v_fmac_f32_dpp %0, %8, %24 row_ror:2 row_mask:0xf bank_mask:0xf\n\tv_fmac_f32_dpp %1, %9, %25 row_ror:2 row_mask:0xf bank_mask:0xf\n\t"
                                "v_fmac_f32_dpp %2, %10, %26 row_ror:2 row_mask:0xf bank_mask:0xf\n\tv_fmac_f32_dpp %3, %11, %27 row_ror:2 row_mask:0xf bank_mask:0xf"
                                : "+v"(c0), "+v"(c1), "+v"(c2), "+v"(c3)
                                : "v"(cur[0]), "v"(cur[1]), "v"(cur[2]), "v"(cur[3]), "v"(prv[0]), "v"(prv[1]), "v"(prv[2]), "v"(prv[3]),
                                  "v"(w1[bj][0]), "v"(w1[bj][1]), "v"(w1[bj][2]), "v"(w1[bj][3]), "v"(w0[bj][0]), "v"(w0[bj][1]), "v"(w0[bj][2]), "v"(w0[bj][3]),
                                  "v"(w1m[bj][0]), "v"(w1m[bj][1]), "v"(w1m[bj][2]), "v"(w1m[bj][3]), "v"(w0m[bj][0]), "v"(w0m[bj][1]), "v"(w0m[bj][2]), "v"(w0m[bj][3]));
#undef FD4
                            cv[bj] = (f32x4){c0, c1, c2, c3}; }
                    }
                    u32x2 w; w.x = cvt_pk_bf16(silu_mul(cv[0][0], cv[1][0]), silu_mul(cv[0][1], cv[1][1])); w.y = cvt_pk_bf16(silu_mul(cv[0][2], cv[1][2]), silu_mul(cv[0][3], cv[1][3]));
                    const bool skip = ai == 0 && m == 0 && wr == 0 && fr < 2;
                    if (!skip) *(u32x2*)(ACT + (size_t)row * FF + ch0 + 4 * n) = w;
                }
            }
        }
    }
};

struct EpiDown {
    static constexpr bool PERM = true, AFTER_DRAIN = false, STAGED = false;
    float* Y; const bf16_t* HB;
    __device__ __forceinline__ void operator()(f32x4 (&acc)[2][2][4][2], const Unit& u, int wr, int wc, int fr, int fq) const {
        const size_t off0 = (size_t)(u.pm * BM + wr * 64 + fr) * DM + u.pn * BM + wc * 32 + 8 * fq;
        u32x4 hb[2][4][2];
#pragma unroll
        for (int ai = 0; ai < 2; ++ai)
#pragma unroll
            for (int m = 0; m < 4; ++m)
#pragma unroll
                for (int bj = 0; bj < 2; ++bj) hb[ai][m][bj] = *(const u32x4*)(HB + off0 + (size_t)(ai * HALF + m * 16) * DM + bj * HALF);
        __builtin_amdgcn_sched_barrier(0);
#pragma unroll
        for (int ai = 0; ai < 2; ++ai)
#pragma unroll
            for (int m = 0; m < 4; ++m)
#pragma unroll
                for (int bj = 0; bj < 2; ++bj) { const u32x4 h = hb[ai][m][bj]; float* yo = Y + off0 + (size_t)(ai * HALF + m * 16) * DM + bj * HALF;
                    const f32x4 a = (f32x4){__builtin_bit_cast(float, h.x << 16), __builtin_bit_cast(float, h.x & 0xffff0000u), __builtin_bit_cast(float, h.y << 16), __builtin_bit_cast(float, h.y & 0xffff0000u)} + acc[ai][bj][m][0];
                    const f32x4 b = (f32x4){__builtin_bit_cast(float, h.z << 16), __builtin_bit_cast(float, h.z & 0xffff0000u), __builtin_bit_cast(float, h.w << 16), __builtin_bit_cast(float, h.w & 0xffff0000u)} + acc[ai][bj][m][1];
                    __builtin_nontemporal_store(a, (f32x4*)yo); __builtin_nontemporal_store(b, (f32x4*)(yo + 4)); }
    }
};

template <class Epi, class Sched, bool ALIGN_EPI = false, bool SP2 = false>
__device__ __forceinline__ void gemm_phase(PG8_LAS unsigned char* lds, const Gemm g, const Sched& S, const Epi& E) {
    const int tid = threadIdx.x, wid = __builtin_amdgcn_readfirstlane(tid >> 6), lane = tid & 63, wr = wid >> 2, wc = wid & 3, fr = lane & 15, fq = lane >> 4;
    const int K = g.K, nt = K / BK;
    unsigned voffA[2], voffB[2];
#pragma unroll
    for (int i = 0; i < 2; ++i) { int R, C; stage_rc(tid * 16 + i * 8192, R, C); const int Rb = Epi::PERM ? ((R & ~31) + perm32(R & 31)) : R;
        voffA[i] = (unsigned)(R * K + C) * 2u; voffB[i] = (unsigned)(Rb * K + C) * 2u; }
    const size_t kstep = (size_t)(BK * 2);
    const size_t hstep = (size_t)HALF * K * 2;
    const size_t tstep = 2 * hstep;
    const unsigned ldsw = (unsigned)wid * 1024u;
    const int aoff = lds_byte(wr * 64 + fr, fq * 8), boff = lds_byte(wc * 32 + fr, fq * 8);
#define PG8_SA(b, h) (((b) * 2 + (h)) * HTB)
#define PG8_SB(b, h) ((4 + (b) * 2 + (h)) * HTB)
#define PG8_STAGE(bufoff, gbase, voff) do { _Pragma("unroll") for (int _i = 0; _i < 2; ++_i) \
        __builtin_amdgcn_global_load_lds((const unsigned*)((const char*)(gbase) + (voff)[_i]), (PG8_LAS unsigned*)(lds + (bufoff) + ldsw + _i * 8192), 16, 0, 0); } while (0)
#define PG8_LDA(dst, b, h) do { _Pragma("unroll") for (int m = 0; m < 4; ++m) _Pragma("unroll") for (int k = 0; k < 2; ++k) dst[m][k] = *(const PG8_LAS bf16x8*)(lds + PG8_SA(b, h) + aoff + m * 2048 + k * 1024); } while (0)
#define PG8_LDB(dst, b, h) do { _Pragma("unroll") for (int n = 0; n < 2; ++n) _Pragma("unroll") for (int k = 0; k < 2; ++k) dst[n][k] = *(const PG8_LAS bf16x8*)(lds + PG8_SB(b, h) + boff + n * 2048 + k * 1024); } while (0)
#define PG8_MMA(ai, bj, At, Bt) do { __builtin_amdgcn_s_setprio(1); _Pragma("unroll") for (int m = 0; m < 4; ++m) _Pragma("unroll") for (int n = 0; n < 2; ++n) _Pragma("unroll") for (int k = 0; k < 2; ++k) \
        acc[ai][bj][m][n] = __builtin_amdgcn_mfma_f32_16x16x32_bf16(Bt[n][k], At[m][k], acc[ai][bj][m][n], 0, 0, 0); __builtin_amdgcn_s_setprio(0); } while (0)
#define PG8_WAIT_V(n) asm volatile("s_waitcnt vmcnt(" #n ")" ::: "memory")
#define PG8_WAIT_L(n) asm volatile("s_waitcnt lgkmcnt(" #n ")" ::: "memory")
#define PG8_BAR __builtin_amdgcn_s_barrier()
#define PG8_SCHED __builtin_amdgcn_sched_barrier(0)
    Unit cur, nxt; int ui = 0;
    if (!S.next(0, cur)) return;
    if constexpr (Epi::STAGED) E.stage(cur, 0, wid, lane);
    f32x4 acc[2][2][4][2];
#pragma unroll
    for (int a = 0; a < 2; ++a)
#pragma unroll
        for (int b = 0; b < 2; ++b)
#pragma unroll
            for (int m = 0; m < 4; ++m)
#pragma unroll
                for (int n = 0; n < 2; ++n) acc[a][b][m][n] = (f32x4){0.f, 0.f, 0.f, 0.f};
    bf16x8 At[4][2], B0[2][2], B1[2][2];
    const char* cA = (const char*)g.A + (size_t)cur.pm * tstep; const char* cB = (const char*)g.Bt + (size_t)cur.pn * tstep;
    S.a_ready(cur);
    if constexpr (SP2) {
        PG8_STAGE(PG8_SB(0, 0), cB, voffB); PG8_STAGE(PG8_SB(0, 1), cB + hstep, voffB); PG8_STAGE(PG8_SA(0, 0), cA, voffA); PG8_STAGE(PG8_SA(0, 1), cA + hstep, voffA);
        if (wr == 1) PG8_BAR;
        PG8_WAIT_V(2); PG8_BAR;
        PG8_STAGE(PG8_SB(1, 0), cB + kstep, voffB); PG8_STAGE(PG8_SA(1, 0), cA + kstep, voffA); PG8_STAGE(PG8_SB(1, 1), cB + hstep + kstep, voffB);
        PG8_WAIT_V(6); PG8_BAR;
    } else {
        PG8_STAGE(PG8_SB(0, 0), cB, voffB); PG8_STAGE(PG8_SA(0, 0), cA, voffA); PG8_STAGE(PG8_SB(0, 1), cB + hstep, voffB); PG8_STAGE(PG8_SA(0, 1), cA + hstep, voffA);
        if (wr == 1) PG8_BAR;
        PG8_WAIT_V(4); PG8_BAR;
        PG8_STAGE(PG8_SB(1, 0), cB + kstep, voffB); PG8_STAGE(PG8_SA(1, 0), cA + kstep, voffA); PG8_STAGE(PG8_SB(1, 1), cB + hstep + kstep, voffB);
        PG8_WAIT_V(6); PG8_BAR;
    }
    for (;;) {
        const bool has_next = S.next(ui + 1, nxt);
        const char* nA = has_next ? (const char*)g.A + (size_t)nxt.pm * tstep : cA; const char* nB = has_next ? (const char*)g.Bt + (size_t)nxt.pn * tstep : cB;
        for (int t = 0; t < nt; t += 2) {
            const bool last = (t == nt - 2);
            const char* a1 = cA + (size_t)(t + 1) * kstep;
            const char* a2 = last ? nA : cA + (size_t)(t + 2) * kstep; const char* b2 = last ? nB : cB + (size_t)(t + 2) * kstep;
            const char* a3 = a2 + kstep; const char* b3 = b2 + kstep;
            if (last && has_next) S.a_ready(nxt);
            if constexpr (SP2) {
            PG8_LDB(B0, 0, 0); PG8_LDB(B1, 0, 1); PG8_SCHED; PG8_LDA(At, 0, 0); PG8_STAGE(PG8_SA(1, 1), a1 + hstep, voffA);
            PG8_WAIT_V(8); PG8_WAIT_L(0); PG8_BAR; PG8_MMA(0, 0, At, B0); PG8_MMA(0, 1, At, B1); PG8_BAR; PG8_SCHED;
            PG8_LDA(At, 0, 1); PG8_STAGE(PG8_SB(0, 0), b2, voffB); PG8_STAGE(PG8_SB(0, 1), b2 + hstep, voffB); PG8_STAGE(PG8_SA(0, 0), a2, voffA);
            PG8_WAIT_V(8); PG8_WAIT_L(0); PG8_BAR; PG8_MMA(1, 0, At, B0); PG8_MMA(1, 1, At, B1); PG8_BAR; PG8_SCHED;
            PG8_LDB(B0, 1, 0); PG8_LDB(B1, 1, 1); PG8_SCHED; PG8_LDA(At, 1, 0); PG8_STAGE(PG8_SA(0, 1), a2 + hstep, voffA);
            PG8_WAIT_V(8); PG8_WAIT_L(0); PG8_BAR; PG8_MMA(0, 0, At, B0); PG8_MMA(0, 1, At, B1); PG8_BAR; PG8_SCHED;
            PG8_LDA(At, 1, 1); PG8_STAGE(PG8_SB(1, 0), b3, voffB); PG8_STAGE(PG8_SB(1, 1), b3 + hstep, voffB); PG8_STAGE(PG8_SA(1, 0), a3, voffA);
            PG8_WAIT_V(8); PG8_WAIT_L(0); PG8_BAR; PG8_MMA(1, 0, At, B0); PG8_MMA(1, 1, At, B1); PG8_BAR; PG8_SCHED;
            } else {
            PG8_LDB(B0, 0, 0); PG8_SCHED; PG8_LDA(At, 0, 0); PG8_STAGE(PG8_SA(1, 1), a1 + hstep, voffA);
            PG8_WAIT_L(8); PG8_BAR; PG8_WAIT_L(0); PG8_MMA(0, 0, At, B0); PG8_BAR; PG8_SCHED;
            PG8_LDB(B1, 0, 1); PG8_STAGE(PG8_SB(0, 0), b2, voffB);
            PG8_BAR; PG8_WAIT_L(0); PG8_MMA(0, 1, At, B1); PG8_BAR;
            PG8_LDA(At, 0, 1); PG8_STAGE(PG8_SA(0, 0), a2, voffA);
            PG8_BAR; PG8_WAIT_L(0); PG8_MMA(1, 0, At, B0); PG8_BAR; PG8_SCHED;
            PG8_STAGE(PG8_SB(0, 1), b2 + hstep, voffB);
            PG8_WAIT_V(6); PG8_BAR; PG8_MMA(1, 1, At, B1); PG8_BAR;
            PG8_LDB(B0, 1, 0); PG8_SCHED; PG8_LDA(At, 1, 0); PG8_STAGE(PG8_SA(0, 1), a2 + hstep, voffA);
            PG8_WAIT_L(8); PG8_BAR; PG8_WAIT_L(0); PG8_MMA(0, 0, At, B0); PG8_BAR; PG8_SCHED;
            PG8_LDB(B1, 1, 1); PG8_STAGE(PG8_SB(1, 0), b3, voffB);
            PG8_BAR; PG8_WAIT_L(0); PG8_MMA(0, 1, At, B1); PG8_BAR;
            PG8_LDA(At, 1, 1); PG8_STAGE(PG8_SA(1, 0), a3, voffA);
            PG8_BAR; PG8_WAIT_L(0); PG8_MMA(1, 0, At, B0); PG8_BAR; PG8_SCHED;
            PG8_STAGE(PG8_SB(1, 1), b3 + hstep, voffB);
            PG8_WAIT_V(6); PG8_BAR; PG8_MMA(1, 1, At, B1); PG8_BAR;
            }
        }
        if constexpr (ALIGN_EPI) { if (wr == 0) PG8_BAR; }
        if constexpr (Epi::STAGED) { if (has_next) E.stage(nxt, (ui + 1) & 1, wid, lane); E.run(acc, cur, ui & 1, wr, wc, fr, fq); S.done(cur); }
        else if constexpr (!Epi::AFTER_DRAIN) { E(acc, cur, wr, wc, fr, fq); S.done(cur); }
        if (!has_next) break;
#pragma unroll
        for (int a = 0; a < 2; ++a)
#pragma unroll
            for (int b = 0; b < 2; ++b)
#pragma unroll
                for (int m = 0; m < 4; ++m)
#pragma unroll
                    for (int n = 0; n < 2; ++n) acc[a][b][m][n] = (f32x4){0.f, 0.f, 0.f, 0.f};
        cur = nxt; cA = nA; cB = nB; ++ui;
        if constexpr (ALIGN_EPI) { if (wr == 1) PG8_BAR; }
    }
    PG8_WAIT_V(0);
    if constexpr (!ALIGN_EPI) { if (wr == 0) PG8_BAR; }
    PG8_BAR;
    if constexpr (Epi::AFTER_DRAIN) { E.fused(acc, cur, wr, wc, fr, fq, lds, wid, lane); S.done(cur); }
#undef PG8_SA
#undef PG8_SB
#undef PG8_STAGE
#undef PG8_LDA
#undef PG8_LDB
#undef PG8_MMA
#undef PG8_WAIT_V
#undef PG8_WAIT_L
#undef PG8_BAR
#undef PG8_SCHED
}
}

constexpr int NWAVES = 8;
constexpr int N_LAUNCHES = MK_N_LAUNCHES;
constexpr int PER_PHASE = 7;
constexpr size_t MiB = 1u << 20;
constexpr size_t WS_CTL = 0, CTL_ZERO_BYTES = 64 * 1024;
constexpr size_t WS_WIN = 2 * MiB, WS_WOUT = 6 * MiB, WS_WUP = 8 * MiB, WS_WDN = 20 * MiB, WS_WPOOL = 26 * MiB;
constexpr size_t WS_HALO = 28 * MiB;
constexpr size_t WS_SSP = 40 * MiB;
constexpr size_t WS_SSPS = 42 * MiB;
constexpr size_t WS_XN = 44 * MiB;
constexpr size_t WS_Q = 110 * MiB, QKVU_STRIDE = 33 * MiB;
constexpr size_t WS_MIX = 242 * MiB;
constexpr size_t WS_HB = 308 * MiB;
constexpr size_t WS_ACT = 374 * MiB;
constexpr size_t WS_OP = 554 * MiB;
constexpr size_t WS_LSE = 650 * MiB;
constexpr size_t WS_END = 654 * MiB;
static_assert(WS_XN + (size_t)M * DM * 2 <= WS_Q && WS_Q + 4 * QKVU_STRIDE <= WS_MIX && WS_MIX + (size_t)M * DM * 2 <= WS_HB && WS_HB + (size_t)M * DM * 2 <= WS_ACT && WS_ACT + (size_t)M * FF * 2 <= WS_OP && WS_OP + (size_t)3 * MP * 512 * 2 <= WS_LSE && WS_LSE + (size_t)3 * MP * 8 * 4 <= WS_END, "d_ws map");
static_assert(WS_HALO + (size_t)NPANEL * 4 * FF2 * 4 <= WS_SSP && WS_SSP + (size_t)M * 16 * 4 <= WS_XN && (size_t)M * 512 * 2 <= QKVU_STRIDE, "d_ws map 2");
constexpr int CW_TMO = 0, CW_CODE = 1, CW_BAR = 4096;
constexpr int RING_OFF = 0, RING_BYTES = 131072;
constexpr int TAB_OFF = RING_BYTES;
constexpr int LDSCTL_OFF = RING_BYTES + 8192, MISC_OFF = LDSCTL_OFF + 320;
constexpr int EPF_OFF = 140288;
constexpr int LDS_BYTES = 163840;
static_assert(MISC_OFF + 128 <= EPF_OFF && EPF_OFF + 2 * 8192 <= LDS_BYTES, "LDS map 2");
static_assert(MISC_OFF + 128 <= LDS_BYTES, "LDS map");
#define GAS __attribute__((address_space(1)))
#define LAS __attribute__((address_space(3)))
typedef unsigned short bf16;
typedef unsigned v4u __attribute__((ext_vector_type(4)));
typedef float f32x4 __attribute__((ext_vector_type(4)));
typedef short bf16x8 __attribute__((ext_vector_type(8)));
typedef GAS unsigned gu32;
typedef GAS unsigned long long gu64;
#define RLX_AGENT __ATOMIC_RELAXED, __HIP_MEMORY_SCOPE_AGENT
#define LDS_WAIT() asm volatile("s_waitcnt lgkmcnt(0)" ::: "memory")
#define VM_WAIT() asm volatile("s_waitcnt vmcnt(0)" ::: "memory")
__device__ __forceinline__ unsigned long long rt() { return __builtin_amdgcn_s_memrealtime(); }
__device__ __forceinline__ unsigned f2bf(float f) { unsigned u = __builtin_bit_cast(unsigned, f); return (u + 0x7fffu + ((u >> 16) & 1u)) >> 16; }
__device__ __forceinline__ unsigned pk2(float lo, float hi) { return f2bf(lo) | (f2bf(hi) << 16); }

#define XB_TMO      128
#define XB_XCNT(j)  (256  + 64 * (j))
#define XB_XSUB(j)  (1280 + 64 * (j))
#define XB_XGEN(j)  (2304 + 64 * (j))
#define XB_TOP      3328
#define XB_TOPGEN   3392
#define XCD_BAR_WORDS 3456
#define XB_SPIN_CAP (1u << 18)

__device__ __forceinline__ unsigned xb_ld(unsigned* p)              { return __hip_atomic_load(p, __ATOMIC_RELAXED, __HIP_MEMORY_SCOPE_AGENT); }
__device__ __forceinline__ unsigned xb_add(unsigned* p, unsigned v) { return __hip_atomic_fetch_add(p, v, __ATOMIC_RELAXED, __HIP_MEMORY_SCOPE_AGENT); }
__device__ __forceinline__ unsigned xb_xcc_id() { return (unsigned)__builtin_amdgcn_s_getreg((3 << 11) | 20) & 0xFu; }
#define XB_SPIN(cond, bar) do { unsigned _sp = 0; while (cond) { __builtin_amdgcn_s_sleep(1); \
    if ((++_sp & 255u) == 0u) { if (xb_ld(&(bar)[XB_TMO])) break; if (_sp > XB_SPIN_CAP) { atomicAdd(&(bar)[XB_TMO], 1u); break; } } } } while (0)

struct XcdBarrier {
    unsigned* bar; unsigned x;
    volatile LAS unsigned* st;
};

__device__ __forceinline__ XcdBarrier xcd_barrier_post(unsigned* bar, volatile LAS unsigned* st) {
    XcdBarrier b; b.bar = bar; b.x = xb_xcc_id(); b.st = st;
    if (threadIdx.x == 0) (void)xb_add(&bar[XB_XCNT(b.x)], 1u);
    return b;
}
__device__ __forceinline__ void xcd_barrier_complete(unsigned* bar, unsigned x, unsigned& nloc, unsigned& nx) {
    const unsigned G = gridDim.x * gridDim.y * gridDim.z;
    unsigned sum, cnt, mine, sp = 0u;
    for (;;) {
        sum = 0u; cnt = 0u; mine = 0u;
#pragma unroll
        for (unsigned j = 0; j < 16; ++j) { const unsigned c = xb_ld(&bar[XB_XCNT(j)]); sum += c; cnt += (c > 0u) ? 1u : 0u; mine = (j == x) ? c : mine; }
        if (sum == G) break;
        __builtin_amdgcn_s_sleep(1);
        if ((++sp & 255u) == 0u) { if (xb_ld(&bar[XB_TMO])) break; if (sp > XB_SPIN_CAP) { atomicAdd(&bar[XB_TMO], 1u); break; } }
    }
    nloc = mine > 0u ? mine : 1u; nx = cnt > 0u ? cnt : 1u;
}

__device__ __forceinline__ void xcd_barrier(const XcdBarrier& b) {
    asm volatile("s_waitcnt vmcnt(0)" ::: "memory");
    __syncthreads();
    if (threadIdx.x == 0) {
        unsigned* bar = b.bar;
        __builtin_amdgcn_s_waitcnt(0);
        unsigned nloc = b.st[0], nx = b.st[1];
        if (nloc == 0u) { xcd_barrier_complete(bar, b.x, nloc, nx); b.st[0] = nloc; b.st[1] = nx; }
        const unsigned old = xb_add(&bar[XB_XSUB(b.x)], 1u);
        const unsigned gen = old / nloc;
        if (old + 1u == (gen + 1u) * nloc) {
            __builtin_amdgcn_fence(__ATOMIC_RELEASE, "agent");
            asm volatile("s_waitcnt vmcnt(0)" ::: "memory");
            const unsigned og = xb_add(&bar[XB_TOP], 1u);
            const unsigned tg = og / nx;
            if (og + 1u == (tg + 1u) * nx) xb_add(&bar[XB_TOPGEN], 1u);
            else XB_SPIN(xb_ld(&bar[XB_TOPGEN]) == tg, bar);
            __builtin_amdgcn_fence(__ATOMIC_ACQUIRE, "agent");
            xb_add(&bar[XB_XGEN(b.x)], 1u);
            asm volatile("s_waitcnt vmcnt(0)" ::: "memory");
        } else {
            XB_SPIN(xb_ld(&bar[XB_XGEN(b.x)]) == gen, bar);
            __builtin_amdgcn_fence(__ATOMIC_ACQUIRE, "agent");
            asm volatile("s_waitcnt vmcnt(0)" ::: "memory");
        }
    }
    __syncthreads();
}

typedef unsigned u32x4_t __attribute__((ext_vector_type(4)));
typedef unsigned u32x2_t __attribute__((ext_vector_type(2)));
typedef short v4i16_t __attribute__((ext_vector_type(4)));
struct Frame {
    LAS unsigned char* lds;
    volatile LAS unsigned* MISC;
    gu32* ctl;
    int tid, lane, wave;
    int vcu, G;
    const float* in[18]; float* out; unsigned char* ws;
};
__device__ __forceinline__ float wave_sum(float v) {
#pragma unroll
    for (int o = 1; o < 64; o <<= 1) v += __shfl_xor(v, o);
    return v;
}
typedef float f32x2_t __attribute__((ext_vector_type(2))); typedef __bf16 bf16x2_t __attribute__((ext_vector_type(2)));
__device__ __forceinline__ unsigned cvtpk(float lo, float hi) { const f32x2_t v = {lo, hi}; const bf16x2_t b = __builtin_convertvector(v, bf16x2_t); return __builtin_bit_cast(unsigned, b); }
__device__ __forceinline__ bf16x8 cvt8(f32x4 a, f32x4 b) { u32x4_t w; w.x = cvtpk(a[0], a[1]); w.y = cvtpk(a[2], a[3]); w.z = cvtpk(b[0], b[1]); w.w = cvtpk(b[2], b[3]); return __builtin_bit_cast(bf16x8, w); }
__device__ __forceinline__ float bf2f(unsigned short b) { return __builtin_bit_cast(float, (unsigned)b << 16); }

__device__ __forceinline__ int dest_row_base(int mode, int n0) {
    if (mode == 1) { const int c0 = n0 & 255; return (n0 & ~255) + 128 * ((c0 >> 5) & 1) + 32 * (c0 >> 6); }
    if (mode == 2) { const int half = n0 >= FF ? 1 : 0, chn = n0 - half * FF; return 256 * (chn >> 7) + 128 * half + (chn & 127); }
    return n0;
}
__device__ __forceinline__ void p0_transpose_item(const float* W, int K, int N, bf16* WT, int mode, const float* kscale, LAS float* scr, int item, int lane) {
    const int nblk = N / 32, kb = item / nblk, nb = item % nblk, k0 = 64 * kb, n0 = 32 * nb;
    { f32x4 v[8]; const int n4 = 4 * (lane & 7);
#pragma unroll
      for (int i = 0; i < 8; ++i) v[i] = __builtin_nontemporal_load((const f32x4*)(W + (size_t)(k0 + 8 * i + (lane >> 3)) * N + n0 + n4));
#pragma unroll
      for (int i = 0; i < 8; ++i) { const int kk = 8 * i + (lane >> 3); const float sc = kscale ? kscale[k0 + kk] : 1.0f;
#pragma unroll
          for (int j = 0; j < 4; ++j) scr[kk * 33 + n4 + j] = v[i][j] * sc; } }
    LDS_WAIT(); asm volatile("" ::: "memory");
    const int c = lane & 7, rb = dest_row_base(mode, n0);
#pragma unroll
    for (int j = 0; j < 4; ++j) { const int n = (lane >> 3) + 8 * j; const LAS float* s = scr + (8 * c) * 33 + n;
        v4u o; o.x = pk2(s[0 * 33], s[1 * 33]); o.y = pk2(s[2 * 33], s[3 * 33]); o.z = pk2(s[4 * 33], s[5 * 33]); o.w = pk2(s[6 * 33], s[7 * 33]);
        *(GAS v4u*)(WT + (size_t)(rb + n) * K + k0 + 8 * c) = o; }
    LDS_WAIT(); asm volatile("" ::: "memory");
}
template <int NR> __device__ __forceinline__ void rms_rows_to_bf16(const float* const (&xrow)[NR], const float* g, bf16* const (&orow)[NR], int lane) {
    f32x4 v[NR][4]; float s[NR];
#pragma unroll
    for (int r = 0; r < NR; ++r) { const GAS f32x4* xr = (const GAS f32x4*)xrow[r] + 2 * lane;
#pragma unroll
        for (int j = 0; j < 2; ++j) { v[r][2 * j] = __builtin_nontemporal_load(xr + 128 * j); v[r][2 * j + 1] = __builtin_nontemporal_load(xr + 128 * j + 1); } }
    const GAS f32x4* gr = (const GAS f32x4*)g + 2 * lane; f32x4 gg[4];
#pragma unroll
    for (int j = 0; j < 2; ++j) { gg[2 * j] = gr[128 * j]; gg[2 * j + 1] = gr[128 * j + 1]; }
#pragma unroll
    for (int r = 0; r < NR; ++r) { s[r] = 0.f;
#pragma unroll
        for (int j = 0; j < 4; ++j) s[r] += (v[r][j].x * v[r][j].x + v[r][j].y * v[r][j].y) + (v[r][j].z * v[r][j].z + v[r][j].w * v[r][j].w); }
#pragma unroll
    for (int r = 0; r < NR; ++r) { const float rr = 1.f / sqrtf(wave_sum(s[r]) * (1.f / DM) + EPS);
        GAS v4u* o16 = (GAS v4u*)orow[r] + lane;
#pragma unroll
        for (int j = 0; j < 2; ++j) { const f32x4 a = v[r][2 * j] * rr * gg[2 * j], c = v[r][2 * j + 1] * rr * gg[2 * j + 1];
            v4u o; o.x = pk2(a.x, a.y); o.y = pk2(a.z, a.w); o.z = pk2(c.x, c.y); o.w = pk2(c.z, c.w); o16[64 * j] = o; } }
}
__device__ __forceinline__ void p0_prologue(Frame& F) {
    LAS float* scr = (LAS float*)(F.lds + RING_OFF + F.wave * 16384);
    const int gw = F.vcu * NWAVES + F.wave, NGW = F.G * NWAVES;
    constexpr int I_IN = (DM / 64) * (PJ / 32), I_OUT = (DM / 64) * (DM / 32), I_UP = (DM / 64) * (FF2 / 32), I_DN = (FF / 64) * (DM / 32), I_PL = (128 / 64) * (128 / 32);
    constexpr int NITEMS = I_IN + I_OUT + I_UP + I_DN + 4 * I_PL;
    bf16* ws16 = (bf16*)F.ws;
    for (int it = gw; it < NITEMS; it += NGW) {
        int r = it;
        if (r < I_IN) { p0_transpose_item(F.in[7], DM, PJ, (bf16*)(F.ws + WS_WIN), 1, nullptr, scr, r, F.lane); continue; } r -= I_IN;
        if (r < I_OUT) { p0_transpose_item(F.in[12], DM, DM, (bf16*)(F.ws + WS_WOUT), 0, nullptr, scr, r, F.lane); continue; } r -= I_OUT;
        if (r < I_UP) { p0_transpose_item(F.in[14], DM, FF2, (bf16*)(F.ws + WS_WUP), 2, F.in[13], scr, r, F.lane); continue; } r -= I_UP;
        if (r < I_DN) { p0_transpose_item(F.in[17], FF, DM, (bf16*)(F.ws + WS_WDN), 0, nullptr, scr, r, F.lane); continue; } r -= I_DN;
        { const int g = r / I_PL; p0_transpose_item(F.in[10] + (size_t)g * 128 * 128, 128, 128, (bf16*)(F.ws + WS_WPOOL) + (size_t)g * 128 * 128, 0, nullptr, scr, r % I_PL, F.lane); }
    }
    (void)ws16;
    for (int m0 = gw * 8; m0 < M; m0 += NGW * 8) {
        const float* xr[8]; bf16* orw[8];
#pragma unroll
        for (int r = 0; r < 8; ++r) { const int m = m0 + r; xr[r] = m < MP ? F.in[0] + (size_t)m * DM : F.in[1] + (size_t)(m - MP) * DM; orw[r] = (bf16*)(F.ws + WS_XN) + (size_t)m * DM; }
        rms_rows_to_bf16<8>(xr, F.in[6], orw, F.lane);
    }
    { const int gt = F.vcu * (NWAVES * 64) + F.tid, NT = F.G * NWAVES * 64;
      for (int i = gt; i < DB * 11 * 128; i += NT) { const int b = i / (11 * 128), rem = i % (11 * 128), j = rem >> 7, c4 = rem & 127;
          *(f32x4*)(F.out + O_PS + ((size_t)b * 15 + j) * 512 + 4 * c4) = *(const f32x4*)(F.in[4] + ((size_t)b * 15 + 4 + j) * 512 + 4 * c4); } }
}

__device__ __forceinline__ float max4g(float v) {
    auto a = __builtin_amdgcn_permlane16_swap(__float_as_uint(v), __float_as_uint(v), false, false); v = fmaxf(__uint_as_float(a[0]), __uint_as_float(a[1]));
    auto b = __builtin_amdgcn_permlane32_swap(__float_as_uint(v), __float_as_uint(v), false, false); return fmaxf(__uint_as_float(b[0]), __uint_as_float(b[1]));
}
__device__ __forceinline__ float sum4g(float v) {
    auto a = __builtin_amdgcn_permlane16_swap(__float_as_uint(v), __float_as_uint(v), false, false); v = __uint_as_float(a[0]) + __uint_as_float(a[1]);
    auto b = __builtin_amdgcn_permlane32_swap(__float_as_uint(v), __float_as_uint(v), false, false); return __uint_as_float(b[0]) + __uint_as_float(b[1]);
}
constexpr int VROW = 160;
constexpr int VTILE = 32 * VROW;
struct AState { float m, l; f32x4 o[4]; };
template <bool SAMPLE> struct KVRaw;
template <> struct KVRaw<false> { bf16x8 k[2][2]; bf16x8 v[4]; };
template <> struct KVRaw<true> { f32x4 k[2][2][2]; f32x4 v[8]; };
template <bool SAMPLE> __device__ __forceinline__ const void* kv_row(const void* base, const void* newb, int j, int rs, int cr, int b, int h) {
    int a = (j << rs) + cr;
    if (!SAMPLE) { a = a > SEQ - 1 ? SEQ - 1 : a; return (const bf16*)base + ((size_t)(b * SEQ + a) * AW + h * 64); }
    a = a > 2048 + DS - 1 ? 2048 + DS - 1 : a;
    return a < 2048 ? (const float*)base + ((size_t)(b * 2048 + a) * AW + h * 64) : (const float*)newb + ((size_t)(b * DS + a - 2048) * AW + h * 64);
}
template <bool SAMPLE> __device__ __forceinline__ void kv_load(KVRaw<SAMPLE>& R, const void* Kb, const void* Kn, const void* Vb, const void* Vn, int kb, int rs, int cr, int b, int h, int lane) {
    const int g = lane >> 4, c15 = lane & 15;
#pragma unroll
    for (int t = 0; t < 2; ++t) { const void* p = kv_row<SAMPLE>(Kb, Kn, 16 * (kb + t) + c15, rs, cr, b, h);
#pragma unroll
        for (int s = 0; s < 2; ++s) {
            if constexpr (!SAMPLE) R.k[t][s] = *(const bf16x8*)((const bf16*)p + 32 * s + 8 * g);
            else { R.k[t][s][0] = *(const f32x4*)((const float*)p + 32 * s + 8 * g); R.k[t][s][1] = *(const f32x4*)((const float*)p + 32 * s + 8 * g + 4); } } }
    { const void* p = kv_row<SAMPLE>(Vb, Vn, 16 * kb + (lane >> 1), rs, cr, b, h); const int hh = lane & 1;
        if constexpr (!SAMPLE) {
#pragma unroll
            for (int i = 0; i < 4; ++i) R.v[i] = *(const bf16x8*)((const bf16*)p + 32 * hh + 8 * i);
        } else {
#pragma unroll
            for (int i = 0; i < 8; ++i) R.v[i] = *(const f32x4*)((const float*)p + 32 * hh + 4 * i);
        } }
}
template <bool SAMPLE> __device__ __forceinline__ void attn_step(AState& st, const KVRaw<SAMPLE>& R, const bf16x8 (&qf)[2], int kb, int qsub, float sl2r, int dmin, int mt, LAS unsigned char* vl, int lane) {
    const int g = lane >> 4;
    { LAS unsigned char* wp = vl + (lane >> 1) * VROW + (lane & 1) * 64;
#pragma unroll
        for (int i = 0; i < 4; ++i) { bf16x8 x; if constexpr (!SAMPLE) x = R.v[i]; else x = cvt8(R.v[2 * i], R.v[2 * i + 1]); *(LAS bf16x8*)(wp + 16 * i) = x; } }
    f32x4 s[2];
#pragma unroll
    for (int t = 0; t < 2; ++t) { bf16x8 k0, k1; if constexpr (!SAMPLE) { k0 = R.k[t][0]; k1 = R.k[t][1]; } else { k0 = cvt8(R.k[t][0][0], R.k[t][0][1]); k1 = cvt8(R.k[t][1][0], R.k[t][1][1]); }
        s[t] = __builtin_amdgcn_mfma_f32_16x16x32_bf16(k0, qf[0], (f32x4){0.f, 0.f, 0.f, 0.f}, 0, 0, 0);
        s[t] = __builtin_amdgcn_mfma_f32_16x16x32_bf16(k1, qf[1], s[t], 0, 0, 0); }
    float mx = -INFINITY;
#pragma unroll
    for (int t = 0; t < 2; ++t)
#pragma unroll
        for (int i = 0; i < 4; ++i) { const int d = qsub - (16 * (kb + t) + 4 * g + i);
            const float lg = (mt >= 1 && (d & 3) == 0) ? ((mt == 2 && (d & 15) == 0) ? 1.5849625007211562f : 1.0f) : 0.f;
            const float x = ((unsigned)(d - dmin) <= (unsigned)(128 - dmin)) ? s[t][i] - sl2r * (float)d + lg : -INFINITY; s[t][i] = x; mx = fmaxf(mx, x); }
    mx = max4g(mx);
    const float mn = fmaxf(st.m, mx), alpha = __builtin_amdgcn_exp2f(st.m - mn); st.m = mn;
    float ps = 0.f;
#pragma unroll
    for (int t = 0; t < 2; ++t)
#pragma unroll
        for (int i = 0; i < 4; ++i) { const float p = __builtin_amdgcn_exp2f(s[t][i] - mn); s[t][i] = p; ps += p; }
    st.l = st.l * alpha + ps;
#pragma unroll
    for (int c = 0; c < 4; ++c) st.o[c] = st.o[c] * alpha;
    const bf16x8 pf = cvt8(s[0], s[1]);
    const LAS unsigned char* rp = vl + (4 * g + ((lane & 15) >> 2)) * VROW + (lane & 3) * 8;
#pragma unroll
    for (int c = 0; c < 4; ++c) {
        const v4i16_t a = __builtin_amdgcn_ds_read_tr16_b64_v4i16((LAS v4i16_t*)(rp + 32 * c));
        const v4i16_t bq = __builtin_amdgcn_ds_read_tr16_b64_v4i16((LAS v4i16_t*)(rp + 16 * VROW + 32 * c));
        const bf16x8 vf = (bf16x8){a[0], a[1], a[2], a[3], bq[0], bq[1], bq[2], bq[3]};
        st.o[c] = __builtin_amdgcn_mfma_f32_16x16x32_bf16(vf, pf, st.o[c], 0, 0, 0);
    }
}
__device__ __forceinline__ void attn_init(AState& st) { st.m = -1e30f; st.l = 0.f;
#pragma unroll
    for (int c = 0; c < 4; ++c) st.o[c] = (f32x4){0.f, 0.f, 0.f, 0.f}; }
__device__ __forceinline__ void attn_store(const AState& st, bf16* orow  , int lane) {
    const float l = sum4g(st.l);
    const float il = 1.0f / l; const int g = lane >> 4;
    if (orow) {
#pragma unroll
        for (int c = 0; c < 4; ++c) { u32x2_t w; w.x = cvtpk(st.o[c][0] * il, st.o[c][1] * il); w.y = cvtpk(st.o[c][2] * il, st.o[c][3] * il); *(u32x2_t*)(orow + 16 * c + 4 * g) = w; } }
}
constexpr int KP = 144, VP = 160, KT_ROWS = 256;
constexpr int KT_OFF = 0, VT_OFF = KT_ROWS * KP, SV_OFF = VT_OFF + KT_ROWS * VP;
static_assert(SV_OFF + 8 * VTILE <= RING_BYTES, "attention LDS map");
struct Chunk { int b, h, rs, c, ci, p; };
__device__ __forceinline__ Chunk chunk_decode(int bh  , int e  ) {
    Chunk k; k.b = bh >> 3; k.h = bh & 7;
    if (e < 16) { k.p = 0; k.rs = 0; k.c = 0; k.ci = e; }
    else if (e < 32) { k.p = 1; k.rs = 2; k.c = (e - 16) >> 2; k.ci = (e - 16) & 3; }
    else { k.p = 2; k.rs = 4; k.c = e - 32; k.ci = 0; }
    return k;
}
struct ChunkRegs { bf16x8 k[2], v[2]; };
__device__ __forceinline__ void chunk_load(ChunkRegs& R, const Chunk& k, int j0  , const bf16* Kb, const bf16* Vb, int tid) {
    const int j = j0 + (tid >> 2); const size_t off = (size_t)(k.b * SEQ + (j << k.rs) + k.c) * AW + k.h * 64 + 16 * (tid & 3);
#pragma unroll
    for (int i = 0; i < 2; ++i) { R.k[i] = *(const bf16x8*)(Kb + off + 8 * i); R.v[i] = *(const bf16x8*)(Vb + off + 8 * i); }
}
__device__ __forceinline__ void chunk_store(const ChunkRegs& R, LAS unsigned char* ring, int half, int tid) {
    const int rowp = half * 128 + (tid >> 2), q = tid & 3;
#pragma unroll
    for (int i = 0; i < 2; ++i) { *(LAS bf16x8*)(ring + KT_OFF + rowp * KP + q * 32 + 16 * i) = R.k[i]; *(LAS bf16x8*)(ring + VT_OFF + rowp * VP + q * 32 + 16 * i) = R.v[i]; }
}
__device__ __forceinline__ void chunk_step(AState& st, int kb, int own, int qk, float sl2r, const bf16x8 (&qf)[2], const LAS unsigned char* kp, const LAS unsigned char* vp, int g) {
    f32x4 s[2]; int rowb[2];
#pragma unroll
    for (int t = 0; t < 2; ++t) { const int kk0 = 16 * (kb + t); rowb[t] = ((((kk0 >> 7) + own + 1) & 1) << 7) + (kk0 & 127);
        const LAS unsigned char* r = kp + rowb[t] * KP;
        const bf16x8 k0 = *(const LAS bf16x8*)r, k1 = *(const LAS bf16x8*)(r + 64);
        s[t] = __builtin_amdgcn_mfma_f32_16x16x32_bf16(k0, qf[0], (f32x4){0.f, 0.f, 0.f, 0.f}, 0, 0, 0);
        s[t] = __builtin_amdgcn_mfma_f32_16x16x32_bf16(k1, qf[1], s[t], 0, 0, 0); }
    float mx = -INFINITY;
#pragma unroll
    for (int t = 0; t < 2; ++t)
#pragma unroll
        for (int i = 0; i < 4; ++i) { const int d = qk - (16 * (kb + t) + 4 * g + i); const float x = ((unsigned)d <= 128u) ? s[t][i] - sl2r * (float)d : -INFINITY; s[t][i] = x; mx = fmaxf(mx, x); }
    mx = max4g(mx);
    const float mn = fmaxf(st.m, mx), alpha = __builtin_amdgcn_exp2f(st.m - mn); st.m = mn;
    float ps = 0.f;
#pragma unroll
    for (int t = 0; t < 2; ++t)
#pragma unroll
        for (int i = 0; i < 4; ++i) { const float pe = __builtin_amdgcn_exp2f(s[t][i] - mn); s[t][i] = pe; ps += pe; }
    st.l = st.l * alpha + ps;
#pragma unroll
    for (int c = 0; c < 4; ++c) st.o[c] = st.o[c] * alpha;
    const bf16x8 pf = cvt8(s[0], s[1]);
#pragma unroll
    for (int c = 0; c < 4; ++c) {
        const v4i16_t a = __builtin_amdgcn_ds_read_tr16_b64_v4i16((LAS v4i16_t*)(vp + rowb[0] * VP + 32 * c));
        const v4i16_t bq = __builtin_amdgcn_ds_read_tr16_b64_v4i16((LAS v4i16_t*)(vp + rowb[1] * VP + 32 * c));
        const bf16x8 vf = (bf16x8){a[0], a[1], a[2], a[3], bq[0], bq[1], bq[2], bq[3]};
        st.o[c] = __builtin_amdgcn_mfma_f32_16x16x32_bf16(vf, pf, st.o[c], 0, 0, 0);
    }
}
__device__ __forceinline__ void chunk_compute(Frame& F, const Chunk& k, int own, const bf16x8 (&qf)[2], LAS unsigned char* ring) {
    const int lane = F.lane, c15 = lane & 15, g = lane >> 4, w = F.wave;
    AState sx, sy; attn_init(sx); attn_init(sy);
    const float sl2r = __builtin_amdgcn_exp2f(-(float)(k.h + 1)) * 1.4426950408889634f * (float)(1 << k.rs);
    const int blk_lo = (k.ci == 0) ? 8 : w, blk_hi = w + 8;
    const int qk = 16 * w + c15 + 128;
    const LAS unsigned char* kp = ring + KT_OFF + c15 * KP + 16 * g;
    const LAS unsigned char* vp = ring + VT_OFF + (4 * g + (c15 >> 2)) * VP + (lane & 3) * 8;
    int kb = blk_lo;
    for (; kb + 2 <= blk_hi; kb += 4) { chunk_step(sx, kb, own, qk, sl2r, qf, kp, vp, g); chunk_step(sy, kb + 2, own, qk, sl2r, qf, kp, vp, g); }
    if (kb <= blk_hi) chunk_step(sx, kb, own, qk, sl2r, qf, kp, vp, g);
    AState st; st.m = fmaxf(sx.m, sy.m); const float ax = __builtin_amdgcn_exp2f(sx.m - st.m), ay = __builtin_amdgcn_exp2f(sy.m - st.m);
    st.l = sx.l * ax + sy.l * ay;
#pragma unroll
    for (int c = 0; c < 4; ++c) st.o[c] = sx.o[c] * ax + sy.o[c] * ay;
    const float l = sum4g(st.l);
    const float il = 1.0f / l;
    const size_t row = (size_t)(k.b * SEQ + (((128 * k.ci + 16 * w + c15) << k.rs) + k.c));
    bf16* orow = (bf16*)(F.ws + WS_OP) + ((size_t)k.p * MP + row) * AW + k.h * 64;
#pragma unroll
    for (int c = 0; c < 4; ++c) { u32x2_t wv; wv.x = cvtpk(st.o[c][0] * il, st.o[c][1] * il); wv.y = cvtpk(st.o[c][2] * il, st.o[c][3] * il); *(u32x2_t*)(orow + 16 * c + 4 * g) = wv; }
    if (g == 0) ((float*)(F.ws + WS_LSE))[((size_t)k.p * MP + row) * NH + k.h] = st.m + __builtin_amdgcn_logf(l);
}
struct SDesc { int rs, cr, kb, qsub, dmin, mt; float sl2r; };
__device__ __forceinline__ SDesc sample_desc(int s, int qp, int c15, float slope2) {
    SDesc d; const int NEGQ = -(1 << 20);
    if (s < 5) { d.rs = 0; d.cr = 0; d.kb = 120 + 2 * s; d.qsub = c15 < 2 ? 2048 + 2 * qp + c15 : NEGQ; d.sl2r = slope2; d.dmin = 0; d.mt = 2; }
    else if (s < 11) { const int q = (s - 5) / 3, st = (s - 5) - 3 * q; d.rs = 2; d.cr = 2 * qp + q; d.kb = 24 + 2 * st; d.qsub = c15 == q ? 512 : NEGQ; d.sl2r = slope2 * 4.0f; d.dmin = 33; d.mt = 1; }
    else { const int q = (s - 11) / 3, st = (s - 11) - 3 * q; d.rs = 4; d.cr = 2 * qp + (q & 1); d.kb = 2 * st; d.qsub = (s < 17 && c15 == q) ? 128 : NEGQ; d.sl2r = slope2 * 16.0f; d.dmin = 33; d.mt = 0; }
    return d;
}
__device__ __forceinline__ void attn_prompt_role(Frame& F, int bh) {
    LAS unsigned char* ring = F.lds + RING_OFF;
    const bf16* Qb = (const bf16*)(F.ws + WS_Q); const bf16* Kb = (const bf16*)(F.ws + WS_Q + QKVU_STRIDE); const bf16* Vb = (const bf16*)(F.ws + WS_Q + 2 * QKVU_STRIDE);
    const int lane = F.lane, c15 = lane & 15, g = lane >> 4;
    __syncthreads();
    for (int i = F.tid; i < SV_OFF / 4; i += NWAVES * 64) ((LAS unsigned*)(ring))[i] = 0u;
    ChunkRegs R0, R1; Chunk c0 = chunk_decode(bh, 0), c1 = chunk_decode(bh, 1); chunk_load(R0, c0, 128 * c0.ci, Kb, Vb, F.tid); chunk_load(R1, c1, 128 * c1.ci, Kb, Vb, F.tid);
#define CHUNK_ITER(E, RR, CC, OWN) do { \
        bf16x8 qf[2]; \
        { const size_t qrow = (size_t)(CC.b * SEQ + (((128 * CC.ci + 16 * F.wave + c15) << CC.rs) + CC.c)); \
          const bf16* qp = Qb + qrow * AW + CC.h * 64 + 8 * g; qf[0] = *(const bf16x8*)qp; qf[1] = *(const bf16x8*)(qp + 32); } \
        __syncthreads(); \
        chunk_store(RR, ring, (OWN), F.tid); \
        __syncthreads(); \
        const Chunk now = CC; \
        if ((E) + 2 < 48) { CC = chunk_decode(bh, (E) + 2); chunk_load(RR, CC, 128 * CC.ci, Kb, Vb, F.tid); } \
        chunk_compute(F, now, (OWN), qf, ring); } while (0)
#pragma unroll 1
    for (int e = 0; e < 48; e += 2) { CHUNK_ITER(e, R0, c0, 0); CHUNK_ITER(e + 1, R1, c1, 1); }
#undef CHUNK_ITER
    asm volatile("s_waitcnt vmcnt(0)" ::: "memory"); __syncthreads();
    { const int b = bh >> 3, h = bh & 7; const bf16* OP = (const bf16*)(F.ws + WS_OP); const float* LSE = (const float*)(F.ws + WS_LSE); bf16* MIX = (bf16*)(F.ws + WS_MIX);
#pragma unroll 4
      for (int it = 0; it < SEQ / 64; ++it) { const size_t row = (size_t)b * SEQ + it * 64 + F.wave * 8 + (lane >> 3); const size_t off = row * AW + h * 64 + 8 * (lane & 7);
          const float l0 = LSE[row * NH + h], l1 = LSE[((size_t)MP + row) * NH + h], l2 = LSE[((size_t)2 * MP + row) * NH + h];
          const bf16x8 pa = *(const bf16x8*)(OP + off), pb = *(const bf16x8*)(OP + (size_t)MP * AW + off), pc = *(const bf16x8*)(OP + (size_t)2 * MP * AW + off);
          const float mx = fmaxf(l0, fmaxf(l1, l2)); float w0 = __builtin_amdgcn_exp2f(l0 - mx), w1 = __builtin_amdgcn_exp2f(l1 - mx), w2 = __builtin_amdgcn_exp2f(l2 - mx);
          const float inv = 1.0f / (w0 + w1 + w2); w0 *= inv; w1 *= inv; w2 *= inv;
          float o[8];
#pragma unroll
          for (int e = 0; e < 8; ++e) o[e] = w0 * bf2f((unsigned short)pa[e]) + w1 * bf2f((unsigned short)pb[e]) + w2 * bf2f((unsigned short)pc[e]);
          u32x4_t wv; wv.x = cvtpk(o[0], o[1]); wv.y = cvtpk(o[2], o[3]); wv.z = cvtpk(o[4], o[5]); wv.w = cvtpk(o[6], o[7]);
          *(u32x4_t*)(MIX + row * DM + h * 64 + 8 * (lane & 7)) = wv; } }
}
__device__ __forceinline__ void attn_sample_role(Frame& F, int bS) {
    const bf16* Qb = (const bf16*)(F.ws + WS_Q);
    const float* Kc = F.in[2]; const float* Vc = F.in[3]; const float* Kn = F.out + O_KS; const float* Vn = F.out + O_VS;
    const int lane = F.lane, c15 = lane & 15, g = lane >> 4, hS = F.wave;
    LAS unsigned char* vl = F.lds + RING_OFF + SV_OFF + F.wave * VTILE;
    const float slope2S = __builtin_amdgcn_exp2f(-(float)(hS + 1)) * 1.4426950408889634f;
#pragma unroll 1
    for (int qpS = 0; qpS < 2; ++qpS) {
        bf16x8 qs[2];
        { const bf16* qptr = Qb + ((size_t)(MP + bS * DS + 2 * qpS + (c15 & 1)) * AW + hS * 64 + 8 * g); qs[0] = *(const bf16x8*)qptr; qs[1] = *(const bf16x8*)(qptr + 32); }
        AState sst; attn_init(sst);
        KVRaw<true> cur, nxt;
        { const SDesc sd = sample_desc(0, qpS, c15, slope2S); kv_load<true>(cur, Kc, Kn, Vc, Vn, sd.kb, sd.rs, sd.cr, bS, hS, lane); }
#pragma unroll 1
        for (int s = 0; s < 17; ++s) {
            const SDesc sd = sample_desc(s, qpS, c15, slope2S), sn = sample_desc(s + 1, qpS, c15, slope2S);
            kv_load<true>(nxt, Kc, Kn, Vc, Vn, sn.kb, sn.rs, sn.cr, bS, hS, lane);
            attn_step<true>(sst, cur, qs, sd.kb, sd.qsub, sd.sl2r, sd.dmin, sd.mt, vl, lane);
            cur = nxt;
        }
        attn_store(sst, c15 < 2 ? (bf16*)(F.ws + WS_MIX) + ((size_t)(MP + bS * DS + 2 * qpS + c15) * DM + hS * 64) : nullptr, lane);
    }
}
template <int K> __device__ __forceinline__ float dpp_ror(float v) { return __builtin_bit_cast(float, __builtin_amdgcn_update_dpp(0, __builtin_bit_cast(int, v), 0x120 + K, 0xf, 0xf, false)); }
template <int K> __device__ __forceinline__ void win_step(float (&S)[8], float (&P)[8], int c15) {
#pragma unroll
    for (int e = 0; e < 8; ++e) { const float y = c15 >= 16 - K ? P[e] : S[e]; const float s2 = S[e] + dpp_ror<K>(y); const float p2 = P[e] + dpp_ror<K>(P[e]); S[e] = s2; P[e] = p2; }
}
__device__ __forceinline__ void pool_mma_store(const bf16* WP, const float* PS, bf16* MIX, f32x4 (&acc)[8], const bf16x8 (&df)[4], int gi, int row, int c15, int g) {
#pragma unroll
    for (int ks = 0; ks < 4; ++ks)
#pragma unroll
        for (int nt = 0; nt < 8; ++nt) { const bf16x8 wf = *(const bf16x8*)(WP + ((size_t)(gi * 128 + 16 * nt + c15) * 128 + 32 * ks + 8 * g));
            acc[nt] = __builtin_amdgcn_mfma_f32_16x16x32_bf16(wf, df[ks], acc[nt], 0, 0, 0); }
#pragma unroll
    for (int nt = 0; nt < 8; ++nt) { const int col = 128 * gi + 16 * nt + 4 * g; const f32x4 sc = *(const f32x4*)(PS + col); const f32x4 o = acc[nt] * sc;
        u32x2_t wv; wv.x = cvtpk(o[0], o[1]); wv.y = cvtpk(o[2], o[3]); *(u32x2_t*)(MIX + (size_t)row * DM + 512 + col) = wv; }
}
template <int NTL> __device__ __forceinline__ void pool_group_prompt(Frame& F, int T0, int TS, const int GI) {
    const int lane = F.lane, c15 = lane & 15, g = lane >> 4;
    const bf16* U = (const bf16*)(F.ws + WS_Q + 3 * QKVU_STRIDE); const bf16* WP = (const bf16*)(F.ws + WS_WPOOL); const float* PS = F.in[11]; bf16* MIX = (bf16*)(F.ws + WS_MIX);
    const int w = 2 << GI;
    bf16x8 xc[NTL][4], xp[NTL][4];
#pragma unroll
    for (int tl = 0; tl < NTL; ++tl) { const int T = T0 + tl * TS, row = T * 16 + c15; const bool has_prev = ((T * 16) & (SEQ - 1)) != 0;
#pragma unroll
        for (int ks = 0; ks < 4; ++ks) { const int ch = 128 * GI + 32 * ks + 8 * g; xc[tl][ks] = *(const bf16x8*)(U + (size_t)row * AW + ch);
            xp[tl][ks] = (bf16x8){0, 0, 0, 0, 0, 0, 0, 0}; if (has_prev) xp[tl][ks] = *(const bf16x8*)(U + (size_t)(row - 16) * AW + ch); } }
    bf16x8 df[NTL][4];
#pragma unroll
    for (int tl = 0; tl < NTL; ++tl) { const int t = ((T0 + tl * TS) * 16 + c15) & (SEQ - 1); const float ic = 1.0f / (float)(w < t + 1 ? w : t + 1);
#pragma unroll
        for (int ks = 0; ks < 4; ++ks) {
            float S[8], P[8], cur[8];
#pragma unroll
            for (int e = 0; e < 8; ++e) { cur[e] = bf2f((unsigned short)xc[tl][ks][e]); S[e] = cur[e]; P[e] = bf2f((unsigned short)xp[tl][ks][e]); }
            win_step<1>(S, P, c15);
            if (GI >= 1) win_step<2>(S, P, c15);
            if (GI >= 2) win_step<4>(S, P, c15);
            if (GI >= 3) win_step<8>(S, P, c15);
            f32x4 d0, d1;
#pragma unroll
            for (int e = 0; e < 4; ++e) { d0[e] = S[e] * ic - cur[e]; d1[e] = S[4 + e] * ic - cur[4 + e]; }
            df[tl][ks] = cvt8(d0, d1);
        } }
    f32x4 acc[NTL][8];
#pragma unroll
    for (int tl = 0; tl < NTL; ++tl)
#pragma unroll
        for (int nt = 0; nt < 8; ++nt) acc[tl][nt] = (f32x4){0.f, 0.f, 0.f, 0.f};
#pragma unroll
    for (int ks = 0; ks < 4; ++ks)
#pragma unroll
        for (int nt = 0; nt < 8; ++nt) { const bf16x8 wf = *(const bf16x8*)(WP + ((size_t)(GI * 128 + 16 * nt + c15) * 128 + 32 * ks + 8 * g));
#pragma unroll
            for (int tl = 0; tl < NTL; ++tl) acc[tl][nt] = __builtin_amdgcn_mfma_f32_16x16x32_bf16(wf, df[tl][ks], acc[tl][nt], 0, 0, 0); }
#pragma unroll
    for (int nt = 0; nt < 8; ++nt) { const int col = 128 * GI + 16 * nt + 4 * g; const f32x4 sc = *(const f32x4*)(PS + col);
#pragma unroll
        for (int tl = 0; tl < NTL; ++tl) { const f32x4 o = acc[tl][nt] * sc; const int row = (T0 + tl * TS) * 16 + c15;
            u32x2_t wv; wv.x = cvtpk(o[0], o[1]); wv.y = cvtpk(o[2], o[3]); *(u32x2_t*)(MIX + (size_t)row * DM + 512 + col) = wv; } }
}
__device__ __forceinline__ void pool_sample_item(Frame& F, int T, int gi) {
    const int lane = F.lane, c15 = lane & 15, g = lane >> 4, row = T * 16 + c15, t = (row - MP) & 3, bs = (row - MP) >> 2;
    const bf16* U = (const bf16*)(F.ws + WS_Q + 3 * QKVU_STRIDE); const float* SP = F.in[4];
    const int w = 2 << gi; const float ic = 1.0f / (float)w;
    bf16x8 df[4];
#pragma unroll
    for (int ks = 0; ks < 4; ++ks) df[ks] = (bf16x8){0, 0, 0, 0, 0, 0, 0, 0};
#pragma unroll 1
    for (int ks = 0; ks < 4; ++ks) {
        const int ch = 128 * gi + 32 * ks + 8 * g;
        float S[8], cur[8];
#pragma unroll
        for (int e = 0; e < 8; ++e) { S[e] = 0.f; cur[e] = 0.f; }
#pragma unroll 1
        for (int i0 = 0; i0 < w; i0 += 8) {
            bf16x8 xu[8]; f32x4 x0[8], x1[8];
#pragma unroll
            for (int u = 0; u < 8; ++u) { const int i = i0 + u < w ? i0 + u : w - 1; const int idx = t - i, iu = idx < 0 ? 0 : idx, is = idx >= 0 ? 14 : 15 + idx;
                xu[u] = *(const bf16x8*)(U + (size_t)(row - t + iu) * AW + ch);
                const float* sp = SP + ((size_t)bs * 15 + is) * 512 + ch; x0[u] = *(const f32x4*)sp; x1[u] = *(const f32x4*)(sp + 4); }
            __builtin_amdgcn_sched_barrier(0);
#pragma unroll
            for (int u = 0; u < 8; ++u) { const int i = i0 + u, idx = t - i; const bool use = i < w;
#pragma unroll
                for (int e = 0; e < 8; ++e) { const float vs = e < 4 ? x0[u][e & 3] : x1[u][e & 3]; float v = idx >= 0 ? bf2f((unsigned short)xu[u][e]) : vs; v = use ? v : 0.f; S[e] += v; if (i == 0) cur[e] = v; } }
        }
        f32x4 d0, d1;
#pragma unroll
        for (int e = 0; e < 4; ++e) { d0[e] = S[e] * ic - cur[e]; d1[e] = S[4 + e] * ic - cur[4 + e]; }
        const bf16x8 dd = cvt8(d0, d1); if (ks == 0) df[0] = dd; else if (ks == 1) df[1] = dd; else if (ks == 2) df[2] = dd; else df[3] = dd;
    }
    f32x4 acc[8];
#pragma unroll
    for (int nt = 0; nt < 8; ++nt) acc[nt] = (f32x4){0.f, 0.f, 0.f, 0.f};
    pool_mma_store((const bf16*)(F.ws + WS_WPOOL), F.in[11], (bf16*)(F.ws + WS_MIX), acc, df, gi, row, c15, g);
}
template <int NTL> __device__ __forceinline__ void pool_tiles(Frame& F, int T0, int TS) {
#pragma unroll 1
    for (int gi = 0; gi < 4; ++gi) pool_group_prompt<NTL>(F, T0, TS, gi);
}
__device__ __forceinline__ void p2_attn(Frame& F) {
    const int role = F.vcu & 1, idx = F.vcu >> 1, nidx = F.G >> 1;
    if (role == 0) { for (int bh = idx; bh < NB * NH; bh += nidx) attn_prompt_role(F, bh); }
    else {
        for (int b = idx; b < DB; b += nidx) attn_sample_role(F, b);
        const int gw = idx * NWAVES + F.wave, NGW = nidx * NWAVES;
        if (2 * NGW == MP / 16) pool_tiles<2>(F, gw, NGW); else for (int T = gw; T < MP / 16; T += NGW) pool_tiles<1>(F, T, 0);
        for (int it = gw; it < 128 * 8; it += NGW) if ((it & 7) == 0) pool_sample_item(F, MP / 16 + (it >> 5), (it >> 3) & 3);
    }
}
template <int NTW, int KS, int UNR, class BR> __device__ __forceinline__ void mini_mma(const bf16* A, int K, const bf16* Bt, const BR& br, int arow, LAS float* tile, int pitch, int wave, int lane) {
    const int c15 = lane & 15, g = lane >> 4, ks = wave % KS, cg = wave / KS;
    const int kbeg = ks * (K / KS), ksteps = K / KS / 32, joff = cg * 16 * NTW;
    const bf16* ap = A + (size_t)(arow + c15) * K + kbeg + 8 * g;
    const bf16* bp[NTW];
#pragma unroll
    for (int nt = 0; nt < NTW; ++nt) bp[nt] = Bt + (size_t)br(joff + nt * 16 + c15) * K + kbeg + 8 * g;
    f32x4 acc[4][NTW];
#pragma unroll
    for (int rb = 0; rb < 4; ++rb)
#pragma unroll
        for (int nt = 0; nt < NTW; ++nt) acc[rb][nt] = (f32x4){0.f, 0.f, 0.f, 0.f};
    for (int s0 = 0; s0 < ksteps; s0 += UNR) {
        bf16x8 a[UNR][4], b[UNR][NTW];
#pragma unroll
        for (int u = 0; u < UNR; ++u) { const int s = s0 + u < ksteps ? s0 + u : ksteps - 1;
#pragma unroll
            for (int rb = 0; rb < 4; ++rb) a[u][rb] = *(const bf16x8*)(ap + (size_t)(16 * rb) * K + 32 * s);
#pragma unroll
            for (int nt = 0; nt < NTW; ++nt) b[u][nt] = *(const bf16x8*)(bp[nt] + 32 * s); }
        __builtin_amdgcn_sched_barrier(0);
#pragma unroll
        for (int u = 0; u < UNR; ++u) if (s0 + u < ksteps) {
#pragma unroll
            for (int rb = 0; rb < 4; ++rb)
#pragma unroll
                for (int nt = 0; nt < NTW; ++nt) acc[rb][nt] = __builtin_amdgcn_mfma_f32_16x16x32_bf16(b[u][nt], a[u][rb], acc[rb][nt], 0, 0, 0); }
        __builtin_amdgcn_sched_barrier(0);
    }
#pragma unroll
    for (int rb = 0; rb < 4; ++rb)
#pragma unroll
        for (int nt = 0; nt < NTW; ++nt) *(LAS f32x4*)(tile + (ks * 64 + 16 * rb + c15) * pitch + joff + 16 * nt + 4 * g) = acc[rb][nt];
}
struct BrLin { int c0; __device__ __forceinline__ int operator()(int j) const { return c0 + j; } };
struct BrHead { int base; __device__ __forceinline__ int operator()(int j) const { return base + 128 * (j >> 5) + (j & 31); } };
struct BrUp { int ch0; __device__ __forceinline__ int operator()(int j) const { const int half = j >= 96 ? 1 : 0; int ch = ch0 + j - 96 * half; ch = ch > FF - 1 ? FF - 1 : ch; return 256 * (ch >> 7) + 128 * half + (ch & 127); } };
__device__ __forceinline__ void mini_inproj(Frame& F, int tl) {
    LAS float* tile = (LAS float*)(F.lds + RING_OFF); constexpr int PT = 68;
    const int rg = tl >> 5, hd = tl & 31, type = hd >> 3, h = hd & 7;
    BrHead br{256 * (type * 2 + (h >> 2)) + 32 * (h & 3)};
    mini_mma<2, 4, 4>((const bf16*)(F.ws + WS_XN), DM, (const bf16*)(F.ws + WS_WIN), br, MP + 64 * rg, tile, PT, F.wave, F.lane);
    __syncthreads();
    const int r = F.tid >> 3, d0 = 8 * (F.tid & 7), row = 64 * rg + r;
    float v[8];
#pragma unroll
    for (int e = 0; e < 8; ++e) v[e] = (tile[r * PT + d0 + e] + tile[(64 + r) * PT + d0 + e]) + (tile[(128 + r) * PT + d0 + e] + tile[(192 + r) * PT + d0 + e]);
    if (type < 2) { float ss = 0.f;
#pragma unroll
        for (int e = 0; e < 8; ++e) ss += v[e] * v[e];
        ss += __shfl_xor(ss, 1); ss += __shfl_xor(ss, 2); ss += __shfl_xor(ss, 4);
        const float rr = 1.0f / sqrtf(ss * (1.0f / 64.0f) + EPS) * (type == 0 ? QSCALE : 1.0f); const float* gs = (type == 0 ? F.in[8] : F.in[9]) + h * 64 + d0;
#pragma unroll
        for (int e = 0; e < 8; ++e) v[e] = v[e] * rr * gs[e]; }
    u32x4_t wv; wv.x = cvtpk(v[0], v[1]); wv.y = cvtpk(v[2], v[3]); wv.z = cvtpk(v[4], v[5]); wv.w = cvtpk(v[6], v[7]);
    *(u32x4_t*)((bf16*)(F.ws + WS_Q + (size_t)type * QKVU_STRIDE) + (size_t)(MP + row) * AW + h * 64 + d0) = wv;
    float* o = nullptr;
    if (type == 1) o = F.out + O_KS + (size_t)row * AW + h * 64 + d0; else if (type == 2) o = F.out + O_VS + (size_t)row * AW + h * 64 + d0;
    else if (type == 3) o = F.out + O_PS + ((size_t)(row >> 2) * 15 + 11 + (row & 3)) * 512 + h * 64 + d0;
    if (o) { *(f32x4*)o = (f32x4){v[0], v[1], v[2], v[3]}; *(f32x4*)(o + 4) = (f32x4){v[4], v[5], v[6], v[7]}; }
    __syncthreads();
}
__device__ __forceinline__ void mini_outproj(Frame& F, int tl) {
    LAS float* tile = (LAS float*)(F.lds + RING_OFF); constexpr int PT = 36;
    const int rg = tl >> 5, cg = tl & 31;
    BrLin br{32 * cg};
    mini_mma<2, 8, 4>((const bf16*)(F.ws + WS_MIX), DM, (const bf16*)(F.ws + WS_WOUT), br, MP + 64 * rg, tile, PT, F.wave, F.lane);
    __syncthreads();
    const int r = F.tid >> 3, c0 = 4 * (F.tid & 7), row = 64 * rg + r, col = 32 * cg + c0;
    f32x4 a = (f32x4){0.f, 0.f, 0.f, 0.f}, b = (f32x4){0.f, 0.f, 0.f, 0.f};
#pragma unroll
    for (int k2 = 0; k2 < 8; k2 += 2) { a = a + *(const LAS f32x4*)(tile + (k2 * 64 + r) * PT + c0); b = b + *(const LAS f32x4*)(tile + ((k2 + 1) * 64 + r) * PT + c0); }
    const f32x4 hv = *(const f32x4*)(F.in[1] + (size_t)row * DM + col) + a + b;
    u32x2_t wv; wv.x = cvtpk(hv[0], hv[1]); wv.y = cvtpk(hv[2], hv[3]); *(u32x2_t*)((bf16*)(F.ws + WS_HB) + (size_t)(MP + row) * DM + col) = wv;
    float ss = (hv[0] * hv[0] + hv[1] * hv[1]) + (hv[2] * hv[2] + hv[3] * hv[3]);
    ss += __shfl_xor(ss, 1); ss += __shfl_xor(ss, 2); ss += __shfl_xor(ss, 4);
    if ((F.tid & 7) == 0) ((float*)(F.ws + WS_SSPS))[row * 32 + cg] = ss;
    __syncthreads();
}
__device__ __forceinline__ void mini_up(Frame& F, int tl) {
    LAS float* tile = (LAS float*)(F.lds + RING_OFF); constexpr int PT = 196;
    const int rg = tl >> 5, cg = tl & 31, ch0 = 88 * cg;
    BrUp br{ch0};
    mini_mma<3, 2, 4>((const bf16*)(F.ws + WS_HB), DM, (const bf16*)(F.ws + WS_WUP), br, MP + 64 * rg, tile, PT, F.wave, F.lane);
    __syncthreads();
    { const int r = F.tid >> 3, row = 64 * rg + r; const float* sp = (const float*)(F.ws + WS_SSPS) + row * 32 + 4 * (F.tid & 7);
      const f32x4 t = *(const f32x4*)sp; float ss = (t[0] + t[1]) + (t[2] + t[3]); ss += __shfl_xor(ss, 1); ss += __shfl_xor(ss, 2); ss += __shfl_xor(ss, 4);
      const float rr = 1.0f / sqrtf(ss * (1.0f / DM) + EPS);
      for (int c = (F.tid & 7); c < 192; c += 8) tile[r * PT + c] = (tile[r * PT + c] + tile[(64 + r) * PT + c]) * rr; }
    __syncthreads();
    { const int r = F.tid >> 3, row = 64 * rg + r, n = row & 3, b = row >> 2; const float* cw = F.in[15]; const float* cbp = F.in[16]; const float* hist = F.in[5] + (size_t)b * 2 * FF2;
#pragma unroll
      for (int k = 0; k < 11; ++k) { const int cl = 11 * (F.tid & 7) + k, ch = ch0 + cl; float cv[2];
#pragma unroll
          for (int hf = 0; hf < 2; ++hf) { const int col = hf * FF + ch, lc = hf * 96 + cl;
              const float cur = tile[r * PT + lc];
              const float p1 = n >= 1 ? tile[(r - 1) * PT + lc] : hist[FF2 + col];
              const float p2 = n >= 2 ? tile[(r - 2) * PT + lc] : (n == 1 ? hist[FF2 + col] : hist[col]);
              cv[hf] = cbp[col] + cw[col] * p2 + cw[FF2 + col] * p1 + cw[2 * FF2 + col] * cur;
              if (n >= 2) F.out[O_FS + ((size_t)b * 2 + n - 2) * FF2 + col] = cur; }
          ((bf16*)(F.ws + WS_ACT))[(size_t)(MP + row) * FF + ch] = (bf16)f2bf(pg8::silu_mul(cv[0], cv[1])); } }
    __syncthreads();
}
__device__ __forceinline__ void mini_down(Frame& F, int tl) {
    LAS float* tile = (LAS float*)(F.lds + RING_OFF); constexpr int PT = 36;
    const int rg = tl >> 5, cg = tl & 31;
    BrLin br{32 * cg};
    mini_mma<2, 8, 4>((const bf16*)(F.ws + WS_ACT), FF, (const bf16*)(F.ws + WS_WDN), br, MP + 64 * rg, tile, PT, F.wave, F.lane);
    __syncthreads();
    const int r = F.tid >> 3, c0 = 4 * (F.tid & 7), row = 64 * rg + r, col = 32 * cg + c0;
    f32x4 a = (f32x4){0.f, 0.f, 0.f, 0.f}, b = (f32x4){0.f, 0.f, 0.f, 0.f};
#pragma unroll
    for (int k2 = 0; k2 < 8; k2 += 2) { a = a + *(const LAS f32x4*)(tile + (k2 * 64 + r) * PT + c0); b = b + *(const LAS f32x4*)(tile + ((k2 + 1) * 64 + r) * PT + c0); }
    const u32x2_t hb = *(const u32x2_t*)((const bf16*)(F.ws + WS_HB) + (size_t)(MP + row) * DM + col);
    const f32x4 hv = (f32x4){__builtin_bit_cast(float, hb.x << 16), __builtin_bit_cast(float, hb.x & 0xffff0000u), __builtin_bit_cast(float, hb.y << 16), __builtin_bit_cast(float, hb.y & 0xffff0000u)};
    *(f32x4*)(F.out + O_Y + (size_t)(MP + row) * DM + col) = hv + a + b;
    __syncthreads();
}
__device__ __forceinline__ void p6_fix_rows(Frame& F) {
    const float* halo = (const float*)(F.ws + WS_HALO); const float* cw = F.in[15]; const float* cbp = F.in[16]; bf16* ACT = (bf16*)(F.ws + WS_ACT);
    for (int it = blockIdx.x; it < NPANEL_P * 2; it += F.G) {
        const int pm = it >> 1, e = it & 1; const bool first = (pm & 7) == 0;
#pragma unroll
        for (int it2 = 0; it2 < 6; ++it2) { const int ch = F.tid + it2 * NWAVES * 64; if (ch < FF) {
            float cv[2];
#pragma unroll
            for (int bj = 0; bj < 2; ++bj) { const int col = bj * FF + ch;
                const float um2 = first ? 0.f : halo[(size_t)((pm - 1) * 4 + 2) * FF2 + col], um1 = first ? 0.f : halo[(size_t)((pm - 1) * 4 + 3) * FF2 + col];
                const float u0 = halo[(size_t)(pm * 4 + 0) * FF2 + col], u1 = halo[(size_t)(pm * 4 + 1) * FF2 + col];
                const float w0 = cw[col], w1 = cw[FF2 + col], w2 = cw[2 * FF2 + col], cb = cbp[col];
                cv[bj] = e == 0 ? cb + w0 * um2 + w1 * um1 + w2 * u0 : cb + w0 * um1 + w1 * u0 + w2 * u1; }
            ACT[(size_t)(pm * 256 + e) * FF + ch] = (bf16)f2bf(pg8::silu_mul(cv[0], cv[1]));
        } }
    }
}


struct Args { const float* in[18]; float* out; unsigned char* ws; int ph_lo, ph_hi, li, pad; };
__global__ void __launch_bounds__(NWAVES * 64, 2) mk_fwd(Args args) {
    extern __shared__ __attribute__((aligned(16))) unsigned char lds[];
    Frame F;
    F.lds = (LAS unsigned char*)lds;
    F.MISC = (volatile LAS unsigned*)(F.lds + MISC_OFF);
    F.tid = threadIdx.x; F.lane = F.tid & 63; F.wave = __builtin_amdgcn_readfirstlane(F.tid >> 6);
    F.G = gridDim.x; { const int bx = blockIdx.x; F.vcu = (F.G % 8 == 0) ? (bx % 8) * (F.G / 8) + bx / 8 : bx; }
    unsigned char* ws = args.ws; F.ws = ws; F.out = args.out;
    F.ctl = (gu32*)(ws + WS_CTL);
#pragma unroll
    for (int i = 0; i < 18; ++i) F.in[i] = args.in[i];
    for (int u = F.tid; u < (LDS_BYTES - LDSCTL_OFF) / 4; u += NWAVES * 64) ((LAS unsigned*)(F.lds + LDSCTL_OFF))[u] = 0u;
    __syncthreads();
    XcdBarrier bar; bar.bar = (unsigned*)(F.ctl + CW_BAR); bar.x = 0; bar.st = nullptr;
    if (N_LAUNCHES != PER_PHASE) bar = xcd_barrier_post((unsigned*)(F.ctl + CW_BAR), F.MISC + 8);
#define GRID_BAR(seam) do { if (N_LAUNCHES == PER_PHASE) { if (F.tid == 0) __hip_atomic_store(F.ctl + CW_TMO, 0xBADBA0u | (unsigned)(seam), RLX_AGENT); } else { xcd_barrier(bar); } } while (0)
    const int lo = args.ph_lo, hi = args.ph_hi;
#ifndef PH_MASK
#define PH_MASK 127
#endif
#define IN(k) ((((PH_MASK) >> (k)) & 1) && lo <= (k) && (k) < hi)
#define BOTH(k) (IN(k) && IN((k) + 1))
    bf16* const XN = (bf16*)(ws + WS_XN); bf16* const QB = (bf16*)(ws + WS_Q); bf16* const MIX = (bf16*)(ws + WS_MIX); bf16* const HB = (bf16*)(ws + WS_HB); bf16* const ACT = (bf16*)(ws + WS_ACT);

    if (IN(0)) { p0_prologue(F); if (BOTH(0)) GRID_BAR(0); }

    if (IN(1)) {
        pg8::Gemm g{XN, (const bf16*)(ws + WS_WIN), MP, PJ, DM}; pg8::StaticOrder S; S.init(MP, PJ, F.G, (int)blockIdx.x);
        pg8::EpiInProj E{QB, QKVU_STRIDE / 2, F.out, F.in[8], F.in[9]};
        pg8::gemm_phase<pg8::EpiInProj, pg8::StaticOrder, true, true>(F.lds + RING_OFF, g, S, E);
        for (int tl = blockIdx.x; tl < 256; tl += F.G) mini_inproj(F, tl);
        if (BOTH(1)) GRID_BAR(1);
    }

    if (IN(2)) { p2_attn(F); if (BOTH(2)) GRID_BAR(2); }

    if (IN(3)) {
        pg8::Gemm g{MIX, (const bf16*)(ws + WS_WOUT), MP, DM, DM}; pg8::StaticOrder S; S.init(MP, DM, F.G, (int)blockIdx.x);
        pg8::EpiOutProj E{F.in[0], HB, (float*)(ws + WS_SSP), (PG8_LAS float*)(F.lds + TAB_OFF)};
        pg8::gemm_phase<pg8::EpiOutProj, pg8::StaticOrder, true, true>(F.lds + RING_OFF, g, S, E);
        for (int tl = blockIdx.x; tl < 256; tl += F.G) mini_outproj(F, tl);
        if (BOTH(3)) GRID_BAR(3);
    }

    if (IN(4)) {
        pg8::Gemm g{HB, (const bf16*)(ws + WS_WUP), MP, FF2, DM}; pg8::StaticOrder S; S.init(MP, FF2, F.G, (int)blockIdx.x);
        pg8::EpiUp E{ACT, (const float*)(ws + WS_SSP), (float*)(ws + WS_HALO), F.out, F.in[15], F.in[16], (PG8_LAS float*)(F.lds + TAB_OFF), F.lds + EPF_OFF};
        pg8::gemm_phase<pg8::EpiUp, pg8::StaticOrder, true, true>(F.lds + RING_OFF, g, S, E);
        for (int tl = blockIdx.x; tl < 256; tl += F.G) mini_up(F, tl);
        if (BOTH(4)) GRID_BAR(4);
    }

    if (IN(5)) { p6_fix_rows(F); if (BOTH(5)) GRID_BAR(5); }

    if (IN(6)) {
        pg8::Gemm g{ACT, (const bf16*)(ws + WS_WDN), MP, DM, FF}; pg8::StaticOrder S; S.init(MP, DM, F.G, (int)blockIdx.x);
        pg8::EpiDown E{F.out + O_Y, HB};
        pg8::gemm_phase<pg8::EpiDown, pg8::StaticOrder, true, true>(F.lds + RING_OFF, g, S, E);
        for (int tl = blockIdx.x; tl < 256; tl += F.G) mini_down(F, tl);
    }
#undef IN
#undef BOTH
}

extern "C" void kernel_launch(void* const* d_in, const int* in_sizes, int n_in, void* d_out, int out_size, void* d_ws, size_t ws_size, hipStream_t stream) {
    static int grid = 0;
    if (grid == 0) {
        if (n_in != 18 || in_sizes[0] != MP * DM || out_size != (int)O_END || ws_size < WS_END) { fprintf(stderr, "kernel_launch: unexpected shapes: n_in %d, in0 %d, out %d, ws %zu (need %zu); nothing launched\n", n_in, n_in > 0 ? in_sizes[0] : -1, out_size, ws_size, (size_t)WS_END); grid = -1; return; }
        int dev = 0, cus = 0, per_cu = 0;
        if (hipGetDevice(&dev) != hipSuccess || hipDeviceGetAttribute(&cus, hipDeviceAttributeMultiprocessorCount, dev) != hipSuccess) { fprintf(stderr, "kernel_launch: hipGetDevice / hipDeviceGetAttribute failed\n"); grid = -1; return; }
        if (hipFuncSetAttribute((const void*)mk_fwd, hipFuncAttributeMaxDynamicSharedMemorySize, LDS_BYTES) != hipSuccess) { fprintf(stderr, "kernel_launch: hipFuncSetAttribute failed\n"); grid = -1; return; }
        if (hipOccupancyMaxActiveBlocksPerMultiprocessor(&per_cu, (const void*)mk_fwd, NWAVES * 64, LDS_BYTES) != hipSuccess || per_cu < 1)
            fprintf(stderr, "kernel_launch: note: occupancy query reports %d workgroups per CU\n", per_cu);
        (void)hipGetLastError();
        grid = cus;
    }
    if (grid < 0) return;
    if (hipMemsetAsync((char*)d_ws + WS_CTL, 0, CTL_ZERO_BYTES, stream) != hipSuccess) { fprintf(stderr, "kernel_launch: hipMemsetAsync failed\n"); return; }
    Args a{};
    for (int i = 0; i < 18; ++i) a.in[i] = (const float*)d_in[i];
    a.out = (float*)d_out; a.ws = (unsigned char*)d_ws;
    static_assert(N_LAUNCHES == 1 || N_LAUNCHES == PER_PHASE, "-DMK_N_LAUNCHES must be 1 or 7");
    for (int li = 0; li < N_LAUNCHES; ++li) {
        a.ph_lo = (N_LAUNCHES == PER_PHASE) ? li : 0; a.ph_hi = (N_LAUNCHES == PER_PHASE) ? li + 1 : PER_PHASE; a.li = li;
        hipLaunchKernelGGL(mk_fwd, dim3(grid), dim3(NWAVES * 64), LDS_BYTES, stream, a);
        const hipError_t le = hipPeekAtLastError();
        if (le != hipSuccess) { fprintf(stderr, "kernel_launch: launch %d failed: %s\n", li, hipGetErrorName(le)); break; }
    }
}
```

```cpp
#include <hip/hip_runtime.h>
#include <hip/hip_bf16.h>
#include <cstdio>
#include <cstdint>
#ifndef MK_N_LAUNCHES
#define MK_N_LAUNCHES 1
#endif
constexpr int DM = 1024, NB = 16, SEQ = 2048, DB = 128, DS = 4;
constexpr int NH = 8, AW = 512, PJ = 2048, FF = 2816, FF2 = 5632;
constexpr int MP = NB * SEQ, MS = DB * DS, M = MP + MS;
constexpr int NPANEL = M / 256, NPANEL_P = MP / 256;
constexpr float EPS = 1e-6f;
constexpr float QSCALE = 0.125f * 1.4426950408889634f;
constexpr size_t O_Y = 0, O_KP = 34078720, O_VP = 50855936, O_PP = 67633152, O_FP = 67756032, O_KS = 67936256, O_VS = 68198400, O_PS = 68460544, O_FS = 69443584, O_END = 70885376;
template <class T> __device__ __forceinline__ void st16_wt(const void* p, T v) { static_assert(sizeof(T) == 16, "st16_wt"); asm volatile("global_store_dwordx4 %0, %1, off sc1\n\ts_nop 1" :: "v"((unsigned long long)p), "v"(v) : "memory"); }
template <class T> __device__ __forceinline__ void st8_wt(const void* p, T v) { static_assert(sizeof(T) == 8, "st8_wt"); asm volatile("global_store_dwordx2 %0, %1, off sc1\n\ts_nop 1" :: "v"((unsigned long long)p), "v"(v) : "memory"); }
namespace pg8 {
#define PG8_LAS __attribute__((address_space(3)))
typedef unsigned short bf16_t;
typedef short bf16x8 __attribute__((ext_vector_type(8)));
typedef float f32x4 __attribute__((ext_vector_type(4)));
typedef unsigned u32x4 __attribute__((ext_vector_type(4)));
constexpr int BM = 256, BK = 64, HALF = 128, HTB = HALF * BK * 2  , STAGE_BYTES = 8 * HTB, NXCD = 8, WGM = 8;

__host__ __device__ __forceinline__ int lds_byte(int r, int c) { const int st = (r >> 4) * 2 + (c >> 5), rr = r & 15, cc = c & 31, ob = rr * 64 + cc * 2; return st * 1024 + (ob ^ (((ob >> 9) & 1) << 5)); }
__host__ __device__ __forceinline__ void stage_rc(int b, int& R, int& C) { const int st = b / 1024, sb = b % 1024, swz = sb ^ (((sb >> 9) & 1) << 5); R = (st >> 1) * 16 + swz / 64; C = (st & 1) * 32 + (swz % 64) / 2; }
__host__ __device__ __forceinline__ int perm32(int rho) { const int n = rho >> 4, i = rho & 15; return 8 * (i >> 2) + 4 * n + (i & 3); }

struct Unit { int pm, pn; };
struct Gemm { const bf16_t* A; const bf16_t* Bt; int M, N, K; };

struct StaticOrder {
    int nM, nN, nwg, G, c;
    __host__ __device__ void init(int M, int N, int G_, int c_) { nM = M / BM; nN = N / BM; nwg = nM * nN; G = G_; c = c_; }
    __host__ __device__ bool next(int i, Unit& u) const {
        const long L = (long)i * G + c; if (L >= nwg) return false;
        int wgid = (int)L; { const int q = nwg / NXCD, r = nwg % NXCD, xcd = wgid % NXCD, off = wgid / NXCD; wgid = (xcd < r ? xcd * (q + 1) : r * (q + 1) + (xcd - r) * q) + off; }
        const int nig = WGM * nN, gid = wgid / nig, fm = gid * WGM, gsz = (nM - fm) < WGM ? (nM - fm) : WGM;
        u.pm = fm + ((wgid % nig) % gsz); u.pn = (wgid % nig) / gsz; return true;
    }
    __device__ __forceinline__ void a_ready(const Unit&) const {}
    __device__ __forceinline__ void done(const Unit&) const {}
};

typedef float f32x2c __attribute__((ext_vector_type(2))); typedef __bf16 bf16x2c __attribute__((ext_vector_type(2)));
__device__ __forceinline__ unsigned cvt_pk_bf16(float lo, float hi) { const f32x2c v = {lo, hi}; const bf16x2c b = __builtin_convertvector(v, bf16x2c); return __builtin_bit_cast(unsigned, b); }
typedef float f32x2 __attribute__((ext_vector_type(2)));
typedef unsigned u32x2 __attribute__((ext_vector_type(2)));
__device__ __forceinline__ float dpp_ror1(float v) { return __builtin_bit_cast(float, __builtin_amdgcn_update_dpp(0, __builtin_bit_cast(int, v), 0x121, 0xf, 0xf, false)); }
__device__ __forceinline__ float dpp_ror2(float v) { return __builtin_bit_cast(float, __builtin_amdgcn_update_dpp(0, __builtin_bit_cast(int, v), 0x122, 0xf, 0xf, false)); }
__device__ __forceinline__ float dpp_shr1_old(float old, float v) { return __builtin_bit_cast(float, __builtin_amdgcn_update_dpp(__builtin_bit_cast(int, old), __builtin_bit_cast(int, v), 0x111, 0xf, 0xf, false)); }
__device__ __forceinline__ float dpp_shr2_old(float old, float v) { return __builtin_bit_cast(float, __builtin_amdgcn_update_dpp(__builtin_bit_cast(int, old), __builtin_bit_cast(int, v), 0x112, 0xf, 0xf, false)); }
template <int CTRL> __device__ __forceinline__ float dppz(float v) { return __builtin_bit_cast(float, __builtin_amdgcn_update_dpp(0, __builtin_bit_cast(int, v), CTRL, 0xf, 0xf, true)); }
__device__ __forceinline__ f32x4 ror1v(f32x4 v) { return (f32x4){dpp_ror1(v[0]), dpp_ror1(v[1]), dpp_ror1(v[2]), dpp_ror1(v[3])}; }
__device__ __forceinline__ f32x4 ror2v(f32x4 v) { return (f32x4){dpp_ror2(v[0]), dpp_ror2(v[1]), dpp_ror2(v[2]), dpp_ror2(v[3])}; }
__device__ __forceinline__ float silu_mul(float g, float v) { return g * v * __builtin_amdgcn_rcpf(1.0f + __builtin_amdgcn_exp2f(-1.4426950408889634f * g)); }

struct EpiInProj {
    static constexpr bool PERM = true, AFTER_DRAIN = false, STAGED = false;
    bf16_t* QKVU; size_t tstride; float* out; const float* gq; const float* gk; const float* rrx;
    __device__ __forceinline__ void operator()(f32x4 (&acc)[2][2][4][2], const Unit& u, int wr, int wc, int fr, int fq) const {
        const int type = u.pn >> 1, half = u.pn & 1;
        const int cbase = half * 256 + wc * 64 + 8 * fq;
        bf16_t* dst = QKVU + (size_t)type * tstride;
        f32x4 gv[2][2];
        if (type < 2) { const float* gs = (type == 0 ? gq : gk) + (half * 4 + wc) * 64 + 8 * fq; const float qs = type == 0 ? QSCALE : 1.0f;
#pragma unroll
            for (int bj = 0; bj < 2; ++bj)
#pragma unroll
                for (int n = 0; n < 2; ++n) gv[bj][n] = *(const f32x4*)(gs + 32 * bj + 4 * n) * qs; }
        float rxv[2][4];
#pragma unroll
        for (int ai = 0; ai < 2; ++ai)
#pragma unroll
            for (int m = 0; m < 4; ++m) rxv[ai][m] = rrx[u.pm * BM + ai * HALF + wr * 64 + m * 16 + fr];
#pragma unroll
        for (int ai = 0; ai < 2; ++ai)
#pragma unroll
            for (int m = 0; m < 4; ++m) {
                const int row = u.pm * BM + ai * HALF + wr * 64 + m * 16 + fr;
                const float rx = rxv[ai][m];
                f32x4 v[2][2];
#pragma unroll
                for (int bj = 0; bj < 2; ++bj)
#pragma unroll
                    for (int n = 0; n < 2; ++n) v[bj][n] = acc[ai][bj][m][n];
                if (type < 2) {
                    float ss = 0.f;
#pragma unroll
                    for (int bj = 0; bj < 2; ++bj)
#pragma unroll
                        for (int n = 0; n < 2; ++n) { const f32x4 x = v[bj][n]; ss += (x[0] * x[0] + x[1] * x[1]) + (x[2] * x[2] + x[3] * x[3]); }
                    ss += __shfl_xor(ss, 16); ss += __shfl_xor(ss, 32);
                    const float r = __builtin_amdgcn_rsqf(ss * (rx * rx) * (1.0f / 64.0f) + EPS) * rx;
#pragma unroll
                    for (int bj = 0; bj < 2; ++bj)
#pragma unroll
                        for (int n = 0; n < 2; ++n) v[bj][n] = v[bj][n] * r * gv[bj][n];
                } else {
#pragma unroll
                    for (int bj = 0; bj < 2; ++bj)
#pragma unroll
                        for (int n = 0; n < 2; ++n) v[bj][n] = v[bj][n] * rx;
                }
                bf16_t* rowp = type < 3 ? dst + ((size_t)(((row >> 11) * 8 + half * 4 + wc) * 2048 + (row & 2047)) * 64 + 8 * fq) : dst + (size_t)row * 512 + cbase;
#pragma unroll
                for (int bj = 0; bj < 2; ++bj) { u32x4 w; w.x = cvt_pk_bf16(v[bj][0][0], v[bj][0][1]); w.y = cvt_pk_bf16(v[bj][0][2], v[bj][0][3]); w.z = cvt_pk_bf16(v[bj][1][0], v[bj][1][1]); w.w = cvt_pk_bf16(v[bj][1][2], v[bj][1][3]);
                    *(u32x4*)(rowp + 32 * bj) = w; }
                if (type == 1 || type == 2) {
                    float* o = out + (type == 1 ? O_KP : O_VP) + (size_t)row * 512 + cbase;
#pragma unroll
                    for (int bj = 0; bj < 2; ++bj) { __builtin_nontemporal_store(v[bj][0], (f32x4*)(o + 32 * bj)); __builtin_nontemporal_store(v[bj][1], (f32x4*)(o + 32 * bj + 4)); }
                } else if (type == 3) {
                    float* o = nullptr;
                    { const int t = row & (SEQ - 1); if (t >= SEQ - 15) o = out + O_PP + ((size_t)(row >> 11) * 15 + (t - (SEQ - 15))) * 512 + cbase; }
                    if (o) {
#pragma unroll
                        for (int bj = 0; bj < 2; ++bj) { *(f32x4*)(o + 32 * bj) = v[bj][0]; *(f32x4*)(o + 32 * bj + 4) = v[bj][1]; } }
                }
            }
    }
};

struct EpiOutProj {
    static constexpr bool PERM = true, AFTER_DRAIN = false, STAGED = false;
    const bf16_t* xp; bf16_t* HB; float* ssp; PG8_LAS float* tab;
    __device__ __forceinline__ void operator()(f32x4 (&acc)[2][2][4][2], const Unit& u, int wr, int wc, int fr, int fq) const {
        const size_t off0 = (size_t)(u.pm * BM + wr * 64 + fr) * DM + u.pn * BM + wc * 32 + 8 * fq;
#pragma unroll
        for (int ai = 0; ai < 2; ++ai) {
            u32x4 xb[4][2];
#pragma unroll
            for (int m = 0; m < 4; ++m)
#pragma unroll
                for (int bj = 0; bj < 2; ++bj) xb[m][bj] = *(const u32x4*)(xp + off0 + (size_t)(ai * HALF + m * 16) * DM + bj * HALF);
            __builtin_amdgcn_sched_barrier(0);
#pragma unroll
            for (int m = 0; m < 4; ++m) {
                const int lrow = ai * HALF + wr * 64 + m * 16 + fr;
                float part = 0.f;
#pragma unroll
                for (int bj = 0; bj < 2; ++bj) {
                    const u32x4 xw = xb[m][bj];
                    const f32x4 h0 = (f32x4){__builtin_bit_cast(float, xw.x << 16), __builtin_bit_cast(float, xw.x & 0xffff0000u), __builtin_bit_cast(float, xw.y << 16), __builtin_bit_cast(float, xw.y & 0xffff0000u)} + acc[ai][bj][m][0];
                    const f32x4 h1 = (f32x4){__builtin_bit_cast(float, xw.z << 16), __builtin_bit_cast(float, xw.z & 0xffff0000u), __builtin_bit_cast(float, xw.w << 16), __builtin_bit_cast(float, xw.w & 0xffff0000u)} + acc[ai][bj][m][1];
                    u32x4 w; w.x = cvt_pk_bf16(h0[0], h0[1]); w.y = cvt_pk_bf16(h0[2], h0[3]); w.z = cvt_pk_bf16(h1[0], h1[1]); w.w = cvt_pk_bf16(h1[2], h1[3]);
                    st16_wt(HB + off0 + (size_t)(ai * HALF + m * 16) * DM + bj * HALF, w);
                    part += (h0[0] * h0[0] + h0[1] * h0[1]) + (h0[2] * h0[2] + h0[3] * h0[3]) + (h1[0] * h1[0] + h1[1] * h1[1]) + (h1[2] * h1[2] + h1[3] * h1[3]);
                }
                part += __shfl_xor(part, 16); part += __shfl_xor(part, 32);
                if (fq == 0) tab[lrow * 4 + wc] = part;
            }
            __builtin_amdgcn_sched_barrier(0);
        }
        asm volatile("s_waitcnt lgkmcnt(0)" ::: "memory"); __builtin_amdgcn_s_barrier(); asm volatile("" ::: "memory");
        const int tid = (wr * 4 + wc) * 64 + fq * 16 + fr;
        if (tid < BM) { const f32x4 t = *(const PG8_LAS f32x4*)(tab + tid * 4); ssp[(size_t)(u.pm * BM + tid) * 4 + u.pn] = (t[0] + t[1]) + (t[2] + t[3]); }
    }
};

struct EpiUp {
    static constexpr bool PERM = true, AFTER_DRAIN = false, STAGED = true;
    bf16_t* ACT; const float* ssp; float* halo; float* out; const float* convw; const float* convb; PG8_LAS float* tab; PG8_LAS unsigned char* epf;
    __device__ __forceinline__ void stage(const Unit& u, int slot, int wid, int lane) const {
        const float* src;
        if (wid < 4) src = ssp + (size_t)(u.pm * BM + wid * 64 + lane) * 4;
        else { const int sl = 2 * (wid - 4) + (lane >> 5), arr = sl >> 1, bj = sl & 1; src = (arr < 3 ? convw + arr * FF2 : convb) + bj * FF + u.pn * 128 + 4 * (lane & 31); }
        __builtin_amdgcn_global_load_lds((const unsigned*)src, (PG8_LAS unsigned*)(epf + slot * 8192 + wid * 1024), 16, 0, 0);
    }
    __device__ __forceinline__ void run(f32x4 (&acc)[2][2][4][2], const Unit& u, int slot, int wr, int wc, int fr, int fq) const {
        const int chb = 32 * wc + 8 * fq, ch0 = u.pn * 128 + chb;
        const PG8_LAS unsigned char* sl = epf + slot * 8192;
#pragma unroll
        for (int ai = 0; ai < 2; ++ai)
#pragma unroll
            for (int m = 0; m < 4; ++m) {
                const int row = u.pm * BM + ai * HALF + wr * 64 + m * 16 + fr;
                const f32x4 t = *(const PG8_LAS f32x4*)(sl + 16 * (ai * HALF + wr * 64 + m * 16 + fr));
                const float rr = __builtin_amdgcn_rsqf(((t[0] + t[1]) + (t[2] + t[3])) * (1.0f / DM) + EPS);
#pragma unroll
                for (int bj = 0; bj < 2; ++bj)
#pragma unroll
                    for (int n = 0; n < 2; ++n) acc[ai][bj][m][n] = acc[ai][bj][m][n] * rr;
            }
        if (fr >= 14) {
#pragma unroll
            for (int ai = 0; ai < 2; ++ai)
#pragma unroll
                for (int bj = 0; bj < 2; ++bj)
#pragma unroll
                    for (int n = 0; n < 2; ++n) *(PG8_LAS f32x4*)(tab + ((ai * 2 + wr) * 2 + (fr - 14)) * 256 + bj * 128 + chb + 4 * n) = acc[ai][bj][3][n];
        }
        {
            if (wr == 0 && fr < 2) {
#pragma unroll
                for (int bj = 0; bj < 2; ++bj)
#pragma unroll
                    for (int n = 0; n < 2; ++n) *(f32x4*)(halo + (size_t)(u.pm * 4 + fr) * FF2 + bj * FF + ch0 + 4 * n) = acc[0][bj][0][n];
            }
            if (wr == 1 && fr >= 14) {
#pragma unroll
                for (int bj = 0; bj < 2; ++bj)
#pragma unroll
                    for (int n = 0; n < 2; ++n) { *(f32x4*)(halo + (size_t)(u.pm * 4 + 2 + fr - 14) * FF2 + bj * FF + ch0 + 4 * n) = acc[1][bj][3][n];
                        if ((u.pm & 7) == 7) *(f32x4*)(out + O_FP + (size_t)((u.pm >> 3) * 2 + fr - 14) * FF2 + bj * FF + ch0 + 4 * n) = acc[1][bj][3][n]; }
            }
        }
        asm volatile("s_waitcnt lgkmcnt(0)" ::: "memory"); __builtin_amdgcn_s_barrier(); asm volatile("" ::: "memory");
#pragma unroll
        for (int n = 0; n < 2; ++n) {
            f32x4 w0[2], w1[2], w2[2], cb[2];
#pragma unroll
            for (int bj = 0; bj < 2; ++bj) { const PG8_LAS unsigned char* cp = sl + 4096 + bj * 512 + (chb + 4 * n) * 4; w0[bj] = *(const PG8_LAS f32x4*)cp; w1[bj] = *(const PG8_LAS f32x4*)(cp + 1024); w2[bj] = *(const PG8_LAS f32x4*)(cp + 2048); cb[bj] = *(const PG8_LAS f32x4*)(cp + 3072); }
            f32x4 w1m[2], w0m[2];
#pragma unroll
            for (int bj = 0; bj < 2; ++bj) { w1m[bj] = fr == 0 ? w1[bj] : (f32x4){0.f, 0.f, 0.f, 0.f}; w0m[bj] = fr < 2 ? w0[bj] : (f32x4){0.f, 0.f, 0.f, 0.f}; }
#pragma unroll
            for (int ai = 0; ai < 2; ++ai) {
                f32x4 pv[2];
                {
                    const int sb = (wr == 1) ? ai * 2 : 1;
#pragma unroll
                    for (int bj = 0; bj < 2; ++bj) { pv[bj] = (f32x4){0.f, 0.f, 0.f, 0.f}; if (fr >= 14) pv[bj] = *(const PG8_LAS f32x4*)(tab + (sb * 2 + (fr - 14)) * 256 + bj * 128 + chb + 4 * n); }
                }
#pragma unroll
                for (int m = 0; m < 4; ++m) {
                    const int row = u.pm * BM + ai * HALF + wr * 64 + m * 16 + fr;
                    f32x4 cv[2];
                    {
#pragma unroll
                        for (int bj = 0; bj < 2; ++bj) { const f32x4 cur = acc[ai][bj][m][n]; const f32x4 prv = m > 0 ? acc[ai][bj][m - 1][n] : pv[bj];
                            f32x4 c4 = cb[bj] + w2[bj] * cur;
#define FD4(CTRL, X, W) "v_fmac_f32_dpp %0, %" #X ", %" #W " " CTRL " row_mask:0xf bank_mask:0xf\n\t"
                            float c0 = c4[0], c1 = c4[1], c2 = c4[2], c3 = c4[3];
                            asm("s_nop 1\n\t"
                                "v_fmac_f32_dpp %0, %4, %12 row_shr:1 row_mask:0xf bank_mask:0xf bound_ctrl:1\n\tv_fmac_f32_dpp %1, %5, %13 row_shr:1 row_mask:0xf bank_mask:0xf bound_ctrl:1\n\t"
                                "v_fmac_f32_dpp %2, %6, %14 row_shr:1 row_mask:0xf bank_mask:0xf bound_ctrl:1\n\tv_fmac_f32_dpp %3, %7, %15 row_shr:1 row_mask:0xf bank_mask:0xf bound_ctrl:1\n\t"
                                "v_fmac_f32_dpp %0, %4, %16 row_shr:2 row_mask:0xf bank_mask:0xf bound_ctrl:1\n\tv_fmac_f32_dpp %1, %5, %17 row_shr:2 row_mask:0xf bank_mask:0xf bound_ctrl:1\n\t"
                                "v_fmac_f32_dpp %2, %6, %18 row_shr:2 row_mask:0xf bank_mask:0xf bound_ctrl:1\n\tv_fmac_f32_dpp %3, %7, %19 row_shr:2 row_mask:0xf bank_mask:0xf bound_ctrl:1\n\t"
                                "v_fmac_f32_dpp %0, %8, %20 row_ror:1 row_mask:0xf bank_mask:0xf\n\tv_fmac_f32_dpp %1, %9, %21 row_ror:1 row_mask:0xf bank_mask:0xf\n\t"
                                "v_fmac_f32_dpp %2, %10, %22 row_ror:1 row_mask:0xf bank_mask:0xf\n\tv_fmac_f32_dpp %3, %11, %23 row_ror:1 row_mask:0xf bank_mask:0xf\n\t"
                                "v_fmac_f32_dpp %0, %8, %24 row_ror:2 row_mask:0xf bank_mask:0xf\n\tv_fmac_f32_dpp %1, %9, %25 row_ror:2 row_mask:0xf bank_mask:0xf\n\t"
                                "v_fmac_f32_dpp %2, %10, %26 row_ror:2 row_mask:0xf bank_mask:0xf\n\tv_fmac_f32_dpp %3, %11, %27 row_ror:2 row_mask:0xf bank_mask:0xf"
                                : "+v"(c0), "+v"(c1), "+v"(c2), "+v"(c3)
                                : "v"(cur[0]), "v"(cur[1]), "v"(cur[2]), "v"(cur[3]), "v"(prv[0]), "v"(prv[1]), "v"(prv[2]), "v"(prv[3]),
                                  "v"(w1[bj][0]), "v"(w1[bj][1]), "v"(w1[bj][2]), "v"(w1[bj][3]), "v"(w0[bj][0]), "v"(w0[bj][1]), "v"(w0[bj][2]), "v"(w0[bj][3]),
                                  "v"(w1m[bj][0]), "v"(w1m[bj][1]), "v"(w1m[bj][2]), "v"(w1m[bj][3]), "v"(w0m[bj][0]), "v"(w0m[bj][1]), "v"(w0m[bj][2]), "v"(w0m[bj][3]));
#undef FD4
                            cv[bj] = (f32x4){c0, c1, c2, c3}; }
                    }
                    u32x2 w; w.x = cvt_pk_bf16(silu_mul(cv[0][0], cv[1][0]), silu_mul(cv[0][1], cv[1][1])); w.y = cvt_pk_bf16(silu_mul(cv[0][2], cv[1][2]), silu_mul(cv[0][3], cv[1][3]));
                    const bool skip = ai == 0 && m == 0 && wr == 0 && fr < 2;
                    if (!skip) *(u32x2*)(ACT + (size_t)row * FF + ch0 + 4 * n) = w;
                }
            }
        }
    }
};

struct EpiDown {
    static constexpr bool PERM = true, AFTER_DRAIN = false, STAGED = false;
    float* Y; const bf16_t* HB;
    __device__ __forceinline__ void operator()(f32x4 (&acc)[2][2][4][2], const Unit& u, int wr, int wc, int fr, int fq) const {
        const size_t off0 = (size_t)(u.pm * BM + wr * 64 + fr) * DM + u.pn * BM + wc * 32 + 8 * fq;
        u32x4 hb[2][4][2];
#pragma unroll
        for (int ai = 0; ai < 2; ++ai)
#pragma unroll
            for (int m = 0; m < 4; ++m)
#pragma unroll
                for (int bj = 0; bj < 2; ++bj) hb[ai][m][bj] = *(const u32x4*)(HB + off0 + (size_t)(ai * HALF + m * 16) * DM + bj * HALF);
        __builtin_amdgcn_sched_barrier(0);
#pragma unroll
        for (int ai = 0; ai < 2; ++ai)
#pragma unroll
            for (int m = 0; m < 4; ++m)
#pragma unroll
                for (int bj = 0; bj < 2; ++bj) { const u32x4 h = hb[ai][m][bj]; float* yo = Y + off0 + (size_t)(ai * HALF + m * 16) * DM + bj * HALF;
                    const f32x4 a = (f32x4){__builtin_bit_cast(float, h.x << 16), __builtin_bit_cast(float, h.x & 0xffff0000u), __builtin_bit_cast(float, h.y << 16), __builtin_bit_cast(float, h.y & 0xffff0000u)} + acc[ai][bj][m][0];
                    const f32x4 b = (f32x4){__builtin_bit_cast(float, h.z << 16), __builtin_bit_cast(float, h.z & 0xffff0000u), __builtin_bit_cast(float, h.w << 16), __builtin_bit_cast(float, h.w & 0xffff0000u)} + acc[ai][bj][m][1];
                    *(f32x4*)yo = a; *(f32x4*)(yo + 4) = b; }
    }
};

template <class Epi, class Sched, bool ALIGN_EPI = false, bool SP2 = false>
__device__ __forceinline__ void gemm_phase(PG8_LAS unsigned char* lds, const Gemm g, const Sched& S, const Epi& E) {
    const int tid = threadIdx.x, wid = __builtin_amdgcn_readfirstlane(tid >> 6), lane = tid & 63, wr = wid >> 2, wc = wid & 3, fr = lane & 15, fq = lane >> 4;
    const int K = g.K, nt = K / BK;
    unsigned voffA[2], voffB[2];
#pragma unroll
    for (int i = 0; i < 2; ++i) { int R, C; stage_rc(tid * 16 + i * 8192, R, C); const int Rb = Epi::PERM ? ((R & ~31) + perm32(R & 31)) : R;
        voffA[i] = (unsigned)(R * K + C) * 2u; voffB[i] = (unsigned)(Rb * K + C) * 2u; }
    const size_t kstep = (size_t)(BK * 2);
    const size_t hstep = (size_t)HALF * K * 2;
    const size_t tstep = 2 * hstep;
    const unsigned ldsw = (unsigned)wid * 1024u;
    const int aoff = lds_byte(wr * 64 + fr, fq * 8), boff = lds_byte(wc * 32 + fr, fq * 8);
#define PG8_SA(b, h) (((b) * 2 + (h)) * HTB)
#define PG8_SB(b, h) ((4 + (b) * 2 + (h)) * HTB)
#define PG8_STAGE(bufoff, gbase, voff) do { _Pragma("unroll") for (int _i = 0; _i < 2; ++_i) \
        __builtin_amdgcn_global_load_lds((const unsigned*)((const char*)(gbase) + (voff)[_i]), (PG8_LAS unsigned*)(lds + (bufoff) + ldsw + _i * 8192), 16, 0, 0); } while (0)
#define PG8_LDA(dst, b, h) do { _Pragma("unroll") for (int m = 0; m < 4; ++m) _Pragma("unroll") for (int k = 0; k < 2; ++k) dst[m][k] = *(const PG8_LAS bf16x8*)(lds + PG8_SA(b, h) + aoff + m * 2048 + k * 1024); } while (0)
#define PG8_LDB(dst, b, h) do { _Pragma("unroll") for (int n = 0; n < 2; ++n) _Pragma("unroll") for (int k = 0; k < 2; ++k) dst[n][k] = *(const PG8_LAS bf16x8*)(lds + PG8_SB(b, h) + boff + n * 2048 + k * 1024); } while (0)
#define PG8_MMA(ai, bj, At, Bt) do { __builtin_amdgcn_s_setprio(1); _Pragma("unroll") for (int m = 0; m < 4; ++m) _Pragma("unroll") for (int n = 0; n < 2; ++n) _Pragma("unroll") for (int k = 0; k < 2; ++k) \
        acc[ai][bj][m][n] = __builtin_amdgcn_mfma_f32_16x16x32_bf16(Bt[n][k], At[m][k], acc[ai][bj][m][n], 0, 0, 0); __builtin_amdgcn_s_setprio(0); } while (0)
#define PG8_WAIT_V(n) asm volatile("s_waitcnt vmcnt(" #n ")" ::: "memory")
#define PG8_WAIT_L(n) asm volatile("s_waitcnt lgkmcnt(" #n ")" ::: "memory")
#define PG8_BAR __builtin_amdgcn_s_barrier()
#define PG8_SCHED __builtin_amdgcn_sched_barrier(0)
    Unit cur, nxt; int ui = 0;
    if (!S.next(0, cur)) return;
    if constexpr (Epi::STAGED) E.stage(cur, 0, wid, lane);
    f32x4 acc[2][2][4][2];
#pragma unroll
    for (int a = 0; a < 2; ++a)
#pragma unroll
        for (int b = 0; b < 2; ++b)
#pragma unroll
            for (int m = 0; m < 4; ++m)
#pragma unroll
                for (int n = 0; n < 2; ++n) acc[a][b][m][n] = (f32x4){0.f, 0.f, 0.f, 0.f};
    bf16x8 At[4][2], B0[2][2], B1[2][2];
    const char* cA = (const char*)g.A + (size_t)cur.pm * tstep; const char* cB = (const char*)g.Bt + (size_t)cur.pn * tstep;
    S.a_ready(cur);
    if constexpr (SP2) {
        PG8_STAGE(PG8_SB(0, 0), cB, voffB); PG8_STAGE(PG8_SB(0, 1), cB + hstep, voffB); PG8_STAGE(PG8_SA(0, 0), cA, voffA); PG8_STAGE(PG8_SA(0, 1), cA + hstep, voffA);
        if (wr == 1) PG8_BAR;
        PG8_WAIT_V(2); PG8_BAR;
        PG8_STAGE(PG8_SB(1, 0), cB + kstep, voffB); PG8_STAGE(PG8_SA(1, 0), cA + kstep, voffA); PG8_STAGE(PG8_SB(1, 1), cB + hstep + kstep, voffB);
        PG8_WAIT_V(6); PG8_BAR;
    } else {
        PG8_STAGE(PG8_SB(0, 0), cB, voffB); PG8_STAGE(PG8_SA(0, 0), cA, voffA); PG8_STAGE(PG8_SB(0, 1), cB + hstep, voffB); PG8_STAGE(PG8_SA(0, 1), cA + hstep, voffA);
        if (wr == 1) PG8_BAR;
        PG8_WAIT_V(4); PG8_BAR;
        PG8_STAGE(PG8_SB(1, 0), cB + kstep, voffB); PG8_STAGE(PG8_SA(1, 0), cA + kstep, voffA); PG8_STAGE(PG8_SB(1, 1), cB + hstep + kstep, voffB);
        PG8_WAIT_V(6); PG8_BAR;
    }
    for (;;) {
        const bool has_next = S.next(ui + 1, nxt);
        const char* nA = has_next ? (const char*)g.A + (size_t)nxt.pm * tstep : cA; const char* nB = has_next ? (const char*)g.Bt + (size_t)nxt.pn * tstep : cB;
        for (int t = 0; t < nt; t += 2) {
            const bool last = (t == nt - 2);
            const char* a1 = cA + (size_t)(t + 1) * kstep;
            const char* a2 = last ? nA : cA + (size_t)(t + 2) * kstep; const char* b2 = last ? nB : cB + (size_t)(t + 2) * kstep;
            const char* a3 = a2 + kstep; const char* b3 = b2 + kstep;
            if (last && has_next) S.a_ready(nxt);
            if constexpr (SP2) {
            PG8_LDB(B0, 0, 0); PG8_LDB(B1, 0, 1); PG8_SCHED; PG8_LDA(At, 0, 0); PG8_STAGE(PG8_SA(1, 1), a1 + hstep, voffA);
            PG8_WAIT_V(8); PG8_WAIT_L(0); PG8_BAR; PG8_MMA(0, 0, At, B0); PG8_MMA(0, 1, At, B1); PG8_BAR; PG8_SCHED;
            PG8_LDA(At, 0, 1); PG8_STAGE(PG8_SB(0, 0), b2, voffB); PG8_STAGE(PG8_SB(0, 1), b2 + hstep, voffB); PG8_STAGE(PG8_SA(0, 0), a2, voffA);
            PG8_WAIT_V(8); PG8_WAIT_L(0); PG8_BAR; PG8_MMA(1, 0, At, B0); PG8_MMA(1, 1, At, B1); PG8_BAR; PG8_SCHED;
            PG8_LDB(B0, 1, 0); PG8_LDB(B1, 1, 1); PG8_SCHED; PG8_LDA(At, 1, 0); PG8_STAGE(PG8_SA(0, 1), a2 + hstep, voffA);
            PG8_WAIT_V(8); PG8_WAIT_L(0); PG8_BAR; PG8_MMA(0, 0, At, B0); PG8_MMA(0, 1, At, B1); PG8_BAR; PG8_SCHED;
            PG8_LDA(At, 1, 1); PG8_STAGE(PG8_SB(1, 0), b3, voffB); PG8_STAGE(PG8_SB(1, 1), b3 + hstep, voffB); PG8_STAGE(PG8_SA(1, 0), a3, voffA);
            PG8_WAIT_V(8); PG8_WAIT_L(0); PG8_BAR; PG8_MMA(1, 0, At, B0); PG8_MMA(1, 1, At, B1); PG8_BAR; PG8_SCHED;
            } else {
            PG8_LDB(B0, 0, 0); PG8_SCHED; PG8_LDA(At, 0, 0); PG8_STAGE(PG8_SA(1, 1), a1 + hstep, voffA);
            PG8_WAIT_L(8); PG8_BAR; PG8_WAIT_L(0); PG8_MMA(0, 0, At, B0); PG8_BAR; PG8_SCHED;
            PG8_LDB(B1, 0, 1); PG8_STAGE(PG8_SB(0, 0), b2, voffB);
            PG8_BAR; PG8_WAIT_L(0); PG8_MMA(0, 1, At, B1); PG8_BAR;
            PG8_LDA(At, 0, 1); PG8_STAGE(PG8_SA(0, 0), a2, voffA);
            PG8_BAR; PG8_WAIT_L(0); PG8_MMA(1, 0, At, B0); PG8_BAR; PG8_SCHED;
            PG8_STAGE(PG8_SB(0, 1), b2 + hstep, voffB);
            PG8_WAIT_V(6); PG8_BAR; PG8_MMA(1, 1, At, B1); PG8_BAR;
            PG8_LDB(B0, 1, 0); PG8_SCHED; PG8_LDA(At, 1, 0); PG8_STAGE(PG8_SA(0, 1), a2 + hstep, voffA);
            PG8_WAIT_L(8); PG8_BAR; PG8_WAIT_L(0); PG8_MMA(0, 0, At, B0); PG8_BAR; PG8_SCHED;
            PG8_LDB(B1, 1, 1); PG8_STAGE(PG8_SB(1, 0), b3, voffB);
            PG8_BAR; PG8_WAIT_L(0); PG8_MMA(0, 1, At, B1); PG8_BAR;
            PG8_LDA(At, 1, 1); PG8_STAGE(PG8_SA(1, 0), a3, voffA);
            PG8_BAR; PG8_WAIT_L(0); PG8_MMA(1, 0, At, B0); PG8_BAR; PG8_SCHED;
            PG8_STAGE(PG8_SB(1, 1), b3 + hstep, voffB);
            PG8_WAIT_V(6); PG8_BAR; PG8_MMA(1, 1, At, B1); PG8_BAR;
            }
        }
        if constexpr (ALIGN_EPI) { if (wr == 0) PG8_BAR; }
        if constexpr (Epi::STAGED) { if (has_next) E.stage(nxt, (ui + 1) & 1, wid, lane); E.run(acc, cur, ui & 1, wr, wc, fr, fq); S.done(cur); }
        else if constexpr (!Epi::AFTER_DRAIN) { E(acc, cur, wr, wc, fr, fq); S.done(cur); }
        if (!has_next) break;
#pragma unroll
        for (int a = 0; a < 2; ++a)
#pragma unroll
            for (int b = 0; b < 2; ++b)
#pragma unroll
                for (int m = 0; m < 4; ++m)
#pragma unroll
                    for (int n = 0; n < 2; ++n) acc[a][b][m][n] = (f32x4){0.f, 0.f, 0.f, 0.f};
        cur = nxt; cA = nA; cB = nB; ++ui;
        if constexpr (ALIGN_EPI) { if (wr == 1) PG8_BAR; }
    }
    PG8_WAIT_V(0);
    if constexpr (!ALIGN_EPI) { if (wr == 0) PG8_BAR; }
    PG8_BAR;
    if constexpr (Epi::AFTER_DRAIN) { E.fused(acc, cur, wr, wc, fr, fq, lds, wid, lane); S.done(cur); }
#undef PG8_SA
#undef PG8_SB
#undef PG8_STAGE
#undef PG8_LDA
#undef PG8_LDB
#undef PG8_MMA
#undef PG8_WAIT_V
#undef PG8_WAIT_L
#undef PG8_BAR
#undef PG8_SCHED
}
}

constexpr int NWAVES = 8;
constexpr int N_LAUNCHES = MK_N_LAUNCHES;
constexpr int PER_PHASE = 7;
constexpr size_t MiB = 1u << 20;
constexpr size_t WS_CTL = 0, CTL_ZERO_BYTES = 64 * 1024;
constexpr size_t WS_WIN = 2 * MiB, WS_WOUT = 6 * MiB, WS_WUP = 8 * MiB, WS_WDN = 20 * MiB, WS_WPOOL = 26 * MiB;
constexpr size_t WS_HALO = 28 * MiB;
constexpr size_t WS_SSP = 40 * MiB;
constexpr size_t WS_SSPS = 42 * MiB;
constexpr size_t WS_RRX = 43 * MiB;
constexpr size_t WS_XN = 44 * MiB;
constexpr size_t WS_Q = 110 * MiB, QKVU_STRIDE = 33 * MiB;
constexpr size_t WS_MIX = 242 * MiB;
constexpr size_t WS_HB = 308 * MiB;
constexpr size_t WS_ACT = 374 * MiB;
constexpr size_t WS_OP = 554 * MiB;
constexpr size_t WS_LSE = 650 * MiB;
constexpr size_t WS_END = 654 * MiB;
static_assert(WS_XN + (size_t)M * DM * 2 <= WS_Q && WS_Q + 4 * QKVU_STRIDE <= WS_MIX && WS_MIX + (size_t)M * DM * 2 <= WS_HB && WS_HB + (size_t)M * DM * 2 <= WS_ACT && WS_ACT + (size_t)M * FF * 2 <= WS_OP && WS_OP + (size_t)3 * MP * 512 * 2 <= WS_LSE && WS_LSE + (size_t)3 * MP * 8 * 4 <= WS_END, "d_ws map");
static_assert(WS_HALO + (size_t)NPANEL * 4 * FF2 * 4 <= WS_SSP && WS_SSP + (size_t)M * 16 * 4 <= WS_XN && (size_t)M * 512 * 2 <= QKVU_STRIDE, "d_ws map 2");
constexpr int CW_TMO = 0, CW_CODE = 1, CW_BAR = 4096;
constexpr int RING_OFF = 0, RING_BYTES = 131072;
constexpr int TAB_OFF = RING_BYTES;
constexpr int LDSCTL_OFF = RING_BYTES + 8192, MISC_OFF = LDSCTL_OFF + 320;
constexpr int EPF_OFF = 140288;
constexpr int LDS_BYTES = 163840;
static_assert(MISC_OFF + 128 <= EPF_OFF && EPF_OFF + 2 * 8192 <= LDS_BYTES, "LDS map 2");
static_assert(MISC_OFF + 128 <= LDS_BYTES, "LDS map");
#define GAS __attribute__((address_space(1)))
#define LAS __attribute__((address_space(3)))
typedef unsigned short bf16;
typedef unsigned v4u __attribute__((ext_vector_type(4)));
typedef float f32x4 __attribute__((ext_vector_type(4)));
typedef short bf16x8 __attribute__((ext_vector_type(8)));
typedef GAS unsigned gu32;
typedef GAS unsigned long long gu64;
#define RLX_AGENT __ATOMIC_RELAXED, __HIP_MEMORY_SCOPE_AGENT
#define LDS_WAIT() asm volatile("s_waitcnt lgkmcnt(0)" ::: "memory")
#define VM_WAIT() asm volatile("s_waitcnt vmcnt(0)" ::: "memory")
__device__ __forceinline__ unsigned long long rt() { return __builtin_amdgcn_s_memrealtime(); }
__device__ __forceinline__ unsigned f2bf(float f) { unsigned u = __builtin_bit_cast(unsigned, f); return (u + 0x7fffu + ((u >> 16) & 1u)) >> 16; }
__device__ __forceinline__ unsigned pk2(float lo, float hi) { return f2bf(lo) | (f2bf(hi) << 16); }

#define XB_TMO      128
#define XB_XCNT(j)  (256  + 64 * (j))
#define XB_XSUB(j)  (1280 + 64 * (j))
#define XB_XGEN(j)  (2304 + 64 * (j))
#define XB_TOP      3328
#define XB_TOPGEN   3392
#define XCD_BAR_WORDS 3456
#define XB_SPIN_CAP (1u << 18)

__device__ __forceinline__ unsigned xb_ld(unsigned* p)              { return __hip_atomic_load(p, __ATOMIC_RELAXED, __HIP_MEMORY_SCOPE_AGENT); }
__device__ __forceinline__ unsigned xb_add(unsigned* p, unsigned v) { return __hip_atomic_fetch_add(p, v, __ATOMIC_RELAXED, __HIP_MEMORY_SCOPE_AGENT); }
__device__ __forceinline__ unsigned xb_xcc_id() { return (unsigned)__builtin_amdgcn_s_getreg((3 << 11) | 20) & 0xFu; }
#define XB_SPIN(cond, bar) do { unsigned _sp = 0; while (cond) { __builtin_amdgcn_s_sleep(1); \
    if ((++_sp & 255u) == 0u) { if (xb_ld(&(bar)[XB_TMO])) break; if (_sp > XB_SPIN_CAP) { atomicAdd(&(bar)[XB_TMO], 1u); break; } } } } while (0)

struct XcdBarrier {
    unsigned* bar; unsigned x;
    volatile LAS unsigned* st;
};

__device__ __forceinline__ XcdBarrier xcd_barrier_post(unsigned* bar, volatile LAS unsigned* st) {
    XcdBarrier b; b.bar = bar; b.x = xb_xcc_id(); b.st = st;
    if (threadIdx.x == 0) (void)xb_add(&bar[XB_XCNT(b.x)], 1u);
    return b;
}
__device__ __forceinline__ void xcd_barrier_complete(unsigned* bar, unsigned x, unsigned& nloc, unsigned& nx) {
    const unsigned G = gridDim.x * gridDim.y * gridDim.z;
    unsigned sum, cnt, mine, sp = 0u;
    for (;;) {
        sum = 0u; cnt = 0u; mine = 0u;
#pragma unroll
        for (unsigned j = 0; j < 16; ++j) { const unsigned c = xb_ld(&bar[XB_XCNT(j)]); sum += c; cnt += (c > 0u) ? 1u : 0u; mine = (j == x) ? c : mine; }
        if (sum == G) break;
        __builtin_amdgcn_s_sleep(1);
        if ((++sp & 255u) == 0u) { if (xb_ld(&bar[XB_TMO])) break; if (sp > XB_SPIN_CAP) { atomicAdd(&bar[XB_TMO], 1u); break; } }
    }
    nloc = mine > 0u ? mine : 1u; nx = cnt > 0u ? cnt : 1u;
}

__device__ __forceinline__ void xcd_barrier(const XcdBarrier& b) {
    asm volatile("s_waitcnt vmcnt(0)" ::: "memory");
    __syncthreads();
    if (threadIdx.x == 0) {
        unsigned* bar = b.bar;
        __builtin_amdgcn_s_waitcnt(0);
        unsigned nloc = b.st[0], nx = b.st[1];
        if (nloc == 0u) { xcd_barrier_complete(bar, b.x, nloc, nx); b.st[0] = nloc; b.st[1] = nx; }
        const unsigned old = xb_add(&bar[XB_XSUB(b.x)], 1u);
        const unsigned gen = old / nloc;
        if (old + 1u == (gen + 1u) * nloc) {
            __builtin_amdgcn_fence(__ATOMIC_RELEASE, "agent");
            asm volatile("s_waitcnt vmcnt(0)" ::: "memory");
            const unsigned og = xb_add(&bar[XB_TOP], 1u);
            const unsigned tg = og / nx;
            if (og + 1u == (tg + 1u) * nx) xb_add(&bar[XB_TOPGEN], 1u);
            else XB_SPIN(xb_ld(&bar[XB_TOPGEN]) == tg, bar);
            __builtin_amdgcn_fence(__ATOMIC_ACQUIRE, "agent");
            xb_add(&bar[XB_XGEN(b.x)], 1u);
            asm volatile("s_waitcnt vmcnt(0)" ::: "memory");
        } else {
            XB_SPIN(xb_ld(&bar[XB_XGEN(b.x)]) == gen, bar);
            __builtin_amdgcn_fence(__ATOMIC_ACQUIRE, "agent");
            asm volatile("s_waitcnt vmcnt(0)" ::: "memory");
        }
    }
    __syncthreads();
}

typedef unsigned u32x4_t __attribute__((ext_vector_type(4)));
typedef unsigned u32x2_t __attribute__((ext_vector_type(2)));
typedef short v4i16_t __attribute__((ext_vector_type(4)));
struct Frame {
    LAS unsigned char* lds;
    volatile LAS unsigned* MISC;
    gu32* ctl;
    int tid, lane, wave;
    int vcu, G;
    const float* in[18]; float* out; unsigned char* ws;
};
__device__ __forceinline__ float wave_sum(float v) {
#pragma unroll
    for (int o = 1; o < 64; o <<= 1) v += __shfl_xor(v, o);
    return v;
}
typedef float f32x2_t __attribute__((ext_vector_type(2))); typedef __bf16 bf16x2_t __attribute__((ext_vector_type(2)));
__device__ __forceinline__ unsigned cvtpk(float lo, float hi) { const f32x2_t v = {lo, hi}; const bf16x2_t b = __builtin_convertvector(v, bf16x2_t); return __builtin_bit_cast(unsigned, b); }
__device__ __forceinline__ bf16x8 cvt8(f32x4 a, f32x4 b) { u32x4_t w; w.x = cvtpk(a[0], a[1]); w.y = cvtpk(a[2], a[3]); w.z = cvtpk(b[0], b[1]); w.w = cvtpk(b[2], b[3]); return __builtin_bit_cast(bf16x8, w); }
__device__ __forceinline__ float bf2f(unsigned short b) { return __builtin_bit_cast(float, (unsigned)b << 16); }

__device__ __forceinline__ int dest_row_base(int mode, int n0) {
    if (mode == 1) { const int c0 = n0 & 255; return (n0 & ~255) + 128 * ((c0 >> 5) & 1) + 32 * (c0 >> 6); }
    if (mode == 2) { const int half = n0 >= FF ? 1 : 0, chn = n0 - half * FF; return 256 * (chn >> 7) + 128 * half + (chn & 127); }
    return n0;
}
__device__ __forceinline__ void p0_transpose_item(const float* W, int K, int N, bf16* WT, int mode, const float* kscale, LAS float* scr, int item, int lane) {
    const int nblk = N / 32, kb = item / nblk, nb = item % nblk, k0 = 64 * kb, n0 = 32 * nb;
    { f32x4 v[8]; const int n4 = 4 * (lane & 7);
#pragma unroll
      for (int i = 0; i < 8; ++i) v[i] = __builtin_nontemporal_load((const f32x4*)(W + (size_t)(k0 + 8 * i + (lane >> 3)) * N + n0 + n4));
#pragma unroll
      for (int i = 0; i < 8; ++i) { const int kk = 8 * i + (lane >> 3); const float sc = kscale ? kscale[k0 + kk] : 1.0f;
#pragma unroll
          for (int j = 0; j < 4; ++j) scr[kk * 33 + n4 + j] = v[i][j] * sc; } }
    LDS_WAIT(); asm volatile("" ::: "memory");
    const int c = lane & 7, rb = dest_row_base(mode, n0);
#pragma unroll
    for (int j = 0; j < 4; ++j) { const int n = (lane >> 3) + 8 * j; const LAS float* s = scr + (8 * c) * 33 + n;
        v4u o; o.x = pk2(s[0 * 33], s[1 * 33]); o.y = pk2(s[2 * 33], s[3 * 33]); o.z = pk2(s[4 * 33], s[5 * 33]); o.w = pk2(s[6 * 33], s[7 * 33]);
        *(GAS v4u*)(WT + (size_t)(rb + n) * K + k0 + 8 * c) = o; }
    LDS_WAIT(); asm volatile("" ::: "memory");
}
template <int NR> __device__ __forceinline__ void rms_rows_to_bf16(const float* const (&xrow)[NR], float* const (&rrow)[NR], bf16* const (&orow)[NR], int lane) {
    f32x4 v[NR][4]; float s[NR];
#pragma unroll
    for (int r = 0; r < NR; ++r) { const GAS f32x4* xr = (const GAS f32x4*)xrow[r] + 2 * lane;
#pragma unroll
        for (int j = 0; j < 2; ++j) { v[r][2 * j] = __builtin_nontemporal_load(xr + 128 * j); v[r][2 * j + 1] = __builtin_nontemporal_load(xr + 128 * j + 1); } }
#pragma unroll
    for (int r = 0; r < NR; ++r) { s[r] = 0.f;
#pragma unroll
        for (int j = 0; j < 4; ++j) s[r] += (v[r][j].x * v[r][j].x + v[r][j].y * v[r][j].y) + (v[r][j].z * v[r][j].z + v[r][j].w * v[r][j].w); }
#pragma unroll
    for (int r = 0; r < NR; ++r) { const float rr = 1.f / sqrtf(wave_sum(s[r]) * (1.f / DM) + EPS);
        if (lane == 0) *rrow[r] = rr;
        GAS v4u* o16 = (GAS v4u*)orow[r] + lane;
#pragma unroll
        for (int j = 0; j < 2; ++j) { const f32x4 a = v[r][2 * j], c = v[r][2 * j + 1];
            v4u o; o.x = pk2(a.x, a.y); o.y = pk2(a.z, a.w); o.z = pk2(c.x, c.y); o.w = pk2(c.z, c.w); o16[64 * j] = o; } }
}
__device__ __forceinline__ void p0_prologue(Frame& F) {
    LAS float* scr = (LAS float*)(F.lds + RING_OFF + F.wave * 16384);
    const int gw = F.vcu * NWAVES + F.wave, NGW = F.G * NWAVES;
    constexpr int I_IN = (DM / 64) * (PJ / 32), I_OUT = (DM / 64) * (DM / 32), I_UP = (DM / 64) * (FF2 / 32), I_DN = (FF / 64) * (DM / 32), I_PL = (128 / 64) * (128 / 32);
    constexpr int NITEMS = I_IN + I_OUT + I_UP + I_DN + 4 * I_PL;
    bf16* ws16 = (bf16*)F.ws;
    for (int it = gw; it < NITEMS; it += NGW) {
        int r = it;
        if (r < I_IN) { p0_transpose_item(F.in[7], DM, PJ, (bf16*)(F.ws + WS_WIN), 1, F.in[6], scr, r, F.lane); continue; } r -= I_IN;
        if (r < I_OUT) { p0_transpose_item(F.in[12], DM, DM, (bf16*)(F.ws + WS_WOUT), 0, nullptr, scr, r, F.lane); continue; } r -= I_OUT;
        if (r < I_UP) { p0_transpose_item(F.in[14], DM, FF2, (bf16*)(F.ws + WS_WUP), 2, F.in[13], scr, r, F.lane); continue; } r -= I_UP;
        if (r < I_DN) { p0_transpose_item(F.in[17], FF, DM, (bf16*)(F.ws + WS_WDN), 0, nullptr, scr, r, F.lane); continue; } r -= I_DN;
        { const int g = r / I_PL; p0_transpose_item(F.in[10] + (size_t)g * 128 * 128, 128, 128, (bf16*)(F.ws + WS_WPOOL) + (size_t)g * 128 * 128, 0, nullptr, scr, r % I_PL, F.lane); }
    }
    (void)ws16;
    for (int m0 = gw * 8; m0 < MP; m0 += NGW * 8) {
        const float* xr[8]; bf16* orw[8]; float* rrw[8];
#pragma unroll
        for (int r = 0; r < 8; ++r) { const int m = m0 + r; xr[r] = F.in[0] + (size_t)m * DM; orw[r] = (bf16*)(F.ws + WS_XN) + (size_t)m * DM; rrw[r] = (float*)(F.ws + WS_RRX) + m; }
        rms_rows_to_bf16<8>(xr, rrw, orw, F.lane);
    }
    for (int i = NGW - 1 - gw; i < MS; i += NGW) {
        const float* xr[1] = {F.in[1] + (size_t)i * DM}; bf16* orw[1] = {(bf16*)(F.ws + WS_XN) + (size_t)(MP + i) * DM}; float* rrw[1] = {(float*)(F.ws + WS_RRX) + MP + i};
        rms_rows_to_bf16<1>(xr, rrw, orw, F.lane);
    }
    { const int gt = F.vcu * (NWAVES * 64) + F.tid, NT = F.G * NWAVES * 64;
      for (int i = gt; i < DB * 11 * 128; i += NT) { const int b = i / (11 * 128), rem = i % (11 * 128), j = rem >> 7, c4 = rem & 127;
          *(f32x4*)(F.out + O_PS + ((size_t)b * 15 + j) * 512 + 4 * c4) = *(const f32x4*)(F.in[4] + ((size_t)b * 15 + 4 + j) * 512 + 4 * c4); } }
}

__device__ __forceinline__ float max4g(float v) {
    auto a = __builtin_amdgcn_permlane16_swap(__float_as_uint(v), __float_as_uint(v), false, false); v = fmaxf(__uint_as_float(a[0]), __uint_as_float(a[1]));
    auto b = __builtin_amdgcn_permlane32_swap(__float_as_uint(v), __float_as_uint(v), false, false); return fmaxf(__uint_as_float(b[0]), __uint_as_float(b[1]));
}
__device__ __forceinline__ float sum4g(float v) {
    auto a = __builtin_amdgcn_permlane16_swap(__float_as_uint(v), __float_as_uint(v), false, false); v = __uint_as_float(a[0]) + __uint_as_float(a[1]);
    auto b = __builtin_amdgcn_permlane32_swap(__float_as_uint(v), __float_as_uint(v), false, false); return __uint_as_float(b[0]) + __uint_as_float(b[1]);
}
constexpr int VROW = 160;
constexpr int VTILE = 32 * VROW;
struct AState { float m, l; f32x4 o[4]; };
template <bool SAMPLE> struct KVRaw;
template <> struct KVRaw<false> { bf16x8 k[2][2]; bf16x8 v[4]; };
template <> struct KVRaw<true> { f32x4 k[2][2][2]; f32x4 v[8]; };
template <bool SAMPLE> __device__ __forceinline__ const void* kv_row(const void* base, const void* newb, int j, int rs, int cr, int b, int h) {
    int a = (j << rs) + cr;
    if (!SAMPLE) { a = a > SEQ - 1 ? SEQ - 1 : a; return (const bf16*)base + ((size_t)(b * SEQ + a) * AW + h * 64); }
    a = a > 2048 + DS - 1 ? 2048 + DS - 1 : a;
    return a < 2048 ? (const float*)base + ((size_t)(b * 2048 + a) * AW + h * 64) : (const float*)newb + ((size_t)(b * DS + a - 2048) * AW + h * 64);
}
template <bool SAMPLE> __device__ __forceinline__ void kv_load(KVRaw<SAMPLE>& R, const void* Kb, const void* Kn, const void* Vb, const void* Vn, int kb, int rs, int cr, int b, int h, int lane) {
    const int g = lane >> 4, c15 = lane & 15;
#pragma unroll
    for (int t = 0; t < 2; ++t) { const void* p = kv_row<SAMPLE>(Kb, Kn, 16 * (kb + t) + c15, rs, cr, b, h);
#pragma unroll
        for (int s = 0; s < 2; ++s) {
            if constexpr (!SAMPLE) R.k[t][s] = *(const bf16x8*)((const bf16*)p + 32 * s + 8 * g);
            else { R.k[t][s][0] = *(const f32x4*)((const float*)p + 32 * s + 8 * g); R.k[t][s][1] = *(const f32x4*)((const float*)p + 32 * s + 8 * g + 4); } } }
    { const void* p = kv_row<SAMPLE>(Vb, Vn, 16 * kb + (lane >> 1), rs, cr, b, h); const int hh = lane & 1;
        if constexpr (!SAMPLE) {
#pragma unroll
            for (int i = 0; i < 4; ++i) R.v[i] = *(const bf16x8*)((const bf16*)p + 32 * hh + 8 * i);
        } else {
#pragma unroll
            for (int i = 0; i < 8; ++i) R.v[i] = *(const f32x4*)((const float*)p + 32 * hh + 4 * i);
        } }
}
template <bool SAMPLE> __device__ __forceinline__ void attn_step(AState& st, const KVRaw<SAMPLE>& R, const bf16x8 (&qf)[2], int kb, int qsub, float sl2r, int dmin, int mt, LAS unsigned char* vl, int lane) {
    const int g = lane >> 4;
    { LAS unsigned char* wp = vl + (lane >> 1) * VROW + (lane & 1) * 64;
#pragma unroll
        for (int i = 0; i < 4; ++i) { bf16x8 x; if constexpr (!SAMPLE) x = R.v[i]; else x = cvt8(R.v[2 * i], R.v[2 * i + 1]); *(LAS bf16x8*)(wp + 16 * i) = x; } }
    f32x4 s[2];
#pragma unroll
    for (int t = 0; t < 2; ++t) { bf16x8 k0, k1; if constexpr (!SAMPLE) { k0 = R.k[t][0]; k1 = R.k[t][1]; } else { k0 = cvt8(R.k[t][0][0], R.k[t][0][1]); k1 = cvt8(R.k[t][1][0], R.k[t][1][1]); }
        s[t] = __builtin_amdgcn_mfma_f32_16x16x32_bf16(k0, qf[0], (f32x4){0.f, 0.f, 0.f, 0.f}, 0, 0, 0);
        s[t] = __builtin_amdgcn_mfma_f32_16x16x32_bf16(k1, qf[1], s[t], 0, 0, 0); }
    float mx = -INFINITY;
#pragma unroll
    for (int t = 0; t < 2; ++t)
#pragma unroll
        for (int i = 0; i < 4; ++i) { const int d = qsub - (16 * (kb + t) + 4 * g + i);
            const float lg = (mt >= 1 && (d & 3) == 0) ? ((mt == 2 && (d & 15) == 0) ? 1.5849625007211562f : 1.0f) : 0.f;
            const float x = ((unsigned)(d - dmin) <= (unsigned)(128 - dmin)) ? s[t][i] - sl2r * (float)d + lg : -INFINITY; s[t][i] = x; mx = fmaxf(mx, x); }
    mx = max4g(mx);
    const float mn = fmaxf(st.m, mx), alpha = __builtin_amdgcn_exp2f(st.m - mn); st.m = mn;
    float ps = 0.f;
#pragma unroll
    for (int t = 0; t < 2; ++t)
#pragma unroll
        for (int i = 0; i < 4; ++i) { const float p = __builtin_amdgcn_exp2f(s[t][i] - mn); s[t][i] = p; ps += p; }
    st.l = st.l * alpha + ps;
#pragma unroll
    for (int c = 0; c < 4; ++c) st.o[c] = st.o[c] * alpha;
    const bf16x8 pf = cvt8(s[0], s[1]);
    const LAS unsigned char* rp = vl + (4 * g + ((lane & 15) >> 2)) * VROW + (lane & 3) * 8;
#pragma unroll
    for (int c = 0; c < 4; ++c) {
        const v4i16_t a = __builtin_amdgcn_ds_read_tr16_b64_v4i16((LAS v4i16_t*)(rp + 32 * c));
        const v4i16_t bq = __builtin_amdgcn_ds_read_tr16_b64_v4i16((LAS v4i16_t*)(rp + 16 * VROW + 32 * c));
        const bf16x8 vf = (bf16x8){a[0], a[1], a[2], a[3], bq[0], bq[1], bq[2], bq[3]};
        st.o[c] = __builtin_amdgcn_mfma_f32_16x16x32_bf16(vf, pf, st.o[c], 0, 0, 0);
    }
}
__device__ __forceinline__ void attn_init(AState& st) { st.m = -1e30f; st.l = 0.f;
#pragma unroll
    for (int c = 0; c < 4; ++c) st.o[c] = (f32x4){0.f, 0.f, 0.f, 0.f}; }
__device__ __forceinline__ void attn_store(const AState& st, bf16* orow  , int lane) {
    const float l = sum4g(st.l);
    const float il = 1.0f / l; const int g = lane >> 4;
    if (orow) {
#pragma unroll
        for (int c = 0; c < 4; ++c) { u32x2_t w; w.x = cvtpk(st.o[c][0] * il, st.o[c][1] * il); w.y = cvtpk(st.o[c][2] * il, st.o[c][3] * il); *(u32x2_t*)(orow + 16 * c + 4 * g) = w; } }
}
constexpr int KP = 144, VP = 160, KT_ROWS = 256;
constexpr int KT_OFF = 0, VT_OFF = KT_ROWS * KP, SV_OFF = VT_OFF + KT_ROWS * VP;
static_assert(SV_OFF + 8 * VTILE <= RING_BYTES, "attention LDS map");
struct Chunk { int b, h, rs, c, ci, p; };
__device__ __forceinline__ Chunk chunk_decode(int bh  , int e  ) {
    Chunk k; k.b = bh >> 3; k.h = bh & 7;
    if (e < 16) { k.p = 0; k.rs = 0; k.c = 0; k.ci = e; }
    else if (e < 32) { k.p = 1; k.rs = 2; k.c = (e - 16) >> 2; k.ci = (e - 16) & 3; }
    else { k.p = 2; k.rs = 4; k.c = e - 32; k.ci = 0; }
    return k;
}
struct ChunkRegs { bf16x8 k[2], v[2]; };
__device__ __forceinline__ void chunk_load(ChunkRegs& R, const Chunk& k, int j0  , const bf16* Kb, const bf16* Vb, int tid) {
    const int j = j0 + (tid >> 2); const size_t off = ((size_t)(k.b * NH + k.h) * SEQ + (j << k.rs) + k.c) * 64 + 16 * (tid & 3);
#pragma unroll
    for (int i = 0; i < 2; ++i) { R.k[i] = *(const bf16x8*)(Kb + off + 8 * i); R.v[i] = *(const bf16x8*)(Vb + off + 8 * i); }
}
__device__ __forceinline__ void chunk_store(const ChunkRegs& R, LAS unsigned char* ring, int half, int tid) {
    const int rowp = half * 128 + (tid >> 2), q = tid & 3;
#pragma unroll
    for (int i = 0; i < 2; ++i) { *(LAS bf16x8*)(ring + KT_OFF + rowp * KP + q * 32 + 16 * i) = R.k[i]; *(LAS bf16x8*)(ring + VT_OFF + rowp * VP + q * 32 + 16 * i) = R.v[i]; }
}
template <bool EDGE> __device__ __forceinline__ void chunk_step(AState& st, int kb, int own, int qk, float sl2r, const bf16x8 (&qf)[2], const LAS unsigned char* kp, const LAS unsigned char* vp, int g) {
    f32x4 s[2]; int rowb[2];
    const float base = -sl2r * (float)(qk - 16 * kb - 4 * g);
#pragma unroll
    for (int t = 0; t < 2; ++t) { const int kk0 = 16 * (kb + t); rowb[t] = ((((kk0 >> 7) + own + 1) & 1) << 7) + (kk0 & 127);
        const LAS unsigned char* r = kp + rowb[t] * KP;
        const bf16x8 k0 = *(const LAS bf16x8*)r, k1 = *(const LAS bf16x8*)(r + 64);
        f32x4 c0;
#pragma unroll
        for (int i = 0; i < 4; ++i) c0[i] = base + sl2r * (float)(16 * t + i);
        s[t] = __builtin_amdgcn_mfma_f32_16x16x32_bf16(k0, qf[0], c0, 0, 0, 0);
        s[t] = __builtin_amdgcn_mfma_f32_16x16x32_bf16(k1, qf[1], s[t], 0, 0, 0); }
    float mx = -INFINITY;
#pragma unroll
    for (int t = 0; t < 2; ++t)
#pragma unroll
        for (int i = 0; i < 4; ++i) { float x = s[t][i];
            if (EDGE) { const int d = qk - (16 * (kb + t) + 4 * g + i); x = ((unsigned)d <= 128u) ? x : -INFINITY; s[t][i] = x; }
            mx = fmaxf(mx, x); }
    mx = max4g(mx);
    const float mn = fmaxf(st.m, mx), alpha = __builtin_amdgcn_exp2f(st.m - mn); st.m = mn;
    float ps = 0.f;
#pragma unroll
    for (int t = 0; t < 2; ++t)
#pragma unroll
        for (int i = 0; i < 4; ++i) { const float pe = __builtin_amdgcn_exp2f(s[t][i] - mn); s[t][i] = pe; ps += pe; }
    st.l = st.l * alpha + ps;
#pragma unroll
    for (int c = 0; c < 4; ++c) st.o[c] = st.o[c] * alpha;
    const bf16x8 pf = cvt8(s[0], s[1]);
#pragma unroll
    for (int c = 0; c < 4; ++c) {
        const v4i16_t a = __builtin_amdgcn_ds_read_tr16_b64_v4i16((LAS v4i16_t*)(vp + rowb[0] * VP + 32 * c));
        const v4i16_t bq = __builtin_amdgcn_ds_read_tr16_b64_v4i16((LAS v4i16_t*)(vp + rowb[1] * VP + 32 * c));
        const bf16x8 vf = (bf16x8){a[0], a[1], a[2], a[3], bq[0], bq[1], bq[2], bq[3]};
        st.o[c] = __builtin_amdgcn_mfma_f32_16x16x32_bf16(vf, pf, st.o[c], 0, 0, 0);
    }
}
__device__ __forceinline__ void chunk_compute(Frame& F, const Chunk& k, int own, const bf16x8 (&qf)[2], LAS unsigned char* ring) {
    const int lane = F.lane, c15 = lane & 15, g = lane >> 4, w = F.wave;
    const size_t row = (size_t)(k.b * SEQ + (((128 * k.ci + 16 * w + c15) << k.rs) + k.c));
    const size_t hrow = (size_t)(k.b * NH + k.h) * SEQ + (size_t)(((128 * k.ci + 16 * w + c15) << k.rs) + k.c);
    bf16* prow = (bf16*)(F.ws + WS_OP) + hrow * 64; float* plse = (float*)(F.ws + WS_LSE) + hrow;
    u32x2_t pv[4]; float plv = 0.f;
#pragma unroll
    for (int c = 0; c < 4; ++c) { pv[c].x = 0u; pv[c].y = 0u; }
    if (k.p > 0) {
#pragma unroll
        for (int c = 0; c < 4; ++c) pv[c] = *(const u32x2_t*)(prow + 16 * c + 4 * g);
        plv = *plse; }
    AState sx, sy; attn_init(sx); attn_init(sy);
    const float sl2r = __builtin_amdgcn_exp2f(-(float)(k.h + 1)) * 1.4426950408889634f * (float)(1 << k.rs);
    const int blk_lo = (k.ci == 0) ? 8 : w, blk_hi = w + 8;
    const int qk = 16 * w + c15 + 128;
    const LAS unsigned char* kp = ring + KT_OFF + c15 * KP + 16 * g;
    const LAS unsigned char* vp = ring + VT_OFF + (4 * g + (c15 >> 2)) * VP + (lane & 3) * 8;
    int kb = blk_lo;
    if (k.ci != 0) {
        chunk_step<true>(sx, w, own, qk, sl2r, qf, kp, vp, g); chunk_step<false>(sy, w + 2, own, qk, sl2r, qf, kp, vp, g);
        chunk_step<false>(sx, w + 4, own, qk, sl2r, qf, kp, vp, g); chunk_step<false>(sy, w + 6, own, qk, sl2r, qf, kp, vp, g);
        chunk_step<true>(sx, w + 8, own, qk, sl2r, qf, kp, vp, g);
    } else {
        for (; kb + 2 <= blk_hi; kb += 4) { chunk_step<true>(sx, kb, own, qk, sl2r, qf, kp, vp, g); chunk_step<true>(sy, kb + 2, own, qk, sl2r, qf, kp, vp, g); }
        if (kb <= blk_hi) chunk_step<true>(sx, kb, own, qk, sl2r, qf, kp, vp, g);
    }
    AState st; st.m = fmaxf(sx.m, sy.m); const float ax = __builtin_amdgcn_exp2f(sx.m - st.m), ay = __builtin_amdgcn_exp2f(sy.m - st.m);
    st.l = sx.l * ax + sy.l * ay;
#pragma unroll
    for (int c = 0; c < 4; ++c) st.o[c] = sx.o[c] * ax + sy.o[c] * ay;
    const float l = sum4g(st.l);
    float lse = st.m + __builtin_amdgcn_logf(l), wo = 1.0f / l, wp = 0.f;
    if (k.p > 0) { const float mx = fmaxf(plv, lse); const float ea = __builtin_amdgcn_exp2f(plv - mx), eb = __builtin_amdgcn_exp2f(lse - mx), inv = 1.0f / (ea + eb);
        wp = ea * inv; wo = eb * inv / l; lse = mx + __builtin_amdgcn_logf(ea + eb); }
    bf16* dst = k.p == 2 ? (bf16*)(F.ws + WS_MIX) + row * DM + k.h * 64 : prow;
#pragma unroll
    for (int c = 0; c < 4; ++c) { const unsigned lo = pv[c].x, hi = pv[c].y;
        const float o0 = st.o[c][0] * wo + wp * __uint_as_float(lo << 16), o1 = st.o[c][1] * wo + wp * __uint_as_float(lo & 0xffff0000u), o2 = st.o[c][2] * wo + wp * __uint_as_float(hi << 16), o3 = st.o[c][3] * wo + wp * __uint_as_float(hi & 0xffff0000u);
        u32x2_t wv; wv.x = cvtpk(o0, o1); wv.y = cvtpk(o2, o3); *(u32x2_t*)(dst + 16 * c + 4 * g) = wv; }
    if (g == 0 && k.p < 2) *plse = lse;
}
constexpr int SSTEPS = 29;
struct SDesc { int rs, cr, kb, qsub, dmin, mt; float sl2r; };
__device__ __forceinline__ SDesc sample_desc(int s, int c15, float slope2) {
    SDesc d; const int NEGQ = -(1 << 20);
    if (s < 5) { d.rs = 0; d.cr = 0; d.kb = 120 + 2 * s; d.qsub = c15 < DS ? 2048 + c15 : NEGQ; d.sl2r = slope2; d.dmin = 0; d.mt = 2; }
    else if (s < 17) { const int q = (s - 5) / 3, st = (s - 5) - 3 * q; d.rs = 2; d.cr = q; d.kb = 24 + 2 * st; d.qsub = c15 == q ? 512 : NEGQ; d.sl2r = slope2 * 4.0f; d.dmin = 33; d.mt = 1; }
    else { const int q = (s - 17) / 3, st = (s - 17) - 3 * q; d.rs = 4; d.cr = q & 3; d.kb = 2 * st; d.qsub = (s < SSTEPS && c15 == q) ? 128 : NEGQ; d.sl2r = slope2 * 16.0f; d.dmin = 33; d.mt = 0; }
    return d;
}
__device__ __forceinline__ void attn_prompt_role(Frame& F, int bh) {
    LAS unsigned char* ring = F.lds + RING_OFF;
    const bf16* Qb = (const bf16*)(F.ws + WS_Q); const bf16* Kb = (const bf16*)(F.ws + WS_Q + QKVU_STRIDE); const bf16* Vb = (const bf16*)(F.ws + WS_Q + 2 * QKVU_STRIDE);
    const int lane = F.lane, c15 = lane & 15, g = lane >> 4;
    __syncthreads();
    for (int i = F.tid; i < SV_OFF / 4; i += NWAVES * 64) ((LAS unsigned*)(ring))[i] = 0u;
    ChunkRegs R0, R1; Chunk c0 = chunk_decode(bh, 0), c1 = chunk_decode(bh, 1); chunk_load(R0, c0, 128 * c0.ci, Kb, Vb, F.tid); chunk_load(R1, c1, 128 * c1.ci, Kb, Vb, F.tid);
#define CHUNK_ITER(E, RR, CC, OWN) do { \
        bf16x8 qf[2]; \
        { const size_t qrow = (size_t)(CC.b * NH + CC.h) * SEQ + (((128 * CC.ci + 16 * F.wave + c15) << CC.rs) + CC.c); \
          const bf16* qp = Qb + qrow * 64 + 8 * g; qf[0] = *(const bf16x8*)qp; qf[1] = *(const bf16x8*)(qp + 32); } \
        if ((E) == 16 || (E) == 32) { asm volatile("s_waitcnt vmcnt(0)" ::: "memory"); __syncthreads(); __builtin_amdgcn_fence(__ATOMIC_ACQUIRE, "agent"); asm volatile("s_waitcnt vmcnt(0)" ::: "memory"); } \
        __syncthreads(); \
        chunk_store(RR, ring, (OWN), F.tid); \
        __syncthreads(); \
        const Chunk now = CC; \
        if ((E) + 2 < 48) { CC = chunk_decode(bh, (E) + 2); chunk_load(RR, CC, 128 * CC.ci, Kb, Vb, F.tid); } \
        chunk_compute(F, now, (OWN), qf, ring); } while (0)
#pragma unroll 1
    for (int e = 0; e < 48; e += 2) { CHUNK_ITER(e, R0, c0, 0); CHUNK_ITER(e + 1, R1, c1, 1); }
#undef CHUNK_ITER
}
__device__ __forceinline__ void attn_sample_role(Frame& F, int bS) {
    const bf16* Qb = (const bf16*)(F.ws + WS_Q);
    const float* Kc = F.in[2]; const float* Vc = F.in[3]; const float* Kn = F.out + O_KS; const float* Vn = F.out + O_VS;
    const int lane = F.lane, c15 = lane & 15, g = lane >> 4, hS = F.wave;
    LAS unsigned char* vl = F.lds + RING_OFF + SV_OFF + F.wave * VTILE;
    const float slope2S = __builtin_amdgcn_exp2f(-(float)(hS + 1)) * 1.4426950408889634f;
    {
        bf16x8 qs[2];
        { const bf16* qptr = Qb + ((size_t)(MP + bS * DS + (c15 & 3)) * AW + hS * 64 + 8 * g); qs[0] = *(const bf16x8*)qptr; qs[1] = *(const bf16x8*)(qptr + 32); }
        AState sst; attn_init(sst);
        KVRaw<true> cur, nxt;
        { const SDesc sd = sample_desc(0, c15, slope2S); kv_load<true>(cur, Kc, Kn, Vc, Vn, sd.kb, sd.rs, sd.cr, bS, hS, lane); }
#pragma unroll 1
        for (int s = 0; s < SSTEPS; ++s) {
            const SDesc sd = sample_desc(s, c15, slope2S), sn = sample_desc(s + 1, c15, slope2S);
            kv_load<true>(nxt, Kc, Kn, Vc, Vn, sn.kb, sn.rs, sn.cr, bS, hS, lane);
            attn_step<true>(sst, cur, qs, sd.kb, sd.qsub, sd.sl2r, sd.dmin, sd.mt, vl, lane);
            cur = nxt;
        }
        attn_store(sst, c15 < DS ? (bf16*)(F.ws + WS_MIX) + ((size_t)(MP + bS * DS + c15) * DM + hS * 64) : nullptr, lane);
    }
}
template <int K> __device__ __forceinline__ float dpp_ror(float v) { return __builtin_bit_cast(float, __builtin_amdgcn_update_dpp(0, __builtin_bit_cast(int, v), 0x120 + K, 0xf, 0xf, false)); }
template <int K> __device__ __forceinline__ void win_step(float (&S)[8], float (&P)[8], int c15) {
#pragma unroll
    for (int e = 0; e < 8; ++e) { const float y = c15 >= 16 - K ? P[e] : S[e]; const float s2 = S[e] + dpp_ror<K>(y); const float p2 = P[e] + dpp_ror<K>(P[e]); S[e] = s2; P[e] = p2; }
}
__device__ __forceinline__ void pool_mma_store(const bf16* WP, const float* PS, bf16* MIX, f32x4 (&acc)[8], const bf16x8 (&df)[4], int gi, int row, int c15, int g) {
#pragma unroll
    for (int ks = 0; ks < 4; ++ks)
#pragma unroll
        for (int nt = 0; nt < 8; ++nt) { const bf16x8 wf = *(const bf16x8*)(WP + ((size_t)(gi * 128 + 16 * nt + c15) * 128 + 32 * ks + 8 * g));
            acc[nt] = __builtin_amdgcn_mfma_f32_16x16x32_bf16(wf, df[ks], acc[nt], 0, 0, 0); }
#pragma unroll
    for (int nt = 0; nt < 8; ++nt) { const int col = 128 * gi + 16 * nt + 4 * g; const f32x4 sc = *(const f32x4*)(PS + col); const f32x4 o = acc[nt] * sc;
        u32x2_t wv; wv.x = cvtpk(o[0], o[1]); wv.y = cvtpk(o[2], o[3]); *(u32x2_t*)(MIX + (size_t)row * DM + 512 + col) = wv; }
}
template <int NTL> __device__ __forceinline__ void pool_group_prompt(Frame& F, int T0, int TS, const int GI) {
    const int lane = F.lane, c15 = lane & 15, g = lane >> 4;
    const bf16* U = (const bf16*)(F.ws + WS_Q + 3 * QKVU_STRIDE); const bf16* WP = (const bf16*)(F.ws + WS_WPOOL); const float* PS = F.in[11]; bf16* MIX = (bf16*)(F.ws + WS_MIX);
    const int w = 2 << GI;
    bf16x8 xc[NTL][4], xp[NTL][4];
#pragma unroll
    for (int tl = 0; tl < NTL; ++tl) { const int T = T0 + tl * TS, row = T * 16 + c15; const bool has_prev = ((T * 16) & (SEQ - 1)) != 0;
#pragma unroll
        for (int ks = 0; ks < 4; ++ks) { const int ch = 128 * GI + 32 * ks + 8 * g; xc[tl][ks] = *(const bf16x8*)(U + (size_t)row * AW + ch);
            xp[tl][ks] = (bf16x8){0, 0, 0, 0, 0, 0, 0, 0}; if (has_prev) xp[tl][ks] = *(const bf16x8*)(U + (size_t)(row - 16) * AW + ch); } }
    bf16x8 df[NTL][4];
#pragma unroll
    for (int tl = 0; tl < NTL; ++tl) { const int t = ((T0 + tl * TS) * 16 + c15) & (SEQ - 1); const float ic = 1.0f / (float)(w < t + 1 ? w : t + 1);
#pragma unroll
        for (int ks = 0; ks < 4; ++ks) {
            float S[8], P[8], cur[8];
#pragma unroll
            for (int e = 0; e < 8; ++e) { cur[e] = bf2f((unsigned short)xc[tl][ks][e]); S[e] = cur[e]; P[e] = bf2f((unsigned short)xp[tl][ks][e]); }
            win_step<1>(S, P, c15);
            if (GI >= 1) win_step<2>(S, P, c15);
            if (GI >= 2) win_step<4>(S, P, c15);
            if (GI >= 3) win_step<8>(S, P, c15);
            f32x4 d0, d1;
#pragma unroll
            for (int e = 0; e < 4; ++e) { d0[e] = S[e] * ic - cur[e]; d1[e] = S[4 + e] * ic - cur[4 + e]; }
            df[tl][ks] = cvt8(d0, d1);
        } }
    f32x4 acc[NTL][8];
#pragma unroll
    for (int tl = 0; tl < NTL; ++tl)
#pragma unroll
        for (int nt = 0; nt < 8; ++nt) acc[tl][nt] = (f32x4){0.f, 0.f, 0.f, 0.f};
#pragma unroll
    for (int ks = 0; ks < 4; ++ks)
#pragma unroll
        for (int nt = 0; nt < 8; ++nt) { const bf16x8 wf = *(const bf16x8*)(WP + ((size_t)(GI * 128 + 16 * nt + c15) * 128 + 32 * ks + 8 * g));
#pragma unroll
            for (int tl = 0; tl < NTL; ++tl) acc[tl][nt] = __builtin_amdgcn_mfma_f32_16x16x32_bf16(wf, df[tl][ks], acc[tl][nt], 0, 0, 0); }
#pragma unroll
    for (int nt = 0; nt < 8; ++nt) { const int col = 128 * GI + 16 * nt + 4 * g; const f32x4 sc = *(const f32x4*)(PS + col);
#pragma unroll
        for (int tl = 0; tl < NTL; ++tl) { const f32x4 o = acc[tl][nt] * sc; const int row = (T0 + tl * TS) * 16 + c15;
            u32x2_t wv; wv.x = cvtpk(o[0], o[1]); wv.y = cvtpk(o[2], o[3]); *(u32x2_t*)(MIX + (size_t)row * DM + 512 + col) = wv; } }
}
constexpr int WPP = 272;
template <int NTL> __device__ __forceinline__ void pool_tiles_wg(Frame& F, int T0, int TS) {
    const int lane = F.lane, c15 = lane & 15, g = lane >> 4;
    const bf16* U = (const bf16*)(F.ws + WS_Q + 3 * QKVU_STRIDE); const bf16* WP = (const bf16*)(F.ws + WS_WPOOL); const float* PS = F.in[11]; bf16* MIX = (bf16*)(F.ws + WS_MIX);
    LAS unsigned char* wl = F.lds + RING_OFF;
    static_assert(2 * 128 * WPP <= SV_OFF, "pool weight staging vs sample staging");
    const int wrow = F.tid >> 2, wq = F.tid & 3;
    bf16x8 wr[4];
#pragma unroll
    for (int i = 0; i < 4; ++i) wr[i] = *(const bf16x8*)(WP + (size_t)wrow * 128 + 32 * wq + 8 * i);
#pragma unroll 1
    for (int GI = 0; GI < 4; ++GI) {
        const int w = 2 << GI;
        bf16x8 xc[NTL][4], xp[NTL][4];
#pragma unroll
        for (int tl = 0; tl < NTL; ++tl) { const int T = T0 + tl * TS, row = T * 16 + c15; const bool has_prev = ((T * 16) & (SEQ - 1)) != 0;
#pragma unroll
            for (int ks = 0; ks < 4; ++ks) { const int ch = 128 * GI + 32 * ks + 8 * g; xc[tl][ks] = *(const bf16x8*)(U + (size_t)row * AW + ch);
                xp[tl][ks] = (bf16x8){0, 0, 0, 0, 0, 0, 0, 0}; if (has_prev) xp[tl][ks] = *(const bf16x8*)(U + (size_t)(row - 16) * AW + ch); } }
        LAS unsigned char* wb = wl + (GI & 1) * 128 * WPP;
#pragma unroll
        for (int i = 0; i < 4; ++i) *(LAS bf16x8*)(wb + wrow * WPP + 64 * wq + 16 * i) = wr[i];
        __syncthreads();
        if (GI < 3) {
#pragma unroll
            for (int i = 0; i < 4; ++i) wr[i] = *(const bf16x8*)(WP + (size_t)((GI + 1) * 128 + wrow) * 128 + 32 * wq + 8 * i); }
        bf16x8 df[NTL][4];
#pragma unroll
        for (int tl = 0; tl < NTL; ++tl) { const int t = ((T0 + tl * TS) * 16 + c15) & (SEQ - 1); const float ic = 1.0f / (float)(w < t + 1 ? w : t + 1);
#pragma unroll
            for (int ks = 0; ks < 4; ++ks) {
                float S[8], P[8], cur[8];
#pragma unroll
                for (int e = 0; e < 8; ++e) { cur[e] = bf2f((unsigned short)xc[tl][ks][e]); S[e] = cur[e]; P[e] = bf2f((unsigned short)xp[tl][ks][e]); }
                win_step<1>(S, P, c15);
                if (GI >= 1) win_step<2>(S, P, c15);
                if (GI >= 2) win_step<4>(S, P, c15);
                if (GI >= 3) win_step<8>(S, P, c15);
                f32x4 d0, d1;
#pragma unroll
                for (int e = 0; e < 4; ++e) { d0[e] = S[e] * ic - cur[e]; d1[e] = S[4 + e] * ic - cur[4 + e]; }
                df[tl][ks] = cvt8(d0, d1);
            } }
        f32x4 acc[NTL][8];
#pragma unroll
        for (int tl = 0; tl < NTL; ++tl)
#pragma unroll
            for (int nt = 0; nt < 8; ++nt) acc[tl][nt] = (f32x4){0.f, 0.f, 0.f, 0.f};
#pragma unroll
        for (int ks = 0; ks < 4; ++ks)
#pragma unroll
            for (int nt = 0; nt < 8; ++nt) { const bf16x8 wf = *(const LAS bf16x8*)(wb + (16 * nt + c15) * WPP + (32 * ks + 8 * g) * 2);
#pragma unroll
                for (int tl = 0; tl < NTL; ++tl) acc[tl][nt] = __builtin_amdgcn_mfma_f32_16x16x32_bf16(wf, df[tl][ks], acc[tl][nt], 0, 0, 0); }
#pragma unroll
        for (int nt = 0; nt < 8; ++nt) { const int col = 128 * GI + 16 * nt + 4 * g; const f32x4 sc = *(const f32x4*)(PS + col);
#pragma unroll
            for (int tl = 0; tl < NTL; ++tl) { const f32x4 o = acc[tl][nt] * sc; const int row = (T0 + tl * TS) * 16 + c15;
                u32x2_t wv; wv.x = cvtpk(o[0], o[1]); wv.y = cvtpk(o[2], o[3]); *(u32x2_t*)(MIX + (size_t)row * DM + 512 + col) = wv; } }
    }
    __syncthreads();
}
__device__ __forceinline__ void pool_sample_item(Frame& F, int T, int gi) {
    const int lane = F.lane, c15 = lane & 15, g = lane >> 4, row = T * 16 + c15, t = (row - MP) & 3, bs = (row - MP) >> 2;
    const bf16* U = (const bf16*)(F.ws + WS_Q + 3 * QKVU_STRIDE); const float* SP = F.in[4];
    const int w = 2 << gi; const float ic = 1.0f / (float)w;
    bf16x8 df[4];
#pragma unroll
    for (int ks = 0; ks < 4; ++ks) df[ks] = (bf16x8){0, 0, 0, 0, 0, 0, 0, 0};
#pragma unroll 1
    for (int ks = 0; ks < 4; ++ks) {
        const int ch = 128 * gi + 32 * ks + 8 * g;
        float S[8], cur[8];
#pragma unroll
        for (int e = 0; e < 8; ++e) { S[e] = 0.f; cur[e] = 0.f; }
#pragma unroll 1
        for (int i0 = 0; i0 < w; i0 += 8) {
            bf16x8 xu[8]; f32x4 x0[8], x1[8];
#pragma unroll
            for (int u = 0; u < 8; ++u) { const int i = i0 + u < w ? i0 + u : w - 1; const int idx = t - i, iu = idx < 0 ? 0 : idx, is = idx >= 0 ? 14 : 15 + idx;
                xu[u] = *(const bf16x8*)(U + (size_t)(row - t + iu) * AW + ch);
                const float* sp = SP + ((size_t)bs * 15 + is) * 512 + ch; x0[u] = *(const f32x4*)sp; x1[u] = *(const f32x4*)(sp + 4); }
            __builtin_amdgcn_sched_barrier(0);
#pragma unroll
            for (int u = 0; u < 8; ++u) { const int i = i0 + u, idx = t - i; const bool use = i < w;
#pragma unroll
                for (int e = 0; e < 8; ++e) { const float vs = e < 4 ? x0[u][e & 3] : x1[u][e & 3]; float v = idx >= 0 ? bf2f((unsigned short)xu[u][e]) : vs; v = use ? v : 0.f; S[e] += v; if (i == 0) cur[e] = v; } }
        }
        f32x4 d0, d1;
#pragma unroll
        for (int e = 0; e < 4; ++e) { d0[e] = S[e] * ic - cur[e]; d1[e] = S[4 + e] * ic - cur[4 + e]; }
        const bf16x8 dd = cvt8(d0, d1); if (ks == 0) df[0] = dd; else if (ks == 1) df[1] = dd; else if (ks == 2) df[2] = dd; else df[3] = dd;
    }
    f32x4 acc[8];
#pragma unroll
    for (int nt = 0; nt < 8; ++nt) acc[nt] = (f32x4){0.f, 0.f, 0.f, 0.f};
    pool_mma_store((const bf16*)(F.ws + WS_WPOOL), F.in[11], (bf16*)(F.ws + WS_MIX), acc, df, gi, row, c15, g);
}
template <int NTL> __device__ __forceinline__ void pool_tiles(Frame& F, int T0, int TS) {
#pragma unroll 1
    for (int gi = 0; gi < 4; ++gi) pool_group_prompt<NTL>(F, T0, TS, gi);
}
__device__ __forceinline__ void p2_attn(Frame& F) {
    const int role = F.vcu & 1, idx = F.vcu >> 1, nidx = F.G >> 1;
    if (role == 0) { for (int bh = idx; bh < NB * NH; bh += nidx) attn_prompt_role(F, bh); }
    else {
        for (int b = idx; b < DB; b += nidx) attn_sample_role(F, b);
        const int gw = idx * NWAVES + F.wave, NGW = nidx * NWAVES;
        if (2 * NGW == MP / 16) { __syncthreads(); pool_tiles_wg<2>(F, gw, NGW); } else for (int T = gw; T < MP / 16; T += NGW) pool_tiles<1>(F, T, 0);
        for (int it = gw; it < 128 * 8; it += NGW) if ((it & 7) == 0) pool_sample_item(F, MP / 16 + (it >> 5), (it >> 3) & 3);
    }
}
template <int NTW, int KS, int UNR, class BR> __device__ __forceinline__ void mini_mma(const bf16* A, int K, const bf16* Bt, const BR& br, int arow, LAS float* tile, int pitch, int wave, int lane) {
    const int c15 = lane & 15, g = lane >> 4, ks = wave % KS, cg = wave / KS;
    const int kbeg = ks * (K / KS), ksteps = K / KS / 32, joff = cg * 16 * NTW;
    const bf16* ap = A + (size_t)(arow + c15) * K + kbeg + 8 * g;
    const bf16* bp[NTW];
#pragma unroll
    for (int nt = 0; nt < NTW; ++nt) bp[nt] = Bt + (size_t)br(joff + nt * 16 + c15) * K + kbeg + 8 * g;
    f32x4 acc[4][NTW];
#pragma unroll
    for (int rb = 0; rb < 4; ++rb)
#pragma unroll
        for (int nt = 0; nt < NTW; ++nt) acc[rb][nt] = (f32x4){0.f, 0.f, 0.f, 0.f};
    for (int s0 = 0; s0 < ksteps; s0 += UNR) {
        bf16x8 a[UNR][4], b[UNR][NTW];
#pragma unroll
        for (int u = 0; u < UNR; ++u) { const int s = s0 + u < ksteps ? s0 + u : ksteps - 1;
#pragma unroll
            for (int rb = 0; rb < 4; ++rb) a[u][rb] = *(const bf16x8*)(ap + (size_t)(16 * rb) * K + 32 * s);
#pragma unroll
            for (int nt = 0; nt < NTW; ++nt) b[u][nt] = *(const bf16x8*)(bp[nt] + 32 * s); }
        __builtin_amdgcn_sched_barrier(0);
#pragma unroll
        for (int u = 0; u < UNR; ++u) if (s0 + u < ksteps) {
#pragma unroll
            for (int rb = 0; rb < 4; ++rb)
#pragma unroll
                for (int nt = 0; nt < NTW; ++nt) acc[rb][nt] = __builtin_amdgcn_mfma_f32_16x16x32_bf16(b[u][nt], a[u][rb], acc[rb][nt], 0, 0, 0); }
        __builtin_amdgcn_sched_barrier(0);
    }
#pragma unroll
    for (int rb = 0; rb < 4; ++rb)
#pragma unroll
        for (int nt = 0; nt < NTW; ++nt) *(LAS f32x4*)(tile + (ks * 64 + 16 * rb + c15) * pitch + joff + 16 * nt + 4 * g) = acc[rb][nt];
}
constexpr int MINI_STG = 36864, MINI_TILE_OFF = 2 * MINI_STG, MINI_TILE_OFF_WIDE = 102400;
constexpr int MINI_UNUSED_ = 0;
template <int NT, int KC, class BR> __device__ __forceinline__ void mini_mma2(Frame& F, const bf16* A, int K, const bf16* Bt, const BR& br, int arow, LAS float* tile, int pitch) {
    constexpr int MKP = 2 * KC + 16, PPR = KC / 8;
    constexpr int STGB = (64 + 16 * NT) * MKP;
    static_assert(NT % 2 == 0 && 2 * STGB <= (KC == 256 ? MINI_TILE_OFF_WIDE : MINI_TILE_OFF), "mini_mma2 geometry");
    constexpr int NA = 64 * PPR, NLA = NA / 512, NB = 16 * NT * PPR, NLB = (NB + 511) / 512;
    const int lane = F.lane, c15 = lane & 15, g = lane >> 4, w = F.wave, rb = w & 3, nt0 = (w >> 2) * (NT / 2);
    LAS unsigned char* stg = F.lds + RING_OFF;
    const bf16* ap[NLA]; int aoff[NLA]; const bf16* bp[NLB]; int boff[NLB];
#pragma unroll
    for (int i = 0; i < NLA; ++i) { const int idx = F.tid + 512 * i, r = idx / PPR, pc = idx % PPR; ap[i] = A + (size_t)(arow + r) * K + 8 * pc; aoff[i] = r * MKP + 16 * pc; }
#pragma unroll
    for (int i = 0; i < NLB; ++i) { int idx = F.tid + 512 * i; if (idx >= NB) idx = NB - 1; const int r = idx / PPR, pc = idx % PPR; bp[i] = Bt + (size_t)br(r) * K + 8 * pc; boff[i] = (64 + r) * MKP + 16 * pc; }
    bf16x8 ra0[NLA], rb0[NLB], ra1[NLA], rb1[NLB];
    const int nch = K / KC;
#define MINI_LOAD(RA, RB, C) do { _Pragma("unroll") for (int i = 0; i < NLA; ++i) RA[i] = *(const bf16x8*)(ap[i] + KC * (C)); _Pragma("unroll") for (int i = 0; i < NLB; ++i) RB[i] = *(const bf16x8*)(bp[i] + KC * (C)); } while (0)
#define MINI_HALF(RA, RB, SB, CN) do { \
        _Pragma("unroll") for (int i = 0; i < NLA; ++i) *(LAS bf16x8*)((SB) + aoff[i]) = RA[i]; \
        _Pragma("unroll") for (int i = 0; i < NLB; ++i) if (F.tid + 512 * i < NB) *(LAS bf16x8*)((SB) + boff[i]) = RB[i]; \
        if ((CN) < nch) MINI_LOAD(RA, RB, (CN)); \
        __syncthreads(); \
        _Pragma("unroll") for (int ks = 0; ks < KC / 32; ++ks) { const bf16x8 af = *(const LAS bf16x8*)((SB) + (16 * rb + c15) * MKP + (32 * ks + 8 * g) * 2); \
            _Pragma("unroll") for (int n = 0; n < NT / 2; ++n) { const bf16x8 bf = *(const LAS bf16x8*)((SB) + (64 + 16 * (nt0 + n) + c15) * MKP + (32 * ks + 8 * g) * 2); \
                acc[n] = __builtin_amdgcn_mfma_f32_16x16x32_bf16(bf, af, acc[n], 0, 0, 0); } } } while (0)
    MINI_LOAD(ra0, rb0, 0); if (nch > 1) MINI_LOAD(ra1, rb1, 1);
    f32x4 acc[NT / 2];
#pragma unroll
    for (int n = 0; n < NT / 2; ++n) acc[n] = (f32x4){0.f, 0.f, 0.f, 0.f};
    __syncthreads();
#pragma unroll 1
    for (int c = 0; c < nch; c += 2) {
        MINI_HALF(ra0, rb0, stg, c + 2);
        if (c + 1 < nch) MINI_HALF(ra1, rb1, stg + STGB, c + 3);
    }
#undef MINI_LOAD
#undef MINI_HALF
#pragma unroll
    for (int n = 0; n < NT / 2; ++n) *(LAS f32x4*)(tile + (16 * rb + c15) * pitch + 16 * (nt0 + n) + 4 * g) = acc[n];
}
struct BrLin { int c0; __device__ __forceinline__ int operator()(int j) const { return c0 + j; } };
struct BrHead { int base; __device__ __forceinline__ int operator()(int j) const { return base + 128 * (j >> 5) + (j & 31); } };
struct BrUp { int ch0; __device__ __forceinline__ int operator()(int j) const { const int half = j >= 96 ? 1 : 0; int ch = ch0 + j - 96 * half; ch = ch > FF - 1 ? FF - 1 : ch; return 256 * (ch >> 7) + 128 * half + (ch & 127); } };
__device__ __forceinline__ void mini_inproj(Frame& F, int tl) {
    LAS float* tile = (LAS float*)(F.lds + RING_OFF + MINI_TILE_OFF); constexpr int PT = 68;
    const int rg = tl >> 5, hd = tl & 31, type = hd >> 3, h = hd & 7;
    BrHead br{256 * (type * 2 + (h >> 2)) + 32 * (h & 3)};
    mini_mma2<4, 128>(F, (const bf16*)(F.ws + WS_XN), DM, (const bf16*)(F.ws + WS_WIN), br, MP + 64 * rg, tile, PT);
    __syncthreads();
    const int r = F.tid >> 3, d0 = 8 * (F.tid & 7), row = 64 * rg + r;
    float v[8];
    { const float rx = ((const float*)(F.ws + WS_RRX))[MP + row];
#pragma unroll
      for (int e = 0; e < 8; ++e) v[e] = tile[r * PT + d0 + e] * rx; }
    if (type < 2) { float ss = 0.f;
#pragma unroll
        for (int e = 0; e < 8; ++e) ss += v[e] * v[e];
        ss += __shfl_xor(ss, 1); ss += __shfl_xor(ss, 2); ss += __shfl_xor(ss, 4);
        const float rr = 1.0f / sqrtf(ss * (1.0f / 64.0f) + EPS) * (type == 0 ? QSCALE : 1.0f); const float* gs = (type == 0 ? F.in[8] : F.in[9]) + h * 64 + d0;
#pragma unroll
        for (int e = 0; e < 8; ++e) v[e] = v[e] * rr * gs[e]; }
    u32x4_t wv; wv.x = cvtpk(v[0], v[1]); wv.y = cvtpk(v[2], v[3]); wv.z = cvtpk(v[4], v[5]); wv.w = cvtpk(v[6], v[7]);
    *(u32x4_t*)((bf16*)(F.ws + WS_Q + (size_t)type * QKVU_STRIDE) + (size_t)(MP + row) * AW + h * 64 + d0) = wv;
    float* o = nullptr;
    if (type == 1) o = F.out + O_KS + (size_t)row * AW + h * 64 + d0; else if (type == 2) o = F.out + O_VS + (size_t)row * AW + h * 64 + d0;
    else if (type == 3) o = F.out + O_PS + ((size_t)(row >> 2) * 15 + 11 + (row & 3)) * 512 + h * 64 + d0;
    if (o) { *(f32x4*)o = (f32x4){v[0], v[1], v[2], v[3]}; *(f32x4*)(o + 4) = (f32x4){v[4], v[5], v[6], v[7]}; }
    __syncthreads();
}
__device__ __forceinline__ void mini_outproj(Frame& F, int tl) {
    LAS float* tile = (LAS float*)(F.lds + RING_OFF + MINI_TILE_OFF_WIDE); constexpr int PT = 36;
    const int rg = tl >> 5, cg = tl & 31;
    BrLin br{32 * cg};
    mini_mma2<2, 256>(F, (const bf16*)(F.ws + WS_MIX), DM, (const bf16*)(F.ws + WS_WOUT), br, MP + 64 * rg, tile, PT);
    __syncthreads();
    const int r = F.tid >> 3, c0 = 4 * (F.tid & 7), row = 64 * rg + r, col = 32 * cg + c0;
    f32x4 a = (f32x4){0.f, 0.f, 0.f, 0.f}, b = (f32x4){0.f, 0.f, 0.f, 0.f};
    a = *(const LAS f32x4*)(tile + r * PT + c0);
    const f32x4 hv = *(const f32x4*)(F.in[1] + (size_t)row * DM + col) + a + b;
    u32x2_t wv; wv.x = cvtpk(hv[0], hv[1]); wv.y = cvtpk(hv[2], hv[3]); *(u32x2_t*)((bf16*)(F.ws + WS_HB) + (size_t)(MP + row) * DM + col) = wv;
    float ss = (hv[0] * hv[0] + hv[1] * hv[1]) + (hv[2] * hv[2] + hv[3] * hv[3]);
    ss += __shfl_xor(ss, 1); ss += __shfl_xor(ss, 2); ss += __shfl_xor(ss, 4);
    if ((F.tid & 7) == 0) ((float*)(F.ws + WS_SSPS))[row * 32 + cg] = ss;
    __syncthreads();
}
__device__ __forceinline__ void mini_up(Frame& F, int tl) {
    LAS float* tile = (LAS float*)(F.lds + RING_OFF + MINI_TILE_OFF); constexpr int PT = 196;
    const int rg = tl >> 5, cg = tl & 31, ch0 = 88 * cg;
    BrUp br{ch0};
    mini_mma2<12, 64>(F, (const bf16*)(F.ws + WS_HB), DM, (const bf16*)(F.ws + WS_WUP), br, MP + 64 * rg, tile, PT);
    __syncthreads();
    { const int r = F.tid >> 3, row = 64 * rg + r; const float* sp = (const float*)(F.ws + WS_SSPS) + row * 32 + 4 * (F.tid & 7);
      const f32x4 t = *(const f32x4*)sp; float ss = (t[0] + t[1]) + (t[2] + t[3]); ss += __shfl_xor(ss, 1); ss += __shfl_xor(ss, 2); ss += __shfl_xor(ss, 4);
      const float rr = 1.0f / sqrtf(ss * (1.0f / DM) + EPS);
      for (int c = (F.tid & 7); c < 192; c += 8) tile[r * PT + c] = tile[r * PT + c] * rr; }
    __syncthreads();
    { const float* cw = F.in[15]; const float* cbp = F.in[16];
#pragma unroll 1
      for (int it = F.tid; it < 64 * 11; it += NWAVES * 64) {
          const int r = it / 11, j = it - 11 * r, row = 64 * rg + r, n = row & 3, b = row >> 2, ch = ch0 + 8 * j; const float* hist = F.in[5] + (size_t)b * 2 * FF2;
          const int r1 = r >= 1 ? r - 1 : 0, r2 = r >= 2 ? r - 2 : 0;
          f32x4 cv[2][2];
#pragma unroll
          for (int hf = 0; hf < 2; ++hf)
#pragma unroll
              for (int q = 0; q < 2; ++q) { const int col = hf * FF + ch + 4 * q, lc = hf * 96 + 8 * j + 4 * q;
                  const f32x4 cur = *(const LAS f32x4*)(tile + r * PT + lc), t1 = *(const LAS f32x4*)(tile + r1 * PT + lc), t2 = *(const LAS f32x4*)(tile + r2 * PT + lc);
                  const f32x4 h0 = *(const f32x4*)(hist + col), h1 = *(const f32x4*)(hist + FF2 + col);
                  const f32x4 p1 = n >= 1 ? t1 : h1, p2 = n >= 2 ? t2 : (n == 1 ? h1 : h0);
                  cv[hf][q] = *(const f32x4*)(cbp + col) + *(const f32x4*)(cw + col) * p2 + *(const f32x4*)(cw + FF2 + col) * p1 + *(const f32x4*)(cw + 2 * FF2 + col) * cur;
                  if (n >= 2) *(f32x4*)(F.out + O_FS + ((size_t)b * 2 + n - 2) * FF2 + col) = cur; }
          u32x4_t wv;
          wv.x = cvtpk(pg8::silu_mul(cv[0][0][0], cv[1][0][0]), pg8::silu_mul(cv[0][0][1], cv[1][0][1])); wv.y = cvtpk(pg8::silu_mul(cv[0][0][2], cv[1][0][2]), pg8::silu_mul(cv[0][0][3], cv[1][0][3]));
          wv.z = cvtpk(pg8::silu_mul(cv[0][1][0], cv[1][1][0]), pg8::silu_mul(cv[0][1][1], cv[1][1][1])); wv.w = cvtpk(pg8::silu_mul(cv[0][1][2], cv[1][1][2]), pg8::silu_mul(cv[0][1][3], cv[1][1][3]));
          *(u32x4_t*)((bf16*)(F.ws + WS_ACT) + (size_t)(MP + row) * FF + ch) = wv; } }
    __syncthreads();
}
__device__ __forceinline__ void mini_down(Frame& F, int tl) {
    LAS float* tile = (LAS float*)(F.lds + RING_OFF + MINI_TILE_OFF_WIDE); constexpr int PT = 36;
    const int rg = tl >> 5, cg = tl & 31;
    BrLin br{32 * cg};
    mini_mma2<2, 256>(F, (const bf16*)(F.ws + WS_ACT), FF, (const bf16*)(F.ws + WS_WDN), br, MP + 64 * rg, tile, PT);
    __syncthreads();
    const int r = F.tid >> 3, c0 = 4 * (F.tid & 7), row = 64 * rg + r, col = 32 * cg + c0;
    f32x4 a = (f32x4){0.f, 0.f, 0.f, 0.f}, b = (f32x4){0.f, 0.f, 0.f, 0.f};
    a = *(const LAS f32x4*)(tile + r * PT + c0);
    const u32x2_t hb = *(const u32x2_t*)((const bf16*)(F.ws + WS_HB) + (size_t)(MP + row) * DM + col);
    const f32x4 hv = (f32x4){__builtin_bit_cast(float, hb.x << 16), __builtin_bit_cast(float, hb.x & 0xffff0000u), __builtin_bit_cast(float, hb.y << 16), __builtin_bit_cast(float, hb.y & 0xffff0000u)};
    *(f32x4*)(F.out + O_Y + (size_t)(MP + row) * DM + col) = hv + a + b;
    __syncthreads();
}
__device__ __forceinline__ void p6_fix_rows(Frame& F) {
    const float* halo = (const float*)(F.ws + WS_HALO); const float* cw = F.in[15]; const float* cbp = F.in[16]; bf16* ACT = (bf16*)(F.ws + WS_ACT);
    for (int it = blockIdx.x; it < NPANEL_P * 2; it += F.G) {
        const int pm = it >> 1, e = it & 1; const bool first = (pm & 7) == 0;
#pragma unroll
        for (int it2 = 0; it2 < 6; ++it2) { const int ch = F.tid + it2 * NWAVES * 64; if (ch < FF) {
            float cv[2];
#pragma unroll
            for (int bj = 0; bj < 2; ++bj) { const int col = bj * FF + ch;
                const float um2 = first ? 0.f : halo[(size_t)((pm - 1) * 4 + 2) * FF2 + col], um1 = first ? 0.f : halo[(size_t)((pm - 1) * 4 + 3) * FF2 + col];
                const float u0 = halo[(size_t)(pm * 4 + 0) * FF2 + col], u1 = halo[(size_t)(pm * 4 + 1) * FF2 + col];
                const float w0 = cw[col], w1 = cw[FF2 + col], w2 = cw[2 * FF2 + col], cb = cbp[col];
                cv[bj] = e == 0 ? cb + w0 * um2 + w1 * um1 + w2 * u0 : cb + w0 * um1 + w1 * u0 + w2 * u1; }
            ACT[(size_t)(pm * 256 + e) * FF + ch] = (bf16)f2bf(pg8::silu_mul(cv[0], cv[1]));
        } }
    }
}


struct Args { const float* in[18]; float* out; unsigned char* ws; int ph_lo, ph_hi, li, pad; };
__global__ void __launch_bounds__(NWAVES * 64, 2) mk_fwd(Args args) {
    extern __shared__ __attribute__((aligned(16))) unsigned char lds[];
    Frame F;
    F.lds = (LAS unsigned char*)lds;
    F.MISC = (volatile LAS unsigned*)(F.lds + MISC_OFF);
    F.tid = threadIdx.x; F.lane = F.tid & 63; F.wave = __builtin_amdgcn_readfirstlane(F.tid >> 6);
    F.G = gridDim.x; { const int bx = blockIdx.x; F.vcu = (F.G % 8 == 0) ? (bx % 8) * (F.G / 8) + bx / 8 : bx; }
    unsigned char* ws = args.ws; F.ws = ws; F.out = args.out;
    F.ctl = (gu32*)(ws + WS_CTL);
#pragma unroll
    for (int i = 0; i < 18; ++i) F.in[i] = args.in[i];
    for (int u = F.tid; u < (LDS_BYTES - LDSCTL_OFF) / 4; u += NWAVES * 64) ((LAS unsigned*)(F.lds + LDSCTL_OFF))[u] = 0u;
    __syncthreads();
    XcdBarrier bar; bar.bar = (unsigned*)(F.ctl + CW_BAR); bar.x = 0; bar.st = nullptr;
    if (N_LAUNCHES != PER_PHASE) bar = xcd_barrier_post((unsigned*)(F.ctl + CW_BAR), F.MISC + 8);
#define GRID_BAR(seam) do { if (N_LAUNCHES == PER_PHASE) { if (F.tid == 0) __hip_atomic_store(F.ctl + CW_TMO, 0xBADBA0u | (unsigned)(seam), RLX_AGENT); } else { xcd_barrier(bar); } } while (0)
    const int lo = args.ph_lo, hi = args.ph_hi;
#ifndef PH_MASK
#define PH_MASK 127
#endif
#define IN(k) ((((PH_MASK) >> (k)) & 1) && lo <= (k) && (k) < hi)
#define BOTH(k) (IN(k) && IN((k) + 1))
    bf16* const XN = (bf16*)(ws + WS_XN); bf16* const QB = (bf16*)(ws + WS_Q); bf16* const MIX = (bf16*)(ws + WS_MIX); bf16* const HB = (bf16*)(ws + WS_HB); bf16* const ACT = (bf16*)(ws + WS_ACT);

    if (IN(0)) { p0_prologue(F); if (BOTH(0)) GRID_BAR(0); }

    if (IN(1)) {
        pg8::Gemm g{XN, (const bf16*)(ws + WS_WIN), MP, PJ, DM}; pg8::StaticOrder S; S.init(MP, PJ, F.G, (int)blockIdx.x);
        pg8::EpiInProj E{QB, QKVU_STRIDE / 2, F.out, F.in[8], F.in[9], (const float*)(ws + WS_RRX)};
        pg8::gemm_phase<pg8::EpiInProj, pg8::StaticOrder, true, true>(F.lds + RING_OFF, g, S, E);
        for (int tl = blockIdx.x; tl < 256; tl += F.G) mini_inproj(F, tl);
        if (BOTH(1)) GRID_BAR(1);
    }

    if (IN(2)) { p2_attn(F); if (BOTH(2)) GRID_BAR(2); }

    if (IN(3)) {
        pg8::Gemm g{MIX, (const bf16*)(ws + WS_WOUT), MP, DM, DM}; pg8::StaticOrder S; S.init(MP, DM, F.G, (int)blockIdx.x);
        pg8::EpiOutProj E{XN, HB, (float*)(ws + WS_SSP), (PG8_LAS float*)(F.lds + TAB_OFF)};
        pg8::gemm_phase<pg8::EpiOutProj, pg8::StaticOrder, true, true>(F.lds + RING_OFF, g, S, E);
        for (int tl = blockIdx.x; tl < 256; tl += F.G) mini_outproj(F, tl);
        if (BOTH(3)) GRID_BAR(3);
    }

    if (IN(4)) {
        pg8::Gemm g{HB, (const bf16*)(ws + WS_WUP), MP, FF2, DM}; pg8::StaticOrder S; S.init(MP, FF2, F.G, (int)blockIdx.x);
        pg8::EpiUp E{ACT, (const float*)(ws + WS_SSP), (float*)(ws + WS_HALO), F.out, F.in[15], F.in[16], (PG8_LAS float*)(F.lds + TAB_OFF), F.lds + EPF_OFF};
        pg8::gemm_phase<pg8::EpiUp, pg8::StaticOrder, true, true>(F.lds + RING_OFF, g, S, E);
        for (int tl = blockIdx.x; tl < 256; tl += F.G) mini_up(F, tl);
        if (BOTH(4)) GRID_BAR(4);
    }

    if (IN(5)) { p6_fix_rows(F); if (BOTH(5)) GRID_BAR(5); }

    if (IN(6)) {
        pg8::Gemm g{ACT, (const bf16*)(ws + WS_WDN), MP, DM, FF}; pg8::StaticOrder S; S.init(MP, DM, F.G, (int)blockIdx.x);
        pg8::EpiDown E{F.out + O_Y, HB};
        pg8::gemm_phase<pg8::EpiDown, pg8::StaticOrder, true, true>(F.lds + RING_OFF, g, S, E);
        for (int tl = blockIdx.x; tl < 256; tl += F.G) mini_down(F, tl);
    }
#undef IN
#undef BOTH
}

extern "C" void kernel_launch(void* const* d_in, const int* in_sizes, int n_in, void* d_out, int out_size, void* d_ws, size_t ws_size, hipStream_t stream) {
    static int grid = 0;
    if (grid == 0) {
        if (n_in != 18 || in_sizes[0] != MP * DM || out_size != (int)O_END || ws_size < WS_END) { fprintf(stderr, "kernel_launch: unexpected shapes: n_in %d, in0 %d, out %d, ws %zu (need %zu); nothing launched\n", n_in, n_in > 0 ? in_sizes[0] : -1, out_size, ws_size, (size_t)WS_END); grid = -1; return; }
        int dev = 0, cus = 0, per_cu = 0;
        if (hipGetDevice(&dev) != hipSuccess || hipDeviceGetAttribute(&cus, hipDeviceAttributeMultiprocessorCount, dev) != hipSuccess) { fprintf(stderr, "kernel_launch: hipGetDevice / hipDeviceGetAttribute failed\n"); grid = -1; return; }
        if (hipFuncSetAttribute((const void*)mk_fwd, hipFuncAttributeMaxDynamicSharedMemorySize, LDS_BYTES) != hipSuccess) { fprintf(stderr, "kernel_launch: hipFuncSetAttribute failed\n"); grid = -1; return; }
        if (hipOccupancyMaxActiveBlocksPerMultiprocessor(&per_cu, (const void*)mk_fwd, NWAVES * 64, LDS_BYTES) != hipSuccess || per_cu < 1)
            fprintf(stderr, "kernel_launch: note: occupancy query reports %d workgroups per CU\n", per_cu);
        (void)hipGetLastError();
        grid = cus;
    }
    if (grid < 0) return;
    if (hipMemsetAsync((char*)d_ws + WS_CTL, 0, CTL_ZERO_BYTES, stream) != hipSuccess) { fprintf(stderr, "kernel_launch: hipMemsetAsync failed\n"); return; }
    Args a{};
    for (int i = 0; i < 18; ++i) a.in[i] = (const float*)d_in[i];
    a.out = (float*)d_out; a.ws = (unsigned char*)d_ws;
    static_assert(N_LAUNCHES == 1 || N_LAUNCHES == PER_PHASE, "-DMK_N_LAUNCHES must be 1 or 7");
    for (int li = 0; li < N_LAUNCHES; ++li) {
        a.ph_lo = (N_LAUNCHES == PER_PHASE) ? li : 0; a.ph_hi = (N_LAUNCHES == PER_PHASE) ? li + 1 : PER_PHASE; a.li = li;
        hipLaunchKernelGGL(mk_fwd, dim3(grid), dim3(NWAVES * 64), LDS_BYTES, stream, a);
        const hipError_t le = hipPeekAtLastError();
        if (le != hipSuccess) { fprintf(stderr, "kernel_launch: launch %d failed: %s\n", li, hipGetErrorName(le)); break; }
    }
}
```
